# Optimizing an MI355X kernel written in HIP

```python
import math
import jax, jax.numpy as jnp
from jax import lax
import numpy as np

D_MODEL = 1024
BATCH = 2
SEQ = 8192
DEPTH = 2

N_HEADS = 8
QK_NOPE_DIM = 64
QK_ROPE_DIM = 32
QK_HEAD_DIM = QK_NOPE_DIM + QK_ROPE_DIM
V_HEAD_DIM = 64
Q_LORA_RANK = 256
KV_LORA_RANK = 128
ROPE_THETA = 10000.0
Q_BLOCK = 128
ATTN_WIDTH = N_HEADS * V_HEAD_DIM

S5_WIDTH = 512
S5_GROUP = 16
S5_GROUPS = S5_WIDTH // S5_GROUP
S5_STATE = 64
DT_MIN = 1e-3
DT_MAX = 1e-1

D_FF_DENSE = 2816
N_EXPERTS = 8
TOP_K = 2
D_FF_EXPERT = 3584
N_DENSE = (DEPTH + 1) // 2
N_MOE = DEPTH // 2

EPS = 1e-6

IN_PARTS = [Q_LORA_RANK, KV_LORA_RANK, QK_ROPE_DIM, S5_WIDTH, D_MODEL, D_MODEL]
IN_COLS = sum(IN_PARTS)
IN_SPLITS = [int(v) for v in np.cumsum(IN_PARTS)[:-1]]

kernel_name = "hybrid_mla_s5_gated_moe_block"


def rmsnorm(x, g):
    xf = x.astype(jnp.float32)
    y = xf * lax.rsqrt(jnp.mean(xf * xf, axis=-1, keepdims=True) + EPS) * g.astype(jnp.float32)
    return y.astype(x.dtype)


def rope_tables(s, dtype):
    pos = jnp.arange(s, dtype=jnp.float32)
    inv = jnp.power(ROPE_THETA, -jnp.arange(0, QK_ROPE_DIM, 2, dtype=jnp.float32) / QK_ROPE_DIM)
    ang = pos[:, None] * inv[None, :]
    return jnp.cos(ang)[:, None, :].astype(dtype), jnp.sin(ang)[:, None, :].astype(dtype)


def rope(x, cos, sin):
    half = QK_ROPE_DIM // 2
    x1, x2 = x[..., :half], x[..., half:]
    return jnp.concatenate([x1 * cos - x2 * sin, x2 * cos + x1 * sin], axis=-1)


def causal_block_attention(q, k, v):
    b, s, h, dq = q.shape
    nb = s // Q_BLOCK
    qb = q.reshape(b, nb, Q_BLOCK, h, dq).transpose(1, 0, 2, 3, 4)
    kpos = jnp.arange(s)
    scale = QK_HEAD_DIM ** -0.5

    def one_block(args):
        qi, i = args
        qpos = i * Q_BLOCK + jnp.arange(Q_BLOCK)
        sc = jnp.einsum('bqhd,bkhd->bhqk', qi, k, preferred_element_type=jnp.float32) * scale
        sc = jnp.where(kpos[None, :] <= qpos[:, None], sc, -jnp.inf)
        p = jax.nn.softmax(sc, axis=-1).astype(v.dtype)
        return jnp.einsum('bhqk,bkhd->bqhd', p, v)

    out = lax.map(one_block, (qb, jnp.arange(nb)))
    return out.transpose(1, 0, 2, 3, 4).reshape(b, s, h, v.shape[-1])


def mla_branch(q_lat, kv_lat, k_rope, q_norm_g, w_uq, kv_norm_g, w_ukv, q_head_g, k_head_g):
    b, s, _ = q_lat.shape
    q = (rmsnorm(q_lat, q_norm_g) @ w_uq).reshape(b, s, N_HEADS, QK_HEAD_DIM)
    kv = (rmsnorm(kv_lat, kv_norm_g) @ w_ukv).reshape(b, s, N_HEADS, QK_NOPE_DIM + V_HEAD_DIM)
    k_nope, v = kv[..., :QK_NOPE_DIM], kv[..., QK_NOPE_DIM:]
    k_rope_h = jnp.broadcast_to(k_rope[:, :, None, :], (b, s, N_HEADS, QK_ROPE_DIM))
    k = jnp.concatenate([k_nope, k_rope_h], axis=-1)
    q = rmsnorm(q, q_head_g)
    k = rmsnorm(k, k_head_g)
    cos, sin = rope_tables(s, q.dtype)
    q = jnp.concatenate([q[..., :QK_NOPE_DIM], rope(q[..., QK_NOPE_DIM:], cos, sin)], axis=-1)
    k = jnp.concatenate([k[..., :QK_NOPE_DIM], rope(k[..., QK_NOPE_DIM:], cos, sin)], axis=-1)
    out = causal_block_attention(q, k, v)
    return out.reshape(b, s, ATTN_WIDTH)


def s5_branch(u, lam_re, lam_im, log_step, b_re, b_im, c_re, c_im, d_skip, w_glu, b_glu):
    bsz, s, _ = u.shape
    uf = u.astype(jnp.float32)
    ug = uf.reshape(bsz, s, S5_GROUPS, S5_GROUP).astype(jnp.complex64)
    lam = lax.complex(lam_re.astype(jnp.float32), lam_im.astype(jnp.float32))
    step = jnp.exp(log_step.astype(jnp.float32))[:, None]
    lam_bar = jnp.exp(lam * step)
    b_mat = lax.complex(b_re.astype(jnp.float32), b_im.astype(jnp.float32))
    b_bar = ((lam_bar - 1.0) / lam)[..., None] * b_mat
    bu = jnp.einsum('gpc,bsgc->bsgp', b_bar, ug)
    a = jnp.broadcast_to(lam_bar, bu.shape)

    def combine(left, right):
        a1, b1 = left
        a2, b2 = right
        return a2 * a1, a2 * b1 + b2

    _, states = lax.associative_scan(combine, (a, bu), axis=1)
    c_mat = lax.complex(c_re.astype(jnp.float32), c_im.astype(jnp.float32))
    y = jnp.real(jnp.einsum('gcp,bsgp->bsgc', c_mat, states)).reshape(bsz, s, S5_WIDTH)
    y = (y + d_skip.astype(jnp.float32) * uf).astype(u.dtype)
    y = jax.nn.gelu(y)
    return y * jax.nn.sigmoid(y @ w_glu + b_glu)


def swiglu(h, w_gate, w_up, w_down):
    return (jax.nn.silu(h @ w_gate) * (h @ w_up)) @ w_down


def moe_swiglu(h, router_w, router_b, w_gate, w_up, w_down):
    b, s, d = h.shape
    t = h.reshape(b * s, d)
    logits = (t @ router_w).astype(jnp.float32) + router_b.astype(jnp.float32)
    top_val, top_idx = lax.top_k(logits, TOP_K)
    top_w = jax.nn.softmax(top_val, axis=-1)
    comb = jnp.sum(jax.nn.one_hot(top_idx, N_EXPERTS, dtype=jnp.float32) * top_w[..., None], axis=1)
    comb = comb.astype(t.dtype)
    out = jnp.zeros_like(t)
    for e in range(N_EXPERTS):
        out = out + comb[:, e:e + 1] * swiglu(t, w_gate[e], w_up[e], w_down[e])
    return out.reshape(b, s, d)


def setup_inputs(seed: int = 0) -> dict:
    key = jax.random.key(seed)
    ks = iter(jax.random.split(key, 48))
    f32 = jnp.float32

    def nrm(shape, fan_in):
        return jax.random.normal(next(ks), shape, f32) * (fan_in ** -0.5)

    def gain(shape):
        return 1.0 + 0.02 * jax.random.normal(next(ks), shape, f32)

    def small(shape, scale=0.01):
        return scale * jax.random.normal(next(ks), shape, f32)

    L, G, P, C = DEPTH, S5_GROUPS, S5_STATE, S5_GROUP
    lam_re = -0.5 + small((L, G, P))
    lam_im = math.pi * jnp.broadcast_to(jnp.arange(P, dtype=f32), (L, G, P)) + small((L, G, P))
    log_step = jax.random.uniform(next(ks), (L, G), f32, math.log(DT_MIN), math.log(DT_MAX))
    return {
        "x": jax.random.normal(next(ks), (BATCH, SEQ, D_MODEL), f32),
        "ln_mix_g": gain((L, D_MODEL)),
        "w_in": nrm((L, D_MODEL, IN_COLS), D_MODEL),
        "b_in": small((L, IN_COLS)),
        "q_norm_g": gain((L, Q_LORA_RANK)),
        "w_uq": nrm((L, Q_LORA_RANK, N_HEADS * QK_HEAD_DIM), Q_LORA_RANK),
        "kv_norm_g": gain((L, KV_LORA_RANK)),
        "w_ukv": nrm((L, KV_LORA_RANK, N_HEADS * (QK_NOPE_DIM + V_HEAD_DIM)), KV_LORA_RANK),
        "q_head_g": gain((L, QK_HEAD_DIM)),
        "k_head_g": gain((L, QK_HEAD_DIM)),
        "s5_lam_re": lam_re,
        "s5_lam_im": lam_im,
        "s5_log_step": log_step,
        "s5_b_re": nrm((L, G, P, C), 2 * C),
        "s5_b_im": nrm((L, G, P, C), 2 * C),
        "s5_c_re": nrm((L, G, C, P), P),
        "s5_c_im": nrm((L, G, C, P), P),
        "s5_d": jax.random.normal(next(ks), (L, S5_WIDTH), f32),
        "w_glu": nrm((L, S5_WIDTH, S5_WIDTH), S5_WIDTH),
        "b_glu": small((L, S5_WIDTH)),
        "w_proj_attn": nrm((L, ATTN_WIDTH, D_MODEL), ATTN_WIDTH),
        "w_proj_ssm": nrm((L, S5_WIDTH, D_MODEL), S5_WIDTH),
        "w_out": nrm((L, D_MODEL, D_MODEL), D_MODEL),
        "ln_ffn_g": gain((L, D_MODEL)),
        "ffn_w_gate": nrm((N_DENSE, D_MODEL, D_FF_DENSE), D_MODEL),
        "ffn_w_up": nrm((N_DENSE, D_MODEL, D_FF_DENSE), D_MODEL),
        "ffn_w_down": nrm((N_DENSE, D_FF_DENSE, D_MODEL), D_FF_DENSE),
        "router_w": nrm((N_MOE, D_MODEL, N_EXPERTS), D_MODEL),
        "router_b": small((N_MOE, N_EXPERTS)),
        "moe_w_gate": nrm((N_MOE, N_EXPERTS, D_MODEL, D_FF_EXPERT), D_MODEL),
        "moe_w_up": nrm((N_MOE, N_EXPERTS, D_MODEL, D_FF_EXPERT), D_MODEL),
        "moe_w_down": nrm((N_MOE, N_EXPERTS, D_FF_EXPERT, D_MODEL), D_FF_EXPERT),
    }


def reference(x, ln_mix_g, w_in, b_in, q_norm_g, w_uq, kv_norm_g, w_ukv, q_head_g, k_head_g,
              s5_lam_re, s5_lam_im, s5_log_step, s5_b_re, s5_b_im, s5_c_re, s5_c_im, s5_d,
              w_glu, b_glu, w_proj_attn, w_proj_ssm, w_out, ln_ffn_g,
              ffn_w_gate, ffn_w_up, ffn_w_down, router_w, router_b,
              moe_w_gate, moe_w_up, moe_w_down):
    for l in range(DEPTH):
        h = rmsnorm(x, ln_mix_g[l])
        proj = h @ w_in[l] + b_in[l]
        q_lat, kv_lat, k_rope, u, gate_a, gate_b = jnp.split(proj, IN_SPLITS, axis=-1)
        attn = mla_branch(q_lat, kv_lat, k_rope, q_norm_g[l], w_uq[l], kv_norm_g[l], w_ukv[l],
                          q_head_g[l], k_head_g[l])
        ssm = s5_branch(u, s5_lam_re[l], s5_lam_im[l], s5_log_step[l], s5_b_re[l], s5_b_im[l],
                        s5_c_re[l], s5_c_im[l], s5_d[l], w_glu[l], b_glu[l])
        mix = (jax.nn.sigmoid(gate_a) * (attn @ w_proj_attn[l])
               + jax.nn.sigmoid(gate_b) * (ssm @ w_proj_ssm[l]))
        x = x + mix @ w_out[l]
        h = rmsnorm(x, ln_ffn_g[l])
        if l % 2 == 0:
            j = l // 2
            x = x + swiglu(h, ffn_w_gate[j], ffn_w_up[j], ffn_w_down[j])
        else:
            j = l // 2
            x = x + moe_swiglu(h, router_w[j], router_b[j], moe_w_gate[j], moe_w_up[j], moe_w_down[j])
    return x
```

```cpp
#include <hip/hip_runtime.h>
#include <cstdio>
#include <cstdint>

typedef unsigned short bf16_t;
typedef short bf16x8 __attribute__((ext_vector_type(8)));
typedef float f32x4 __attribute__((ext_vector_type(4)));
typedef unsigned u32x4 __attribute__((ext_vector_type(4)));

constexpr int D = 1024, BATCH = 2, SEQ = 8192, T = BATCH * SEQ, DEPTH = 2;
constexpr int NH = 8, QKD = 96, NOPE = 64, ROPE = 32, VD = 64, QLR = 256, KVLR = 128;
constexpr int S5W = 512, S5G = 32, S5P = 64, S5C = 16;
constexpr int FFD = 2816, NE = 8, FFE = 3584, INC = 2976;
constexpr int RCAP = 34816;
constexpr float EPS = 1e-6f;
constexpr float QSCALE = 0.14724444602590306f;

__device__ __forceinline__ unsigned f2bf(float f) { unsigned u = __builtin_bit_cast(unsigned, f); return (u + 0x7fffu + ((u >> 16) & 1u)) >> 16; }
__device__ __forceinline__ float bf2f(unsigned h) { return __builtin_bit_cast(float, h << 16); }
__device__ __forceinline__ float wave_sum(float v) {
#pragma unroll
    for (int o = 1; o < 64; o <<= 1) v += __shfl_xor(v, o);
    return v;
}
__device__ __forceinline__ float sigmoidf_(float v) { return 1.f / (1.f + __expf(-v)); }
__device__ __forceinline__ float siluf_(float v) { return v / (1.f + __expf(-v)); }
__device__ __forceinline__ float gelu_tanh(float v) {
    const float z = 0.7978845608028654f * (v + 0.044715f * v * v * v);
    const float e = __expf(2.f * z);
    const float th = 1.f - 2.f / (e + 1.f);
    return 0.5f * v * (1.f + th);
}
__device__ __forceinline__ void sincos_rev(double rev, float& s, float& c) {
    const double fr = rev - floor(rev);
    const float f = (float)fr;
    s = __builtin_amdgcn_sinf(f); c = __builtin_amdgcn_cosf(f);
}

__global__ void __launch_bounds__(256) k_rms1024(const float* __restrict__ x, const float* __restrict__ g, bf16_t* __restrict__ out, int rows) {
    const int lane = threadIdx.x & 63; const int row = blockIdx.x * 4 + (threadIdx.x >> 6);
    if (row >= rows) return;
    const f32x4* xr = (const f32x4*)(x + (size_t)row * D) + lane;
    f32x4 v[4]; float s = 0.f;
#pragma unroll
    for (int j = 0; j < 4; ++j) { v[j] = xr[64 * j]; s += v[j].x * v[j].x + v[j].y * v[j].y + v[j].z * v[j].z + v[j].w * v[j].w; }
    const float r = rsqrtf(wave_sum(s) * (1.f / D) + EPS);
#pragma unroll
    for (int j = 0; j < 4; ++j) {
        const f32x4 gg = *((const f32x4*)g + lane + 64 * j);
        const unsigned lo = f2bf(v[j].x * r * gg.x) | (f2bf(v[j].y * r * gg.y) << 16), hi = f2bf(v[j].z * r * gg.z) | (f2bf(v[j].w * r * gg.w) << 16);
        *((uint2*)(out + (size_t)row * D) + lane + 64 * j) = make_uint2(lo, hi);
    }
}
template <int W>
__global__ void __launch_bounds__(256) k_rms_small(const float* __restrict__ x, const float* __restrict__ g, bf16_t* __restrict__ out, int rows) {
    const int lane = threadIdx.x & 63; const int row = blockIdx.x * 4 + (threadIdx.x >> 6);
    if (row >= rows) return;
    float v[W / 64]; float s = 0.f;
#pragma unroll
    for (int j = 0; j < W / 64; ++j) { v[j] = x[(size_t)row * W + lane + 64 * j]; s += v[j] * v[j]; }
    const float r = rsqrtf(wave_sum(s) * (1.f / W) + EPS);
#pragma unroll
    for (int j = 0; j < W / 64; ++j) out[(size_t)row * W + lane + 64 * j] = (bf16_t)f2bf(v[j] * r * g[lane + 64 * j]);
}

template <bool DUAL, class Epi>
__global__ void __launch_bounds__(256) k_sgemm(const bf16_t* __restrict__ A, int lda, const int* __restrict__ arow, const int* __restrict__ texp, size_t wstride,
                                               const float* __restrict__ W, const float* __restrict__ W2, int ldw, int M, int N, int K, Epi E) {
    const int lane = threadIdx.x & 63;
    const long wv = (long)blockIdx.x * 4 + (threadIdx.x >> 6);
    const int ntn = N >> 5; const long nt = (long)(M >> 5) * ntn;
    if (wv >= nt) return;
    const int tm = (int)(wv / ntn), tn = (int)(wv % ntn);
    if (texp) { const int e = texp[tm]; if (e < 0) return; W += (size_t)e * wstride; if (DUAL) W2 += (size_t)e * wstride; }
    const int r16 = lane & 15, q = lane >> 4;
    f32x4 acc[2][2], acc2[2][2];
#pragma unroll
    for (int i = 0; i < 2; ++i)
#pragma unroll
        for (int j = 0; j < 2; ++j) { acc[i][j] = (f32x4){0.f, 0.f, 0.f, 0.f}; acc2[i][j] = (f32x4){0.f, 0.f, 0.f, 0.f}; }
    const bf16_t* ap[2]; bool av[2];
#pragma unroll
    for (int i = 0; i < 2; ++i) { const int r = tm * 32 + i * 16 + r16; const int rr = arow ? arow[r] : r; av[i] = rr >= 0; ap[i] = A + (size_t)(av[i] ? rr : 0) * lda + q * 8; }
    const size_t woff = (size_t)(q * 8) * ldw + tn * 32 + r16;
    for (int k0 = 0; k0 < K; k0 += 32) {
        bf16x8 a[2], b[2], b2[2];
#pragma unroll
        for (int i = 0; i < 2; ++i) { a[i] = (bf16x8){0, 0, 0, 0, 0, 0, 0, 0}; if (av[i]) a[i] = *(const bf16x8*)(ap[i] + k0); }
#pragma unroll
        for (int jn = 0; jn < 2; ++jn)
#pragma unroll
            for (int j = 0; j < 8; ++j) {
                b[jn][j] = (short)f2bf(W[woff + (size_t)(k0 + j) * ldw + jn * 16]);
                if (DUAL) b2[jn][j] = (short)f2bf(W2[woff + (size_t)(k0 + j) * ldw + jn * 16]);
            }
#pragma unroll
        for (int i = 0; i < 2; ++i)
#pragma unroll
            for (int jn = 0; jn < 2; ++jn) {
                acc[i][jn] = __builtin_amdgcn_mfma_f32_16x16x32_bf16(a[i], b[jn], acc[i][jn], 0, 0, 0);
                if (DUAL) acc2[i][jn] = __builtin_amdgcn_mfma_f32_16x16x32_bf16(a[i], b2[jn], acc2[i][jn], 0, 0, 0);
            }
    }
#pragma unroll
    for (int i = 0; i < 2; ++i)
#pragma unroll
        for (int jn = 0; jn < 2; ++jn)
#pragma unroll
            for (int j = 0; j < 4; ++j) E(tm * 32 + i * 16 + q * 4 + j, tn * 32 + jn * 16 + r16, acc[i][jn][j], acc2[i][jn][j]);
}

struct EpiProj {
    const float* b; float* qlat; float* kvlat; float* krope; bf16_t* u; bf16_t* ga; bf16_t* gb;
    __device__ __forceinline__ void operator()(int r, int c, float v, float) const {
        v += b[c];
        if (c < 256) qlat[(size_t)r * 256 + c] = v;
        else if (c < 384) kvlat[(size_t)r * 128 + (c - 256)] = v;
        else if (c < 416) krope[(size_t)r * 32 + (c - 384)] = v;
        else if (c < 928) u[(size_t)r * 512 + (c - 416)] = (bf16_t)f2bf(v);
        else if (c < 1952) ga[(size_t)r * 1024 + (c - 928)] = (bf16_t)f2bf(sigmoidf_(v));
        else gb[(size_t)r * 1024 + (c - 1952)] = (bf16_t)f2bf(sigmoidf_(v));
    }
};
struct EpiF32 { float* C; int ldc; int pad; __device__ __forceinline__ void operator()(int r, int c, float v, float) const { C[(size_t)r * ldc + c] = v; } };
struct EpiGlu {
    const bf16_t* yg; const float* b; bf16_t* out;
    __device__ __forceinline__ void operator()(int r, int c, float v, float) const { const float y = bf2f(yg[(size_t)r * 512 + c]); out[(size_t)r * 512 + c] = (bf16_t)f2bf(y * sigmoidf_(v + b[c])); }
};
struct EpiMixA { const bf16_t* ga; float* tmp; __device__ __forceinline__ void operator()(int r, int c, float v, float) const { tmp[(size_t)r * 1024 + c] = bf2f(ga[(size_t)r * 1024 + c]) * v; } };
struct EpiMixB { const bf16_t* gb; const float* tmp; bf16_t* mix;
    __device__ __forceinline__ void operator()(int r, int c, float v, float) const { mix[(size_t)r * 1024 + c] = (bf16_t)f2bf(tmp[(size_t)r * 1024 + c] + bf2f(gb[(size_t)r * 1024 + c]) * v); } };
struct EpiResid { const float* xin; float* xout; __device__ __forceinline__ void operator()(int r, int c, float v, float) const { xout[(size_t)r * 1024 + c] = xin[(size_t)r * 1024 + c] + v; } };
struct EpiSwiglu { bf16_t* h; int ldh; int pad; __device__ __forceinline__ void operator()(int r, int c, float vg, float vu) const { h[(size_t)r * ldh + c] = (bf16_t)f2bf(siluf_(vg) * vu); } };

__constant__ double c_invrev[16] = {0.15915494309189535, 0.08949940160889101, 0.050329212104487035, 0.0283021958306234, 0.015915494309189534, 0.008949940160889102,
    0.005032921210448704, 0.00283021958306234, 0.0015915494309189536, 0.0008949940160889102, 0.0005032921210448703, 0.00028302195830623395, 0.00015915494309189535,
    8.949940160889102e-05, 5.0329212104487035e-05, 2.8302195830623396e-05};
__global__ void __launch_bounds__(256) k_heads(const float* __restrict__ qraw, const float* __restrict__ kvraw, const float* __restrict__ krope, const float* __restrict__ gq, const float* __restrict__ gk,
                                               bf16_t* __restrict__ Qn, bf16_t* __restrict__ Kn, bf16_t* __restrict__ Vn) {
    const int id = blockIdx.x * 256 + threadIdx.x; const int t = id >> 3, h = id & 7;
    const int b = t / SEQ, s = t % SEQ;
    float cs[16], sn[16];
#pragma unroll
    for (int i = 0; i < 16; ++i) sincos_rev((double)s * c_invrev[i], sn[i], cs[i]);
    const size_t orow = ((size_t)(b * NH + h) * SEQ + s);
    {
        float q[96]; float ss = 0.f;
#pragma unroll
        for (int i = 0; i < 96; ++i) { q[i] = qraw[(size_t)t * 768 + h * 96 + i]; ss += q[i] * q[i]; }
        const float r = rsqrtf(ss * (1.f / 96.f) + EPS);
#pragma unroll
        for (int i = 0; i < 96; ++i) q[i] = q[i] * r * gq[i];
#pragma unroll
        for (int i = 0; i < 16; ++i) { const float x1 = q[64 + i], x2 = q[80 + i]; q[64 + i] = x1 * cs[i] - x2 * sn[i]; q[80 + i] = x2 * cs[i] + x1 * sn[i]; }
#pragma unroll
        for (int i = 0; i < 96; ++i) Qn[orow * 96 + i] = (bf16_t)f2bf(q[i] * QSCALE);
    }
    {
        float k[96]; float ss = 0.f;
#pragma unroll
        for (int i = 0; i < 64; ++i) { k[i] = kvraw[(size_t)t * 1024 + h * 128 + i]; ss += k[i] * k[i]; }
#pragma unroll
        for (int i = 0; i < 32; ++i) { k[64 + i] = krope[(size_t)t * 32 + i]; ss += k[64 + i] * k[64 + i]; }
        const float r = rsqrtf(ss * (1.f / 96.f) + EPS);
#pragma unroll
        for (int i = 0; i < 96; ++i) k[i] = k[i] * r * gk[i];
#pragma unroll
        for (int i = 0; i < 16; ++i) { const float x1 = k[64 + i], x2 = k[80 + i]; k[64 + i] = x1 * cs[i] - x2 * sn[i]; k[80 + i] = x2 * cs[i] + x1 * sn[i]; }
#pragma unroll
        for (int i = 0; i < 96; ++i) Kn[orow * 96 + i] = (bf16_t)f2bf(k[i]);
#pragma unroll
        for (int i = 0; i < 64; ++i) Vn[orow * 64 + i] = (bf16_t)f2bf(kvraw[(size_t)t * 1024 + h * 128 + 64 + i]);
    }
}

__global__ void __launch_bounds__(256) k_attn(const bf16_t* __restrict__ Qn, const bf16_t* __restrict__ Kn, const bf16_t* __restrict__ Vn, bf16_t* __restrict__ att) {
    const int id = blockIdx.x * 256 + threadIdx.x;
    const int bh = id / SEQ, qi = id % SEQ;
    const int qmax = __builtin_amdgcn_readfirstlane(qi | 63);
    float q[96];
    {
        const u32x4* qp = (const u32x4*)(Qn + (size_t)id * 96);
#pragma unroll
        for (int i = 0; i < 12; ++i) { const u32x4 w = qp[i];
#pragma unroll
            for (int j = 0; j < 4; ++j) { q[i * 8 + 2 * j] = bf2f(w[j] & 0xffffu); q[i * 8 + 2 * j + 1] = bf2f(w[j] >> 16); } }
    }
    float o[64];
#pragma unroll
    for (int i = 0; i < 64; ++i) o[i] = 0.f;
    float m = -1e30f, l = 0.f;
    const bf16_t* kb = Kn + (size_t)bh * SEQ * 96; const bf16_t* vb = Vn + (size_t)bh * SEQ * 64;
    for (int j = 0; j <= qmax; ++j) {
        const u32x4* kp = (const u32x4*)(kb + (size_t)j * 96);
        float s = 0.f;
#pragma unroll
        for (int i = 0; i < 12; ++i) { const u32x4 w = kp[i];
#pragma unroll
            for (int jj = 0; jj < 4; ++jj) { s += q[i * 8 + 2 * jj] * bf2f(w[jj] & 0xffffu); s += q[i * 8 + 2 * jj + 1] * bf2f(w[jj] >> 16); } }
        if (j <= qi) {
            const float mn = fmaxf(m, s);
            const float al = exp2f(m - mn), p = exp2f(s - mn);
            l = l * al + p; m = mn;
            const u32x4* vp = (const u32x4*)(vb + (size_t)j * 64);
#pragma unroll
            for (int i = 0; i < 8; ++i) { const u32x4 w = vp[i];
#pragma unroll
                for (int jj = 0; jj < 4; ++jj) { o[i * 8 + 2 * jj] = o[i * 8 + 2 * jj] * al + p * bf2f(w[jj] & 0xffffu); o[i * 8 + 2 * jj + 1] = o[i * 8 + 2 * jj + 1] * al + p * bf2f(w[jj] >> 16); } }
        }
    }
    const float rl = 1.f / l;
    const int b = bh / NH, h = bh % NH;
    bf16_t* op = att + ((size_t)(b * SEQ + qi)) * 512 + h * 64;
#pragma unroll
    for (int i = 0; i < 64; ++i) op[i] = (bf16_t)f2bf(o[i] * rl);
}

__global__ void __launch_bounds__(64) k_s5(const bf16_t* __restrict__ U, const float* __restrict__ lam_re, const float* __restrict__ lam_im, const float* __restrict__ log_step,
                                           const float* __restrict__ b_re, const float* __restrict__ b_im, const float* __restrict__ c_re, const float* __restrict__ c_im,
                                           const float* __restrict__ dsk, bf16_t* __restrict__ YG) {
    const int b = blockIdx.x / S5G, g = blockIdx.x % S5G, p = threadIdx.x;
    const float lre = lam_re[g * 64 + p], lim = lam_im[g * 64 + p], st = __expf(log_step[g]);
    const float mag = __expf(lre * st);
    float sn, cs; sincos_rev((double)lim * (double)st * 0.15915494309189535, sn, cs);
    const float lbr = mag * cs, lbi = mag * sn;
    const float nr = lbr - 1.f, ni = lbi, den = 1.f / (lre * lre + lim * lim);
    const float cr = (nr * lre + ni * lim) * den, ci = (ni * lre - nr * lim) * den;
    float Br[16], Bi[16], Cr[16], Ci[16];
#pragma unroll
    for (int c = 0; c < 16; ++c) {
        const float br = b_re[(g * 64 + p) * 16 + c], bi = b_im[(g * 64 + p) * 16 + c];
        Br[c] = cr * br - ci * bi; Bi[c] = cr * bi + ci * br;
        Cr[c] = c_re[(g * 16 + c) * 64 + p]; Ci[c] = c_im[(g * 16 + c) * 64 + p];
    }
    const float dk = dsk[g * 16 + (p & 15)];
    float xr = 0.f, xi = 0.f;
    const bf16_t* up = U + (size_t)b * SEQ * 512 + g * 16;
    bf16_t* yp = YG + (size_t)b * SEQ * 512 + g * 16;
#pragma unroll 2
    for (int t = 0; t < SEQ; ++t) {
        const u32x4 w0 = *(const u32x4*)(up + (size_t)t * 512), w1 = *(const u32x4*)(up + (size_t)t * 512 + 8);
        float u[16];
#pragma unroll
        for (int j = 0; j < 4; ++j) { u[2 * j] = bf2f(w0[j] & 0xffffu); u[2 * j + 1] = bf2f(w0[j] >> 16); u[8 + 2 * j] = bf2f(w1[j] & 0xffffu); u[8 + 2 * j + 1] = bf2f(w1[j] >> 16); }
        float br = 0.f, bi = 0.f;
#pragma unroll
        for (int c = 0; c < 16; ++c) { br += Br[c] * u[c]; bi += Bi[c] * u[c]; }
        const float nxr = lbr * xr - lbi * xi + br, nxi = lbr * xi + lbi * xr + bi;
        xr = nxr; xi = nxi;
        float mine = 0.f, um = 0.f;
#pragma unroll
        for (int c = 0; c < 16; ++c) {
            const float y = wave_sum(Cr[c] * xr - Ci[c] * xi);
            if ((p & 15) == c) { mine = y; um = u[c]; }
        }
        if (p < 16) yp[(size_t)t * 512 + p] = (bf16_t)f2bf(gelu_tanh(mine + dk * um));
    }
}

__global__ void __launch_bounds__(256) k_router(const float* __restrict__ x, const float* __restrict__ g, const float* __restrict__ rw, const float* __restrict__ rb, int* __restrict__ tope, float* __restrict__ topw) {
    const int lane = threadIdx.x & 63; const int t = blockIdx.x * 4 + (threadIdx.x >> 6);
    const float* xr = x + (size_t)t * D;
    float h[16]; float s = 0.f;
#pragma unroll
    for (int j = 0; j < 16; ++j) { h[j] = xr[lane + 64 * j]; s += h[j] * h[j]; }
    const float r = rsqrtf(wave_sum(s) * (1.f / D) + EPS);
    float lg[8];
#pragma unroll
    for (int e = 0; e < 8; ++e) lg[e] = 0.f;
#pragma unroll
    for (int j = 0; j < 16; ++j) { const int k = lane + 64 * j; const float hv = h[j] * r * g[k];
#pragma unroll
        for (int e = 0; e < 8; ++e) lg[e] += hv * rw[k * 8 + e]; }
#pragma unroll
    for (int e = 0; e < 8; ++e) lg[e] = wave_sum(lg[e]) + rb[e];
    int e0 = 0; float v0 = lg[0];
#pragma unroll
    for (int e = 1; e < 8; ++e) if (lg[e] > v0) { v0 = lg[e]; e0 = e; }
    int e1 = -1; float v1 = -3.0e38f;
#pragma unroll
    for (int e = 0; e < 8; ++e) if (e != e0 && lg[e] > v1) { v1 = lg[e]; e1 = e; }
    if (lane == 0) { const float w1 = 1.f / (1.f + __expf(v0 - v1)); tope[t * 2] = e0; tope[t * 2 + 1] = e1; topw[t * 2] = 1.f - w1; topw[t * 2 + 1] = w1; }
}
__global__ void __launch_bounds__(1024) k_route_build(const int* __restrict__ tope, int* __restrict__ rowtok, int* __restrict__ pos, int* __restrict__ tile32e) {
    __shared__ int wcnt[16][8]; __shared__ int base[8]; __shared__ int segoff[9];
    const int tid = threadIdx.x, lane = tid & 63, wv = tid >> 6;
    for (int r = tid; r < RCAP; r += 1024) rowtok[r] = -1;
    if (tid < 8) base[tid] = 0;
    __syncthreads();
    for (int c0 = 0; c0 < T; c0 += 1024) {
        const int t = c0 + tid; const int e0 = tope[t * 2], e1 = tope[t * 2 + 1];
        for (int e = 0; e < 8; ++e) { const unsigned long long m = __ballot(e0 == e || e1 == e); if (lane == 0) wcnt[wv][e] = __popcll(m); }
        __syncthreads();
        if (tid < 8) { int s = 0; for (int w = 0; w < 16; ++w) s += wcnt[w][tid]; base[tid] += s; }
        __syncthreads();
    }
    if (tid == 0) { int o = 0; for (int e = 0; e < 8; ++e) { segoff[e] = o; o += (base[e] + 255) & ~255; } segoff[8] = o; }
    __syncthreads();
    for (int i = tid; i < RCAP / 32; i += 1024) { int e = -1; for (int k = 0; k < 8; ++k) if (i * 32 >= segoff[k] && i * 32 < segoff[k + 1]) e = k; tile32e[i] = e; }
    __syncthreads();
    if (tid < 8) base[tid] = segoff[tid];
    __syncthreads();
    for (int c0 = 0; c0 < T; c0 += 1024) {
        const int t = c0 + tid; const int e0 = tope[t * 2], e1 = tope[t * 2 + 1];
        int rank0 = 0, rank1 = 0;
        for (int e = 0; e < 8; ++e) { const bool f = (e0 == e || e1 == e); const unsigned long long m = __ballot(f);
            const int pre = __popcll(m & ((1ull << lane) - 1ull)); if (lane == 0) wcnt[wv][e] = __popcll(m);
            if (e0 == e) rank0 = pre; if (e1 == e) rank1 = pre; }
        __syncthreads();
        { int off = base[e0]; for (int w = 0; w < wv; ++w) off += wcnt[w][e0]; const int r = off + rank0; pos[t * 2] = r; rowtok[r] = t; }
        { int off = base[e1]; for (int w = 0; w < wv; ++w) off += wcnt[w][e1]; const int r = off + rank1; pos[t * 2 + 1] = r; rowtok[r] = t; }
        __syncthreads();
        if (tid < 8) { int s = 0; for (int w = 0; w < 16; ++w) s += wcnt[w][tid]; base[tid] += s; }
        __syncthreads();
    }
}
__global__ void __launch_bounds__(256) k_moe_combine(float* __restrict__ x, const float* __restrict__ Y, const int* __restrict__ pos, const float* __restrict__ topw) {
    const int t = blockIdx.x; const int c = threadIdx.x * 4;
    const int p0 = pos[t * 2], p1 = pos[t * 2 + 1]; const float w0 = topw[t * 2], w1 = topw[t * 2 + 1];
    f32x4 xv = *(f32x4*)(x + (size_t)t * D + c); const f32x4 y0 = *(const f32x4*)(Y + (size_t)p0 * D + c), y1 = *(const f32x4*)(Y + (size_t)p1 * D + c);
    xv = xv + y0 * w0 + y1 * w1; *(f32x4*)(x + (size_t)t * D + c) = xv;
}

template <bool DUAL, class Epi>
static void sgemm(hipStream_t st, const bf16_t* A, int lda, const int* arow, const int* texp, size_t wstride, const float* W, const float* W2, int ldw, int M, int N, int K, Epi E) {
    const long nt = (long)(M / 32) * (N / 32);
    k_sgemm<DUAL, Epi><<<dim3((unsigned)((nt + 3) / 4)), dim3(256), 0, st>>>(A, lda, arow, texp, wstride, W, W2, ldw, M, N, K, E);
}

extern "C" void kernel_launch(void* const* d_in, const int* in_sizes, int n_in, void* d_out, int out_size, void* d_ws, size_t ws_size, hipStream_t stream) {
    if (n_in != 32 || out_size != T * D) { fprintf(stderr, "kernel_launch: unexpected inputs\n"); return; }
    const size_t MiB = 1u << 20;
    if (ws_size < 472 * MiB) { fprintf(stderr, "kernel_launch: workspace too small: %zu\n", ws_size); return; }
    auto F = [&](int i) { return (const float*)d_in[i]; };
    unsigned char* ws = (unsigned char*)d_ws;
    float* X = (float*)d_out;
    bf16_t* XN = (bf16_t*)(ws + 1 * MiB);
    float* QLAT = (float*)(ws + 33 * MiB); float* KVLAT = (float*)(ws + 49 * MiB); float* KROPE = (float*)(ws + 57 * MiB);
    bf16_t* U = (bf16_t*)(ws + 59 * MiB); bf16_t* GA = (bf16_t*)(ws + 75 * MiB); bf16_t* GB = (bf16_t*)(ws + 107 * MiB);
    bf16_t* QN = (bf16_t*)(ws + 139 * MiB); bf16_t* KVN = (bf16_t*)(ws + 147 * MiB);
    float* QRAW = (float*)(ws + 151 * MiB); float* KVRAW = (float*)(ws + 199 * MiB);
    bf16_t* Qn = (bf16_t*)(ws + 263 * MiB); bf16_t* Kn = (bf16_t*)(ws + 287 * MiB); bf16_t* Vn = (bf16_t*)(ws + 311 * MiB);
    bf16_t* ATT = (bf16_t*)(ws + 327 * MiB); bf16_t* YG = (bf16_t*)(ws + 343 * MiB); bf16_t* SSM = (bf16_t*)(ws + 359 * MiB);
    float* TMP = (float*)(ws + 375 * MiB); bf16_t* MIX = (bf16_t*)(ws + 439 * MiB);
    bf16_t* HD = (bf16_t*)(ws + 33 * MiB);
    int* TOPE = (int*)(ws + 33 * MiB); float* TOPW = (float*)(ws + 34 * MiB); int* POS = (int*)(ws + 35 * MiB); int* ROWTOK = (int*)(ws + 36 * MiB); int* TILE32E = (int*)(ws + 37 * MiB);
    bf16_t* H1 = (bf16_t*)(ws + 40 * MiB); float* Y = (float*)(ws + 280 * MiB);

    for (int l = 0; l < DEPTH; ++l) {
        const float* xin = (l == 0) ? F(0) : X;
        k_rms1024<<<T / 4, 256, 0, stream>>>(xin, F(1) + l * D, XN, T);
        sgemm<false>(stream, XN, D, nullptr, nullptr, 0, F(2) + (size_t)l * D * INC, nullptr, INC, T, INC, D, EpiProj{F(3) + l * INC, QLAT, KVLAT, KROPE, U, GA, GB});
        k_rms_small<256><<<T / 4, 256, 0, stream>>>(QLAT, F(4) + l * QLR, QN, T);
        k_rms_small<128><<<T / 4, 256, 0, stream>>>(KVLAT, F(6) + l * KVLR, KVN, T);
        sgemm<false>(stream, QN, QLR, nullptr, nullptr, 0, F(5) + (size_t)l * QLR * 768, nullptr, 768, T, 768, QLR, EpiF32{QRAW, 768});
        sgemm<false>(stream, KVN, KVLR, nullptr, nullptr, 0, F(7) + (size_t)l * KVLR * 1024, nullptr, 1024, T, 1024, KVLR, EpiF32{KVRAW, 1024});
        k_heads<<<T * NH / 256, 256, 0, stream>>>(QRAW, KVRAW, KROPE, F(8) + l * QKD, F(9) + l * QKD, Qn, Kn, Vn);
        k_attn<<<BATCH * NH * SEQ / 256, 256, 0, stream>>>(Qn, Kn, Vn, ATT);
        k_s5<<<BATCH * S5G, 64, 0, stream>>>(U, F(10) + l * 2048, F(11) + l * 2048, F(12) + l * 32, F(13) + (size_t)l * 32768, F(14) + (size_t)l * 32768, F(15) + (size_t)l * 32768, F(16) + (size_t)l * 32768, F(17) + l * 512, YG);
        sgemm<false>(stream, YG, 512, nullptr, nullptr, 0, F(18) + (size_t)l * 512 * 512, nullptr, 512, T, 512, 512, EpiGlu{YG, F(19) + l * 512, SSM});
        sgemm<false>(stream, ATT, 512, nullptr, nullptr, 0, F(20) + (size_t)l * 512 * 1024, nullptr, 1024, T, 1024, 512, EpiMixA{GA, TMP});
        sgemm<false>(stream, SSM, 512, nullptr, nullptr, 0, F(21) + (size_t)l * 512 * 1024, nullptr, 1024, T, 1024, 512, EpiMixB{GB, TMP, MIX});
        sgemm<false>(stream, MIX, D, nullptr, nullptr, 0, F(22) + (size_t)l * D * D, nullptr, D, T, D, D, EpiResid{xin, X});
        k_rms1024<<<T / 4, 256, 0, stream>>>(X, F(23) + l * D, XN, T);
        if (l % 2 == 0) {
            const int j = l / 2;
            sgemm<true>(stream, XN, D, nullptr, nullptr, 0, F(24) + (size_t)j * D * FFD, F(25) + (size_t)j * D * FFD, FFD, T, FFD, D, EpiSwiglu{HD, FFD});
            sgemm<false>(stream, HD, FFD, nullptr, nullptr, 0, F(26) + (size_t)j * FFD * D, nullptr, D, T, D, FFD, EpiResid{X, X});
        } else {
            const int j = l / 2;
            k_router<<<T / 4, 256, 0, stream>>>(X, F(23) + l * D, F(27) + (size_t)j * D * NE, F(28) + j * NE, TOPE, TOPW);
            k_route_build<<<1, 1024, 0, stream>>>(TOPE, ROWTOK, POS, TILE32E);
            sgemm<true>(stream, XN, D, ROWTOK, TILE32E, (size_t)D * FFE, F(29) + (size_t)j * NE * D * FFE, F(30) + (size_t)j * NE * D * FFE, FFE, RCAP, FFE, D, EpiSwiglu{H1, FFE});
            sgemm<false>(stream, H1, FFE, nullptr, TILE32E, (size_t)FFE * D, F(31) + (size_t)j * NE * FFE * D, nullptr, D, RCAP, D, FFE, EpiF32{Y, D});
            k_moe_combine<<<T, 256, 0, stream>>>(X, Y, POS, TOPW);
        }
    }
}
```

```cpp
#include <hip/hip_runtime.h>
#include <cstdio>
#include <cstdint>

typedef unsigned short bf16_t;
typedef short bf16x8 __attribute__((ext_vector_type(8)));
typedef float f32x4 __attribute__((ext_vector_type(4)));
typedef unsigned u32x4 __attribute__((ext_vector_type(4)));
#define LAS __attribute__((address_space(3)))
#define GAS __attribute__((address_space(1)))

constexpr int D = 1024, BATCH = 2, SEQ = 8192, T = BATCH * SEQ, DEPTH = 2;
constexpr int NH = 8, QKD = 96, QLR = 256, KVLR = 128;
constexpr int S5G = 32;
constexpr int FFD = 2816, NE = 8, FFE = 3584, INC = 2976;
constexpr int RCAP = 34816;
constexpr float EPS = 1e-6f;
constexpr float QSCALE = 0.14724444602590306f;
constexpr int NWAVES = 8, NTHREADS = 512;
constexpr int LDS_BYTES = 147456;
constexpr int LDSCTL_OFF = 131072;
constexpr size_t MiB = 1u << 20;

__device__ __forceinline__ unsigned f2bf(float f) { unsigned u = __builtin_bit_cast(unsigned, f); return (u + 0x7fffu + ((u >> 16) & 1u)) >> 16; }
__device__ __forceinline__ float bf2f(unsigned h) { return __builtin_bit_cast(float, h << 16); }
__device__ __forceinline__ float bflo(unsigned w) { return __builtin_bit_cast(float, w << 16); }
__device__ __forceinline__ float bfhi(unsigned w) { return __builtin_bit_cast(float, w & 0xffff0000u); }
__device__ __forceinline__ float wave_sum(float v) {
#pragma unroll
    for (int o = 1; o < 64; o <<= 1) v += __shfl_xor(v, o);
    return v;
}
__device__ __forceinline__ float sigmoidf_(float v) { return 1.f / (1.f + __expf(-v)); }
__device__ __forceinline__ float siluf_(float v) { return v / (1.f + __expf(-v)); }
__device__ __forceinline__ float gelu_tanh(float v) {
    const float z = 0.7978845608028654f * (v + 0.044715f * v * v * v);
    const float e = __expf(2.f * z);
    const float th = 1.f - 2.f / (e + 1.f);
    return 0.5f * v * (1.f + th);
}
__device__ __forceinline__ void sincos_rev(double rev, float& s, float& c) {
    const double fr = rev - floor(rev);
    const float f = (float)fr;
    s = __builtin_amdgcn_sinf(f); c = __builtin_amdgcn_cosf(f);
}
__constant__ double c_invrev[16] = {0.15915494309189535, 0.08949940160889101, 0.050329212104487035, 0.0283021958306234, 0.015915494309189534, 0.008949940160889102,
    0.005032921210448704, 0.00283021958306234, 0.0015915494309189536, 0.0008949940160889102, 0.0005032921210448703, 0.00028302195830623395, 0.00015915494309189535,
    8.949940160889102e-05, 5.0329212104487035e-05, 2.8302195830623396e-05};

#define XB_TMO      128
#define XB_XCNT(j)  (256  + 64 * (j))
#define XB_XSUB(j)  (1280 + 64 * (j))
#define XB_XGEN(j)  (2304 + 64 * (j))
#define XB_TOP      3328
#define XB_TOPGEN   3392
#define XCD_BAR_WORDS 3456
#define XB_SPIN_CAP (1u << 18)

__device__ __forceinline__ unsigned xb_ld(unsigned* p)              { return __hip_atomic_load(p, __ATOMIC_RELAXED, __HIP_MEMORY_SCOPE_AGENT); }
__device__ __forceinline__ unsigned xb_add(unsigned* p, unsigned v) { return __hip_atomic_fetch_add(p, v, __ATOMIC_RELAXED, __HIP_MEMORY_SCOPE_AGENT); }
__device__ __forceinline__ unsigned xb_xcc_id() { return (unsigned)__builtin_amdgcn_s_getreg((3 << 11) | 20) & 0xFu; }
#define XB_SPIN(cond, bar) do { unsigned _sp = 0; while (cond) { __builtin_amdgcn_s_sleep(1); \
    if ((++_sp & 255u) == 0u) { if (xb_ld(&(bar)[XB_TMO])) break; if (_sp > XB_SPIN_CAP) { atomicAdd(&(bar)[XB_TMO], 1u); break; } } } } while (0)

struct XcdBarrier {
    unsigned* bar; unsigned x;
    volatile LAS unsigned* st;
};

__device__ __forceinline__ XcdBarrier xcd_barrier_post(unsigned* bar, volatile LAS unsigned* st) {
    XcdBarrier b; b.bar = bar; b.x = xb_xcc_id(); b.st = st;
    if (threadIdx.x == 0) (void)xb_add(&bar[XB_XCNT(b.x)], 1u);
    return b;
}
__device__ __forceinline__ void xcd_barrier_complete(unsigned* bar, unsigned x, unsigned& nloc, unsigned& nx) {
    const unsigned G = gridDim.x * gridDim.y * gridDim.z;
    unsigned sum, cnt, mine, sp = 0u;
    for (;;) {
        sum = 0u; cnt = 0u; mine = 0u;
#pragma unroll
        for (unsigned j = 0; j < 16; ++j) { const unsigned c = xb_ld(&bar[XB_XCNT(j)]); sum += c; cnt += (c > 0u) ? 1u : 0u; mine = (j == x) ? c : mine; }
        if (sum == G) break;
        __builtin_amdgcn_s_sleep(1);
        if ((++sp & 255u) == 0u) { if (xb_ld(&bar[XB_TMO])) break; if (sp > XB_SPIN_CAP) { atomicAdd(&bar[XB_TMO], 1u); break; } }
    }
    nloc = mine > 0u ? mine : 1u; nx = cnt > 0u ? cnt : 1u;
}

__device__ __forceinline__ void xcd_barrier(const XcdBarrier& b) {
    asm volatile("s_waitcnt vmcnt(0)" ::: "memory");
    __syncthreads();
    if (threadIdx.x == 0) {
        unsigned* bar = b.bar;
        __builtin_amdgcn_s_waitcnt(0);
        unsigned nloc = b.st[0], nx = b.st[1];
        if (nloc == 0u) { xcd_barrier_complete(bar, b.x, nloc, nx); b.st[0] = nloc; b.st[1] = nx; }
        const unsigned old = xb_add(&bar[XB_XSUB(b.x)], 1u);
        const unsigned gen = old / nloc;
        if (old + 1u == (gen + 1u) * nloc) {
            __builtin_amdgcn_fence(__ATOMIC_RELEASE, "agent");
            asm volatile("s_waitcnt vmcnt(0)" ::: "memory");
            const unsigned og = xb_add(&bar[XB_TOP], 1u);
            const unsigned tg = og / nx;
            if (og + 1u == (tg + 1u) * nx) xb_add(&bar[XB_TOPGEN], 1u);
            else XB_SPIN(xb_ld(&bar[XB_TOPGEN]) == tg, bar);
            __builtin_amdgcn_fence(__ATOMIC_ACQUIRE, "agent");
            xb_add(&bar[XB_XGEN(b.x)], 1u);
            asm volatile("s_waitcnt vmcnt(0)" ::: "memory");
        } else {
            XB_SPIN(xb_ld(&bar[XB_XGEN(b.x)]) == gen, bar);
            __builtin_amdgcn_fence(__ATOMIC_ACQUIRE, "agent");
            asm volatile("s_waitcnt vmcnt(0)" ::: "memory");
        }
    }
    __syncthreads();
}
struct Ctx { int tid, lane, wave, G, gw, NGW; LAS unsigned char* lds; };

__device__ __forceinline__ void s_rms1024(const Ctx& c, const float* __restrict__ x, const float* __restrict__ g, bf16_t* __restrict__ out) {
    for (int row = c.gw; row < T; row += c.NGW) {
        const f32x4* xr = (const f32x4*)(x + (size_t)row * D) + c.lane;
        f32x4 v[4]; float s = 0.f;
#pragma unroll
        for (int j = 0; j < 4; ++j) { v[j] = xr[64 * j]; s += v[j].x * v[j].x + v[j].y * v[j].y + v[j].z * v[j].z + v[j].w * v[j].w; }
        const float r = rsqrtf(wave_sum(s) * (1.f / D) + EPS);
#pragma unroll
        for (int j = 0; j < 4; ++j) {
            const f32x4 gg = *((const f32x4*)g + c.lane + 64 * j);
            const unsigned lo = f2bf(v[j].x * r * gg.x) | (f2bf(v[j].y * r * gg.y) << 16), hi = f2bf(v[j].z * r * gg.z) | (f2bf(v[j].w * r * gg.w) << 16);
            *((uint2*)(out + (size_t)row * D) + c.lane + 64 * j) = make_uint2(lo, hi);
        }
    }
}
template <int W>
__device__ __forceinline__ void s_rms_small(const Ctx& c, const float* __restrict__ x, const float* __restrict__ g, bf16_t* __restrict__ out) {
    for (int row = c.gw; row < T; row += c.NGW) {
        float v[W / 64]; float s = 0.f;
#pragma unroll
        for (int j = 0; j < W / 64; ++j) { v[j] = x[(size_t)row * W + c.lane + 64 * j]; s += v[j] * v[j]; }
        const float r = rsqrtf(wave_sum(s) * (1.f / W) + EPS);
#pragma unroll
        for (int j = 0; j < W / 64; ++j) out[(size_t)row * W + c.lane + 64 * j] = (bf16_t)f2bf(v[j] * r * g[c.lane + 64 * j]);
    }
}
template <bool DUAL, class Epi>
__device__ __forceinline__ void s_gemm(const Ctx& c, const bf16_t* __restrict__ A, int lda, const int* __restrict__ arow, const int* __restrict__ texp, size_t wstride,
                                       const float* __restrict__ W0, const float* __restrict__ W20, int ldw, int M, int N, int K, const Epi& E) {
    const int lane = c.lane, ntn = N >> 5; const long nt = (long)(M >> 5) * ntn;
    const int r16 = lane & 15, q = lane >> 4;
    for (long wv = c.gw; wv < nt; wv += c.NGW) {
        const int tm = (int)(wv / ntn), tn = (int)(wv % ntn);
        const float* W = W0; const float* W2 = W20;
        if (texp) { const int e = texp[tm]; if (e < 0) continue; W += (size_t)e * wstride; if (DUAL) W2 += (size_t)e * wstride; }
        f32x4 acc[2][2], acc2[2][2];
#pragma unroll
        for (int i = 0; i < 2; ++i)
#pragma unroll
            for (int j = 0; j < 2; ++j) { acc[i][j] = (f32x4){0.f, 0.f, 0.f, 0.f}; acc2[i][j] = (f32x4){0.f, 0.f, 0.f, 0.f}; }
        const bf16_t* ap[2]; bool av[2];
#pragma unroll
        for (int i = 0; i < 2; ++i) { const int r = tm * 32 + i * 16 + r16; const int rr = arow ? arow[r] : r; av[i] = rr >= 0; ap[i] = A + (size_t)(av[i] ? rr : 0) * lda + q * 8; }
        const size_t woff = (size_t)(q * 8) * ldw + tn * 32 + r16;
        for (int k0 = 0; k0 < K; k0 += 32) {
            bf16x8 a[2], b[2], b2[2];
#pragma unroll
            for (int i = 0; i < 2; ++i) { a[i] = (bf16x8){0, 0, 0, 0, 0, 0, 0, 0}; if (av[i]) a[i] = *(const bf16x8*)(ap[i] + k0); }
#pragma unroll
            for (int jn = 0; jn < 2; ++jn)
#pragma unroll
                for (int j = 0; j < 8; ++j) {
                    b[jn][j] = (short)f2bf(W[woff + (size_t)(k0 + j) * ldw + jn * 16]);
                    if (DUAL) b2[jn][j] = (short)f2bf(W2[woff + (size_t)(k0 + j) * ldw + jn * 16]);
                }
#pragma unroll
            for (int i = 0; i < 2; ++i)
#pragma unroll
                for (int jn = 0; jn < 2; ++jn) {
                    acc[i][jn] = __builtin_amdgcn_mfma_f32_16x16x32_bf16(a[i], b[jn], acc[i][jn], 0, 0, 0);
                    if (DUAL) acc2[i][jn] = __builtin_amdgcn_mfma_f32_16x16x32_bf16(a[i], b2[jn], acc2[i][jn], 0, 0, 0);
                }
        }
#pragma unroll
        for (int i = 0; i < 2; ++i)
#pragma unroll
            for (int jn = 0; jn < 2; ++jn)
#pragma unroll
                for (int j = 0; j < 4; ++j) E(tm * 32 + i * 16 + q * 4 + j, tn * 32 + jn * 16 + r16, acc[i][jn][j], acc2[i][jn][j]);
    }
}
struct EpiProj {
    const float* b; float* qlat; float* kvlat; float* krope; bf16_t* u; bf16_t* ga; bf16_t* gb;
    __device__ __forceinline__ void operator()(int r, int c, float v, float) const {
        v += b[c];
        if (c < 256) qlat[(size_t)r * 256 + c] = v;
        else if (c < 384) kvlat[(size_t)r * 128 + (c - 256)] = v;
        else if (c < 416) krope[(size_t)r * 32 + (c - 384)] = v;
        else if (c < 928) u[(size_t)r * 512 + (c - 416)] = (bf16_t)f2bf(v);
        else if (c < 1952) ga[(size_t)r * 1024 + (c - 928)] = (bf16_t)f2bf(sigmoidf_(v));
        else gb[(size_t)r * 1024 + (c - 1952)] = (bf16_t)f2bf(sigmoidf_(v));
    }
};
struct EpiF32 { float* C; int ldc; __device__ __forceinline__ void operator()(int r, int c, float v, float) const { C[(size_t)r * ldc + c] = v; } };
struct EpiGlu { const bf16_t* yg; const float* b; bf16_t* out;
    __device__ __forceinline__ void operator()(int r, int c, float v, float) const { const float y = bf2f(yg[(size_t)r * 512 + c]); out[(size_t)r * 512 + c] = (bf16_t)f2bf(y * sigmoidf_(v + b[c])); } };
struct EpiMixA { const bf16_t* ga; float* tmp; __device__ __forceinline__ void operator()(int r, int c, float v, float) const { tmp[(size_t)r * 1024 + c] = bf2f(ga[(size_t)r * 1024 + c]) * v; } };
struct EpiMixB { const bf16_t* gb; const float* tmp; bf16_t* mix;
    __device__ __forceinline__ void operator()(int r, int c, float v, float) const { mix[(size_t)r * 1024 + c] = (bf16_t)f2bf(tmp[(size_t)r * 1024 + c] + bf2f(gb[(size_t)r * 1024 + c]) * v); } };
struct EpiResid { const float* xin; float* xout; __device__ __forceinline__ void operator()(int r, int c, float v, float) const { xout[(size_t)r * 1024 + c] = xin[(size_t)r * 1024 + c] + v; } };
struct EpiSwiglu { bf16_t* h; int ldh; __device__ __forceinline__ void operator()(int r, int c, float vg, float vu) const { h[(size_t)r * ldh + c] = (bf16_t)f2bf(siluf_(vg) * vu); } };

__device__ __forceinline__ void s_heads(const Ctx& c, const float* __restrict__ qraw, const float* __restrict__ kvraw, const float* __restrict__ krope, const float* __restrict__ gq, const float* __restrict__ gk,
                                        bf16_t* __restrict__ Qn, bf16_t* __restrict__ Kn, bf16_t* __restrict__ Vn) {
    const int lane = c.lane;
    for (int id = c.gw; id < T * NH * 2; id += c.NGW) {
        const int which = id & 1, h = (id >> 1) & 7, t = id >> 4;
        const int b = t / SEQ, s = t % SEQ;
        const size_t orow = ((size_t)(b * NH + h) * SEQ + s);
        float v0, v1 = 0.f;
        if (which == 0) { v0 = qraw[(size_t)t * 768 + h * 96 + lane]; if (lane < 32) v1 = qraw[(size_t)t * 768 + h * 96 + 64 + lane]; }
        else { v0 = kvraw[(size_t)t * 1024 + h * 128 + lane]; if (lane < 32) v1 = krope[(size_t)t * 32 + lane]; }
        const float ss = wave_sum(v0 * v0 + v1 * v1);
        const float r = rsqrtf(ss * (1.f / 96.f) + EPS) * (which == 0 ? QSCALE : 1.f);
        const float* gg = which == 0 ? gq : gk;
        v0 = v0 * r * gg[lane]; if (lane < 32) v1 = v1 * r * gg[64 + lane];
        const float partner = __shfl_xor(v1, 16);
        float sn, cs; sincos_rev((double)s * c_invrev[lane & 15], sn, cs);
        const float rot = (lane < 16) ? (v1 * cs - partner * sn) : (v1 * cs + partner * sn);
        bf16_t* op = (which == 0 ? Qn : Kn) + orow * 96;
        op[lane] = (bf16_t)f2bf(v0);
        if (lane < 32) op[64 + lane] = (bf16_t)f2bf(rot);
        if (which == 1) Vn[orow * 64 + lane] = (bf16_t)f2bf(kvraw[(size_t)t * 1024 + h * 128 + 64 + lane]);
    }
}
__device__ __forceinline__ void s_attn(const Ctx& c, int aw, int NAW, const bf16_t* __restrict__ Qn, const bf16_t* __restrict__ Kn, const bf16_t* __restrict__ Vn, bf16_t* __restrict__ att) {
    for (int base2 = aw * 64; base2 < 2 * BATCH * NH * SEQ; base2 += NAW * 64) {
        const int half = base2 & 64 ? 1 : 0;
        const int base = (base2 >> 7) * 64;
        const int id = base + c.lane;
        const int bh = base / SEQ, qi = id % SEQ;
        const int qmax = (base % SEQ) + 63;
        unsigned q[48];
        { const u32x4* qp = (const u32x4*)(Qn + (size_t)id * 96);
#pragma unroll
          for (int i = 0; i < 12; ++i) { const u32x4 w = qp[i]; q[4 * i] = w[0]; q[4 * i + 1] = w[1]; q[4 * i + 2] = w[2]; q[4 * i + 3] = w[3]; } }
        float o[32];
#pragma unroll
        for (int i = 0; i < 32; ++i) o[i] = 0.f;
        float m = -1e30f, l = 0.f;
        const bf16_t* kb = Kn + (size_t)bh * SEQ * 96; const bf16_t* vb = Vn + (size_t)bh * SEQ * 64 + half * 32;
        for (int j = 0; j <= qmax; ++j) {
            const u32x4* kp = (const u32x4*)(kb + (size_t)j * 96);
            float s = 0.f;
#pragma unroll
            for (int i = 0; i < 12; ++i) { const u32x4 w = kp[i];
#pragma unroll
                for (int jj = 0; jj < 4; ++jj) { s += bflo(q[4 * i + jj]) * bflo(w[jj]); s += bfhi(q[4 * i + jj]) * bfhi(w[jj]); } }
            if (j <= qi) {
                const float mn = fmaxf(m, s);
                const float al = exp2f(m - mn), p = exp2f(s - mn);
                l = l * al + p; m = mn;
                const u32x4* vp = (const u32x4*)(vb + (size_t)j * 64);
#pragma unroll
                for (int i = 0; i < 4; ++i) { const u32x4 w = vp[i];
#pragma unroll
                    for (int jj = 0; jj < 4; ++jj) { o[i * 8 + 2 * jj] = o[i * 8 + 2 * jj] * al + p * bflo(w[jj]); o[i * 8 + 2 * jj + 1] = o[i * 8 + 2 * jj + 1] * al + p * bfhi(w[jj]); } }
            }
        }
        const float rl = 1.f / l;
        const int b = bh / NH, h = bh % NH;
        bf16_t* op = att + ((size_t)(b * SEQ + qi)) * 512 + h * 64 + half * 32;
#pragma unroll
        for (int i = 0; i < 4; ++i) { u32x4 w;
#pragma unroll
            for (int j = 0; j < 4; ++j) w[j] = f2bf(o[i * 8 + 2 * j] * rl) | (f2bf(o[i * 8 + 2 * j + 1] * rl) << 16);
            *(u32x4*)(op + i * 8) = w; }
    }
}
__device__ __forceinline__ void s_s5(const Ctx& c, const bf16_t* __restrict__ U, const float* __restrict__ lam_re, const float* __restrict__ lam_im, const float* __restrict__ log_step,
                                     const float* __restrict__ b_re, const float* __restrict__ b_im, const float* __restrict__ c_re, const float* __restrict__ c_im,
                                     const float* __restrict__ dsk, bf16_t* __restrict__ YG) {
    if (c.gw >= BATCH * S5G) return;
    const int b = c.gw / S5G, g = c.gw % S5G, p = c.lane;
    const float lre = lam_re[g * 64 + p], lim = lam_im[g * 64 + p], st = __expf(log_step[g]);
    const float mag = __expf(lre * st);
    float sn, cs; sincos_rev((double)lim * (double)st * 0.15915494309189535, sn, cs);
    const float lbr = mag * cs, lbi = mag * sn;
    const float nr = lbr - 1.f, ni = lbi, den = 1.f / (lre * lre + lim * lim);
    const float cr = (nr * lre + ni * lim) * den, ci = (ni * lre - nr * lim) * den;
    float Br[16], Bi[16], Cr[16], Ci[16];
#pragma unroll
    for (int k = 0; k < 16; ++k) {
        const float br = b_re[(g * 64 + p) * 16 + k], bi = b_im[(g * 64 + p) * 16 + k];
        Br[k] = cr * br - ci * bi; Bi[k] = cr * bi + ci * br;
        Cr[k] = c_re[(g * 16 + k) * 64 + p]; Ci[k] = c_im[(g * 16 + k) * 64 + p];
    }
    const float dk = dsk[g * 16 + (p & 15)];
    float xr = 0.f, xi = 0.f;
    const bf16_t* up = U + (size_t)b * SEQ * 512 + g * 16;
    bf16_t* yp = YG + (size_t)b * SEQ * 512 + g * 16;
#pragma unroll 2
    for (int t = 0; t < SEQ; ++t) {
        const u32x4 w0 = *(const u32x4*)(up + (size_t)t * 512), w1 = *(const u32x4*)(up + (size_t)t * 512 + 8);
        float u[16];
#pragma unroll
        for (int j = 0; j < 4; ++j) { u[2 * j] = bflo(w0[j]); u[2 * j + 1] = bfhi(w0[j]); u[8 + 2 * j] = bflo(w1[j]); u[8 + 2 * j + 1] = bfhi(w1[j]); }
        float br = 0.f, bi = 0.f;
#pragma unroll
        for (int k = 0; k < 16; ++k) { br += Br[k] * u[k]; bi += Bi[k] * u[k]; }
        const float nxr = lbr * xr - lbi * xi + br, nxi = lbr * xi + lbi * xr + bi;
        xr = nxr; xi = nxi;
        float mine = 0.f, um = 0.f;
#pragma unroll
        for (int k = 0; k < 16; ++k) {
            const float y = wave_sum(Cr[k] * xr - Ci[k] * xi);
            if ((p & 15) == k) { mine = y; um = u[k]; }
        }
        if (p < 16) yp[(size_t)t * 512 + p] = (bf16_t)f2bf(gelu_tanh(mine + dk * um));
    }
}
__device__ __forceinline__ void s_router(const Ctx& c, const float* __restrict__ x, const float* __restrict__ g, const float* __restrict__ rw, const float* __restrict__ rb, int* __restrict__ tope, float* __restrict__ topw) {
    for (int t = c.gw; t < T; t += c.NGW) {
        const float* xr = x + (size_t)t * D;
        float h[16]; float s = 0.f;
#pragma unroll
        for (int j = 0; j < 16; ++j) { h[j] = xr[c.lane + 64 * j]; s += h[j] * h[j]; }
        const float r = rsqrtf(wave_sum(s) * (1.f / D) + EPS);
        float lg[8];
#pragma unroll
        for (int e = 0; e < 8; ++e) lg[e] = 0.f;
#pragma unroll
        for (int j = 0; j < 16; ++j) { const int k = c.lane + 64 * j; const float hv = h[j] * r * g[k];
#pragma unroll
            for (int e = 0; e < 8; ++e) lg[e] += hv * rw[k * 8 + e]; }
#pragma unroll
        for (int e = 0; e < 8; ++e) lg[e] = wave_sum(lg[e]) + rb[e];
        int e0 = 0; float v0 = lg[0];
#pragma unroll
        for (int e = 1; e < 8; ++e) if (lg[e] > v0) { v0 = lg[e]; e0 = e; }
        int e1 = -1; float v1 = -3.0e38f;
#pragma unroll
        for (int e = 0; e < 8; ++e) if (e != e0 && lg[e] > v1) { v1 = lg[e]; e1 = e; }
        if (c.lane == 0) { const float w1 = 1.f / (1.f + __expf(v0 - v1)); tope[t * 2] = e0; tope[t * 2 + 1] = e1; topw[t * 2] = 1.f - w1; topw[t * 2 + 1] = w1; }
    }
}
__device__ __forceinline__ void s_route_build(const Ctx& c, const int* __restrict__ tope, int* __restrict__ rowtok, int* __restrict__ pos, int* __restrict__ tile32e) {
    for (int r = blockIdx.x * NTHREADS + c.tid; r < RCAP; r += c.G * NTHREADS) rowtok[r] = -1;
    if (blockIdx.x != 0) return;
    LAS int* wcnt = (LAS int*)(c.lds);
    LAS int* base = wcnt + 64;
    LAS int* segoff = base + 8;
    const int tid = c.tid, lane = c.lane, wv = c.wave;
    if (tid < 8) base[tid] = 0;
    __syncthreads();
    for (int c0 = 0; c0 < T; c0 += NTHREADS) {
        const int t = c0 + tid; const int e0 = tope[t * 2], e1 = tope[t * 2 + 1];
        for (int e = 0; e < 8; ++e) { const unsigned long long m = __ballot(e0 == e || e1 == e); if (lane == 0) wcnt[wv * 8 + e] = __popcll(m); }
        __syncthreads();
        if (tid < 8) { int s = 0; for (int w = 0; w < 8; ++w) s += wcnt[w * 8 + tid]; base[tid] += s; }
        __syncthreads();
    }
    if (tid == 0) { int o = 0; for (int e = 0; e < 8; ++e) { segoff[e] = o; o += (base[e] + 255) & ~255; } segoff[8] = o; }
    __syncthreads();
    for (int i = tid; i < RCAP / 32; i += NTHREADS) { int e = -1; for (int k = 0; k < 8; ++k) if (i * 32 >= segoff[k] && i * 32 < segoff[k + 1]) e = k; tile32e[i] = e; }
    __syncthreads();
    if (tid < 8) base[tid] = segoff[tid];
    __syncthreads();
    for (int c0 = 0; c0 < T; c0 += NTHREADS) {
        const int t = c0 + tid; const int e0 = tope[t * 2], e1 = tope[t * 2 + 1];
        int rank0 = 0, rank1 = 0;
        for (int e = 0; e < 8; ++e) { const bool f = (e0 == e || e1 == e); const unsigned long long m = __ballot(f);
            const int pre = __popcll(m & ((1ull << lane) - 1ull)); if (lane == 0) wcnt[wv * 8 + e] = __popcll(m);
            if (e0 == e) rank0 = pre; if (e1 == e) rank1 = pre; }
        __syncthreads();
        { int off = base[e0]; for (int w = 0; w < wv; ++w) off += wcnt[w * 8 + e0]; pos[t * 2] = off + rank0; }
        { int off = base[e1]; for (int w = 0; w < wv; ++w) off += wcnt[w * 8 + e1]; pos[t * 2 + 1] = off + rank1; }
        __syncthreads();
        if (tid < 8) { int s = 0; for (int w = 0; w < 8; ++w) s += wcnt[w * 8 + tid]; base[tid] += s; }
        __syncthreads();
    }
}
__device__ __forceinline__ void s_rowtok(const Ctx& c, const int* __restrict__ pos, int* __restrict__ rowtok) {
    for (int i = blockIdx.x * NTHREADS + c.tid; i < T * 2; i += c.G * NTHREADS) rowtok[pos[i]] = i >> 1;
}
__device__ __forceinline__ void s_moe_combine(const Ctx& c, float* __restrict__ x, const float* __restrict__ Y, const int* __restrict__ pos, const float* __restrict__ topw) {
    for (int i = blockIdx.x * NTHREADS + c.tid; i < T * 256; i += c.G * NTHREADS) {
        const int t = i >> 8, cc = (i & 255) * 4;
        const int p0 = pos[t * 2], p1 = pos[t * 2 + 1]; const float w0 = topw[t * 2], w1 = topw[t * 2 + 1];
        f32x4 xv = *(f32x4*)(x + (size_t)t * D + cc); const f32x4 y0 = *(const f32x4*)(Y + (size_t)p0 * D + cc), y1 = *(const f32x4*)(Y + (size_t)p1 * D + cc);
        xv = xv + y0 * w0 + y1 * w1; *(f32x4*)(x + (size_t)t * D + cc) = xv;
    }
}
struct Args { const float* in[32]; float* out; unsigned char* ws; int ph_lo, ph_hi; };
constexpr size_t WS_CTL = 0, CTL_ZERO_BYTES = 1 * MiB;
constexpr int CW_BAR = 4096;
constexpr size_t WS_XN = 1 * MiB, WS_QLAT = 33 * MiB, WS_KVLAT = 49 * MiB, WS_KROPE = 57 * MiB, WS_U = 59 * MiB, WS_GA = 75 * MiB, WS_GB = 107 * MiB, WS_QN = 139 * MiB, WS_KVN = 147 * MiB,
    WS_QRAW = 151 * MiB, WS_KVRAW = 199 * MiB, WS_Q = 263 * MiB, WS_K = 287 * MiB, WS_V = 311 * MiB, WS_ATT = 327 * MiB, WS_YG = 343 * MiB, WS_SSM = 359 * MiB, WS_TMP = 375 * MiB, WS_MIX = 439 * MiB;
constexpr size_t WS_HD = 33 * MiB, WS_TOPE = 33 * MiB, WS_TOPW = 34 * MiB, WS_POS = 35 * MiB, WS_ROWTOK = 36 * MiB, WS_TILE32E = 37 * MiB, WS_H1 = 40 * MiB, WS_Y = 280 * MiB, WS_END = 472 * MiB;

__global__ void __launch_bounds__(NTHREADS, 2) mk_fwd(Args a) {
    extern __shared__ __attribute__((aligned(16))) unsigned char lds_raw[];
    Ctx c0; c0.lds = (LAS unsigned char*)lds_raw;
    c0.tid = threadIdx.x; c0.lane = c0.tid & 63; c0.wave = __builtin_amdgcn_readfirstlane(c0.tid >> 6); c0.G = gridDim.x; c0.gw = blockIdx.x * NWAVES + c0.wave; c0.NGW = c0.G * NWAVES;
    volatile LAS unsigned* MISC = (volatile LAS unsigned*)(c0.lds + LDSCTL_OFF);
    for (int u = c0.tid; u < (LDS_BYTES - LDSCTL_OFF) / 4; u += NTHREADS) ((LAS unsigned*)(c0.lds + LDSCTL_OFF))[u] = 0u;
    __syncthreads();
    unsigned char* ws0 = a.ws;
    XcdBarrier bar = xcd_barrier_post((unsigned*)(ws0 + WS_CTL) + CW_BAR, MISC + 8);
    const int lo = a.ph_lo, hi = a.ph_hi; int ph = 0;
#define PH_BEGIN if (ph >= lo && ph < hi) { Ctx c = c0; asm volatile("" : "+v"(c.tid), "+v"(c.lane), "+s"(c.wave), "+s"(c.gw), "+s"(c.G), "+s"(c.NGW)); unsigned char* ws = ws0; asm volatile("" : "+s"(ws)); float* X = a.out; asm volatile("" : "+s"(X));
#define PH_END if (ph + 1 < hi) xcd_barrier(bar); } ++ph;
#define IN(k) ({ const float* p_ = a.in[k]; asm volatile("" : "+s"(p_)); p_; })
#define WSP(type, off) ((type*)(ws + (off)))
#define XN WSP(bf16_t, WS_XN)
#define QLAT WSP(float, WS_QLAT)
#define KVLAT WSP(float, WS_KVLAT)
#define KROPE WSP(float, WS_KROPE)
#define U_ WSP(bf16_t, WS_U)
#define GA WSP(bf16_t, WS_GA)
#define GB WSP(bf16_t, WS_GB)
#define QN WSP(bf16_t, WS_QN)
#define KVN WSP(bf16_t, WS_KVN)
#define QRAW WSP(float, WS_QRAW)
#define KVRAW WSP(float, WS_KVRAW)
#define Qn WSP(bf16_t, WS_Q)
#define Kn WSP(bf16_t, WS_K)
#define Vn WSP(bf16_t, WS_V)
#define ATT WSP(bf16_t, WS_ATT)
#define YG WSP(bf16_t, WS_YG)
#define SSM WSP(bf16_t, WS_SSM)
#define TMP WSP(float, WS_TMP)
#define MIX WSP(bf16_t, WS_MIX)
#define HD WSP(bf16_t, WS_HD)
#define TOPE WSP(int, WS_TOPE)
#define TOPW WSP(float, WS_TOPW)
#define POS WSP(int, WS_POS)
#define ROWTOK WSP(int, WS_ROWTOK)
#define TILE32E WSP(int, WS_TILE32E)
#define H1 WSP(bf16_t, WS_H1)
#define Y_ WSP(float, WS_Y)

    for (int l = 0; l < DEPTH; ++l) {
        PH_BEGIN s_rms1024(c, l == 0 ? IN(0) : X, IN(1) + l * D, XN); PH_END
        PH_BEGIN s_gemm<false>(c, XN, D, nullptr, nullptr, 0, IN(2) + (size_t)l * D * INC, nullptr, INC, T, INC, D, EpiProj{IN(3) + l * INC, QLAT, KVLAT, KROPE, U_, GA, GB}); PH_END
        PH_BEGIN s_rms_small<256>(c, QLAT, IN(4) + l * QLR, QN); s_rms_small<128>(c, KVLAT, IN(6) + l * KVLR, KVN); PH_END
        PH_BEGIN s_gemm<false>(c, QN, QLR, nullptr, nullptr, 0, IN(5) + (size_t)l * QLR * 768, nullptr, 768, T, 768, QLR, EpiF32{QRAW, 768});
                 s_gemm<false>(c, KVN, KVLR, nullptr, nullptr, 0, IN(7) + (size_t)l * KVLR * 1024, nullptr, 1024, T, 1024, KVLR, EpiF32{KVRAW, 1024}); PH_END
        PH_BEGIN s_heads(c, QRAW, KVRAW, KROPE, IN(8) + l * QKD, IN(9) + l * QKD, Qn, Kn, Vn); PH_END
        PH_BEGIN s_s5(c, U_, IN(10) + l * 2048, IN(11) + l * 2048, IN(12) + l * 32, IN(13) + (size_t)l * 32768, IN(14) + (size_t)l * 32768, IN(15) + (size_t)l * 32768, IN(16) + (size_t)l * 32768, IN(17) + l * 512, YG);
                 if (c.gw >= BATCH * S5G) s_attn(c, c.gw - BATCH * S5G, c.NGW - BATCH * S5G, Qn, Kn, Vn, ATT); PH_END
        PH_BEGIN s_gemm<false>(c, YG, 512, nullptr, nullptr, 0, IN(18) + (size_t)l * 512 * 512, nullptr, 512, T, 512, 512, EpiGlu{YG, IN(19) + l * 512, SSM});
                 s_gemm<false>(c, ATT, 512, nullptr, nullptr, 0, IN(20) + (size_t)l * 512 * 1024, nullptr, 1024, T, 1024, 512, EpiMixA{GA, TMP}); PH_END
        PH_BEGIN s_gemm<false>(c, SSM, 512, nullptr, nullptr, 0, IN(21) + (size_t)l * 512 * 1024, nullptr, 1024, T, 1024, 512, EpiMixB{GB, TMP, MIX}); PH_END
        PH_BEGIN s_gemm<false>(c, MIX, D, nullptr, nullptr, 0, IN(22) + (size_t)l * D * D, nullptr, D, T, D, D, EpiResid{l == 0 ? IN(0) : X, X}); PH_END
        PH_BEGIN s_rms1024(c, X, IN(23) + l * D, XN); if (l == 1) s_router(c, X, IN(23) + l * D, IN(27), IN(28), TOPE, TOPW); PH_END
        if (l == 0) {
            PH_BEGIN s_gemm<true>(c, XN, D, nullptr, nullptr, 0, IN(24), IN(25), FFD, T, FFD, D, EpiSwiglu{HD, FFD}); PH_END
            PH_BEGIN s_gemm<false>(c, HD, FFD, nullptr, nullptr, 0, IN(26), nullptr, D, T, D, FFD, EpiResid{X, X}); PH_END
        } else {
            PH_BEGIN s_route_build(c, TOPE, ROWTOK, POS, TILE32E); PH_END
            PH_BEGIN s_rowtok(c, POS, ROWTOK); PH_END
            PH_BEGIN s_gemm<true>(c, XN, D, ROWTOK, TILE32E, (size_t)D * FFE, IN(29), IN(30), FFE, RCAP, FFE, D, EpiSwiglu{H1, FFE}); PH_END
            PH_BEGIN s_gemm<false>(c, H1, FFE, nullptr, TILE32E, (size_t)FFE * D, IN(31), nullptr, D, RCAP, D, FFE, EpiF32{Y_, D}); PH_END
            PH_BEGIN s_moe_combine(c, X, Y_, POS, TOPW); PH_END
        }
    }
}

extern "C" void kernel_launch(void* const* d_in, const int* in_sizes, int n_in, void* d_out, int out_size, void* d_ws, size_t ws_size, hipStream_t stream) {
    static int grid = 0;
    if (grid == 0) {
        if (n_in != 32 || out_size != T * D || ws_size < WS_END) { fprintf(stderr, "kernel_launch: unexpected shapes (n_in %d out %d ws %zu)\n", n_in, out_size, ws_size); grid = -1; return; }
        int dev = 0, cus = 0, per_cu = 0;
        if (hipGetDevice(&dev) != hipSuccess || hipDeviceGetAttribute(&cus, hipDeviceAttributeMultiprocessorCount, dev) != hipSuccess) { grid = -1; return; }
        if (hipFuncSetAttribute((const void*)mk_fwd, hipFuncAttributeMaxDynamicSharedMemorySize, LDS_BYTES) != hipSuccess) { fprintf(stderr, "kernel_launch: hipFuncSetAttribute failed\n"); grid = -1; return; }
        if (hipOccupancyMaxActiveBlocksPerMultiprocessor(&per_cu, (const void*)mk_fwd, NTHREADS, LDS_BYTES) != hipSuccess || per_cu < 1) { fprintf(stderr, "kernel_launch: occupancy query says %d\n", per_cu); }
        (void)hipGetLastError();
        grid = cus;
    }
    if (grid < 0) return;
    (void)hipMemsetAsync((char*)d_ws + WS_CTL, 0, CTL_ZERO_BYTES, stream);
    Args a{};
    for (int i = 0; i < 32; ++i) a.in[i] = (const float*)d_in[i];
    a.out = (float*)d_out; a.ws = (unsigned char*)d_ws; a.ph_lo = 0; a.ph_hi = 1000;
    hipLaunchKernelGGL(mk_fwd, dim3(grid), dim3(NTHREADS), LDS_BYTES, stream, a);
}
```

```cpp
#include <hip/hip_runtime.h>
#include <cstdio>
#include <cstdint>

typedef unsigned short bf16_t;
typedef short bf16x8 __attribute__((ext_vector_type(8)));
typedef float f32x4 __attribute__((ext_vector_type(4)));
typedef unsigned u32x4 __attribute__((ext_vector_type(4)));
#define LAS __attribute__((address_space(3)))
#define GAS __attribute__((address_space(1)))

constexpr int D = 1024, BATCH = 2, SEQ = 8192, T = BATCH * SEQ, DEPTH = 2;
constexpr int NH = 8, QKD = 96, QLR = 256, KVLR = 128;
constexpr int S5G = 32;
constexpr int FFD = 2816, NE = 8, FFE = 3584, INC = 2976;
constexpr int RCAP = 34816;
constexpr float EPS = 1e-6f;
constexpr float QSCALE = 0.14724444602590306f;
constexpr int NWAVES = 8, NTHREADS = 512;
constexpr int LDS_BYTES = 147456;
constexpr int LDSCTL_OFF = 131072;
constexpr size_t MiB = 1u << 20;

__device__ __forceinline__ unsigned f2bf(float f) { unsigned u = __builtin_bit_cast(unsigned, f); return (u + 0x7fffu + ((u >> 16) & 1u)) >> 16; }
__device__ __forceinline__ float bf2f(unsigned h) { return __builtin_bit_cast(float, h << 16); }
__device__ __forceinline__ float bflo(unsigned w) { return __builtin_bit_cast(float, w << 16); }
__device__ __forceinline__ float bfhi(unsigned w) { return __builtin_bit_cast(float, w & 0xffff0000u); }
__device__ __forceinline__ int hw_lane() { int l; asm volatile("v_mbcnt_lo_u32_b32 %0, -1, 0\n\tv_mbcnt_hi_u32_b32 %0, -1, %0" : "=v"(l)); return l; }
__device__ __forceinline__ float bperm(float v, int lane_src) { return __builtin_bit_cast(float, __builtin_amdgcn_ds_bpermute(lane_src << 2, __builtin_bit_cast(int, v))); }
template <int M> __device__ __forceinline__ float xadd(float v, int lane) { return v + bperm(v, lane ^ M); }
__device__ __forceinline__ float wave_sum(float v, int lane) { v = xadd<1>(v, lane); v = xadd<2>(v, lane); v = xadd<4>(v, lane); v = xadd<8>(v, lane); v = xadd<16>(v, lane); return xadd<32>(v, lane); }
__device__ __forceinline__ float sigmoidf_(float v) { return 1.f / (1.f + __expf(-v)); }
__device__ __forceinline__ float siluf_(float v) { return v / (1.f + __expf(-v)); }
__device__ __forceinline__ float gelu_tanh(float v) {
    const float z = 0.7978845608028654f * (v + 0.044715f * v * v * v);
    const float e = __expf(2.f * z);
    const float th = 1.f - 2.f / (e + 1.f);
    return 0.5f * v * (1.f + th);
}
__device__ __forceinline__ void sincos_rev(double rev, float& s, float& c) {
    const double fr = rev - floor(rev);
    const float f = (float)fr;
    s = __builtin_amdgcn_sinf(f); c = __builtin_amdgcn_cosf(f);
}
__constant__ double c_invrev[16] = {0.15915494309189535, 0.08949940160889101, 0.050329212104487035, 0.0283021958306234, 0.015915494309189534, 0.008949940160889102,
    0.005032921210448704, 0.00283021958306234, 0.0015915494309189536, 0.0008949940160889102, 0.0005032921210448703, 0.00028302195830623395, 0.00015915494309189535,
    8.949940160889102e-05, 5.0329212104487035e-05, 2.8302195830623396e-05};

#define XB_TMO      128
#define XB_XCNT(j)  (256  + 64 * (j))
#define XB_XSUB(j)  (1280 + 64 * (j))
#define XB_XGEN(j)  (2304 + 64 * (j))
#define XB_TOP      3328
#define XB_TOPGEN   3392
#define XCD_BAR_WORDS 3456
#define XB_SPIN_CAP (1u << 18)

__device__ __forceinline__ unsigned xb_ld(unsigned* p)              { return __hip_atomic_load(p, __ATOMIC_RELAXED, __HIP_MEMORY_SCOPE_AGENT); }
__device__ __forceinline__ unsigned xb_add(unsigned* p, unsigned v) { return __hip_atomic_fetch_add(p, v, __ATOMIC_RELAXED, __HIP_MEMORY_SCOPE_AGENT); }
__device__ __forceinline__ unsigned xb_xcc_id() { return (unsigned)__builtin_amdgcn_s_getreg((3 << 11) | 20) & 0xFu; }
#define XB_SPIN(cond, bar) do { unsigned _sp = 0; while (cond) { __builtin_amdgcn_s_sleep(1); \
    if ((++_sp & 255u) == 0u) { if (xb_ld(&(bar)[XB_TMO])) break; if (_sp > XB_SPIN_CAP) { atomicAdd(&(bar)[XB_TMO], 1u); break; } } } } while (0)

struct XcdBarrier {
    unsigned* bar; unsigned x; unsigned w;
    volatile LAS unsigned* st;
};

__device__ __forceinline__ XcdBarrier xcd_barrier_post(unsigned* bar, volatile LAS unsigned* st) {
    XcdBarrier b; b.bar = bar; b.x = xb_xcc_id(); b.st = st;
    if (threadIdx.x == 0) (void)xb_add(&bar[XB_XCNT(b.x)], 1u);
    return b;
}
__device__ __forceinline__ void xcd_barrier_complete(unsigned* bar, unsigned x, unsigned& nloc, unsigned& nx) {
    const unsigned G = gridDim.x * gridDim.y * gridDim.z;
    unsigned sum, cnt, mine, sp = 0u;
    for (;;) {
        sum = 0u; cnt = 0u; mine = 0u;
#pragma unroll
        for (unsigned j = 0; j < 16; ++j) { const unsigned c = xb_ld(&bar[XB_XCNT(j)]); sum += c; cnt += (c > 0u) ? 1u : 0u; mine = (j == x) ? c : mine; }
        if (sum == G) break;
        __builtin_amdgcn_s_sleep(1);
        if ((++sp & 255u) == 0u) { if (xb_ld(&bar[XB_TMO])) break; if (sp > XB_SPIN_CAP) { atomicAdd(&bar[XB_TMO], 1u); break; } }
    }
    nloc = mine > 0u ? mine : 1u; nx = cnt > 0u ? cnt : 1u;
}

__device__ __forceinline__ void xcd_barrier(const XcdBarrier& b) {
    asm volatile("s_waitcnt vmcnt(0)" ::: "memory");
    __syncthreads();
    if (b.w == 0u && hw_lane() == 0) {
        unsigned* bar = b.bar; asm volatile("" : "+s"(bar));
        __builtin_amdgcn_s_waitcnt(0);
        unsigned nloc = b.st[0], nx = b.st[1];
        if (nloc == 0u) { xcd_barrier_complete(bar, b.x, nloc, nx); b.st[0] = nloc; b.st[1] = nx; }
        const unsigned old = xb_add(&bar[XB_XSUB(b.x)], 1u);
        const unsigned gen = old / nloc;
        if (old + 1u == (gen + 1u) * nloc) {
            __builtin_amdgcn_fence(__ATOMIC_RELEASE, "agent");
            asm volatile("s_waitcnt vmcnt(0)" ::: "memory");
            const unsigned og = xb_add(&bar[XB_TOP], 1u);
            const unsigned tg = og / nx;
            if (og + 1u == (tg + 1u) * nx) xb_add(&bar[XB_TOPGEN], 1u);
            else XB_SPIN(xb_ld(&bar[XB_TOPGEN]) == tg, bar);
            __builtin_amdgcn_fence(__ATOMIC_ACQUIRE, "agent");
            xb_add(&bar[XB_XGEN(b.x)], 1u);
            asm volatile("s_waitcnt vmcnt(0)" ::: "memory");
        } else {
            XB_SPIN(xb_ld(&bar[XB_XGEN(b.x)]) == gen, bar);
            __builtin_amdgcn_fence(__ATOMIC_ACQUIRE, "agent");
            asm volatile("s_waitcnt vmcnt(0)" ::: "memory");
        }
    }
    __syncthreads();
}
struct Ctx { int tid, lane, wave, G, gw, NGW; LAS unsigned char* lds; };

__device__ __forceinline__ void s_rms1024(const Ctx& c, const float* __restrict__ x, const float* __restrict__ g, bf16_t* __restrict__ out) {
    for (int row = c.gw; row < T; row += c.NGW) {
        const f32x4* xr = (const f32x4*)(x + (size_t)row * D) + c.lane;
        f32x4 v[4]; float s = 0.f;
#pragma unroll
        for (int j = 0; j < 4; ++j) { v[j] = xr[64 * j]; s += v[j].x * v[j].x + v[j].y * v[j].y + v[j].z * v[j].z + v[j].w * v[j].w; }
        const float r = rsqrtf(wave_sum(s, c.lane) * (1.f / D) + EPS);
#pragma unroll
        for (int j = 0; j < 4; ++j) {
            const f32x4 gg = *((const f32x4*)g + c.lane + 64 * j);
            const unsigned lo = f2bf(v[j].x * r * gg.x) | (f2bf(v[j].y * r * gg.y) << 16), hi = f2bf(v[j].z * r * gg.z) | (f2bf(v[j].w * r * gg.w) << 16);
            *((uint2*)(out + (size_t)row * D) + c.lane + 64 * j) = make_uint2(lo, hi);
        }
    }
}
template <int W>
__device__ __forceinline__ void s_rms_small(const Ctx& c, const float* __restrict__ x, const float* __restrict__ g, bf16_t* __restrict__ out) {
    for (int row = c.gw; row < T; row += c.NGW) {
        float v[W / 64]; float s = 0.f;
#pragma unroll
        for (int j = 0; j < W / 64; ++j) { v[j] = x[(size_t)row * W + c.lane + 64 * j]; s += v[j] * v[j]; }
        const float r = rsqrtf(wave_sum(s, c.lane) * (1.f / W) + EPS);
#pragma unroll
        for (int j = 0; j < W / 64; ++j) out[(size_t)row * W + c.lane + 64 * j] = (bf16_t)f2bf(v[j] * r * g[c.lane + 64 * j]);
    }
}
template <bool DUAL, class Epi>
__device__ __forceinline__ void s_gemm(const Ctx& c, const bf16_t* __restrict__ A, int lda, const int* __restrict__ arow, const int* __restrict__ texp, size_t wstride,
                                       const float* __restrict__ W0, const float* __restrict__ W20, int ldw, int M, int N, int K, const Epi& E) {
    const int lane = c.lane, ntn = N >> 5; const long nt = (long)(M >> 5) * ntn;
    const int r16 = lane & 15, q = lane >> 4;
    for (long wv = c.gw; wv < nt; wv += c.NGW) {
        const int tm = (int)(wv / ntn), tn = (int)(wv % ntn);
        const float* W = W0; const float* W2 = W20;
        if (texp) { const int e = texp[tm]; if (e < 0) continue; W += (size_t)e * wstride; if (DUAL) W2 += (size_t)e * wstride; }
        f32x4 acc[2][2], acc2[2][2];
#pragma unroll
        for (int i = 0; i < 2; ++i)
#pragma unroll
            for (int j = 0; j < 2; ++j) { acc[i][j] = (f32x4){0.f, 0.f, 0.f, 0.f}; acc2[i][j] = (f32x4){0.f, 0.f, 0.f, 0.f}; }
        const bf16_t* ap[2]; bool av[2];
#pragma unroll
        for (int i = 0; i < 2; ++i) { const int r = tm * 32 + i * 16 + r16; const int rr = arow ? arow[r] : r; av[i] = rr >= 0; ap[i] = A + (size_t)(av[i] ? rr : 0) * lda + q * 8; }
        const size_t woff = (size_t)(q * 8) * ldw + tn * 32 + r16;
        for (int k0 = 0; k0 < K; k0 += 32) {
            bf16x8 a[2], b[2], b2[2];
#pragma unroll
            for (int i = 0; i < 2; ++i) { a[i] = (bf16x8){0, 0, 0, 0, 0, 0, 0, 0}; if (av[i]) a[i] = *(const bf16x8*)(ap[i] + k0); }
#pragma unroll
            for (int jn = 0; jn < 2; ++jn)
#pragma unroll
                for (int j = 0; j < 8; ++j) {
                    b[jn][j] = (short)f2bf(W[woff + (size_t)(k0 + j) * ldw + jn * 16]);
                    if (DUAL) b2[jn][j] = (short)f2bf(W2[woff + (size_t)(k0 + j) * ldw + jn * 16]);
                }
#pragma unroll
            for (int i = 0; i < 2; ++i)
#pragma unroll
                for (int jn = 0; jn < 2; ++jn) {
                    acc[i][jn] = __builtin_amdgcn_mfma_f32_16x16x32_bf16(a[i], b[jn], acc[i][jn], 0, 0, 0);
                    if (DUAL) acc2[i][jn] = __builtin_amdgcn_mfma_f32_16x16x32_bf16(a[i], b2[jn], acc2[i][jn], 0, 0, 0);
                }
        }
#pragma unroll
        for (int i = 0; i < 2; ++i)
#pragma unroll
            for (int jn = 0; jn < 2; ++jn)
#pragma unroll
                for (int j = 0; j < 4; ++j) E(tm * 32 + i * 16 + q * 4 + j, tn * 32 + jn * 16 + r16, acc[i][jn][j], acc2[i][jn][j]);
    }
}
struct EpiProj {
    const float* b; float* qlat; float* kvlat; float* krope; bf16_t* u; bf16_t* ga; bf16_t* gb;
    __device__ __forceinline__ void operator()(int r, int c, float v, float) const {
        v += b[c];
        if (c < 256) qlat[(size_t)r * 256 + c] = v;
        else if (c < 384) kvlat[(size_t)r * 128 + (c - 256)] = v;
        else if (c < 416) krope[(size_t)r * 32 + (c - 384)] = v;
        else if (c < 928) u[(size_t)r * 512 + (c - 416)] = (bf16_t)f2bf(v);
        else if (c < 1952) ga[(size_t)r * 1024 + (c - 928)] = (bf16_t)f2bf(sigmoidf_(v));
        else gb[(size_t)r * 1024 + (c - 1952)] = (bf16_t)f2bf(sigmoidf_(v));
    }
};
struct EpiF32 { float* C; int ldc; __device__ __forceinline__ void operator()(int r, int c, float v, float) const { C[(size_t)r * ldc + c] = v; } };
struct EpiGlu { const bf16_t* yg; const float* b; bf16_t* out;
    __device__ __forceinline__ void operator()(int r, int c, float v, float) const { const float y = bf2f(yg[(size_t)r * 512 + c]); out[(size_t)r * 512 + c] = (bf16_t)f2bf(y * sigmoidf_(v + b[c])); } };
struct EpiMixA { const bf16_t* ga; float* tmp; __device__ __forceinline__ void operator()(int r, int c, float v, float) const { tmp[(size_t)r * 1024 + c] = bf2f(ga[(size_t)r * 1024 + c]) * v; } };
struct EpiMixB { const bf16_t* gb; const float* tmp; bf16_t* mix;
    __device__ __forceinline__ void operator()(int r, int c, float v, float) const { mix[(size_t)r * 1024 + c] = (bf16_t)f2bf(tmp[(size_t)r * 1024 + c] + bf2f(gb[(size_t)r * 1024 + c]) * v); } };
struct EpiResid { const float* xin; float* xout; __device__ __forceinline__ void operator()(int r, int c, float v, float) const { xout[(size_t)r * 1024 + c] = xin[(size_t)r * 1024 + c] + v; } };
struct EpiSwiglu { bf16_t* h; int ldh; __device__ __forceinline__ void operator()(int r, int c, float vg, float vu) const { h[(size_t)r * ldh + c] = (bf16_t)f2bf(siluf_(vg) * vu); } };

__device__ __forceinline__ void s_heads(const Ctx& c, const float* __restrict__ qraw, const float* __restrict__ kvraw, const float* __restrict__ krope, const float* __restrict__ gq, const float* __restrict__ gk,
                                        bf16_t* __restrict__ Qn, bf16_t* __restrict__ Kn, bf16_t* __restrict__ Vn) {
    const int lane = c.lane;
    for (int id = c.gw; id < T * NH * 2; id += c.NGW) {
        const int which = id & 1, h = (id >> 1) & 7, t = id >> 4;
        const int b = t / SEQ, s = t % SEQ;
        const size_t orow = ((size_t)(b * NH + h) * SEQ + s);
        float v0, v1 = 0.f;
        if (which == 0) { v0 = qraw[(size_t)t * 768 + h * 96 + lane]; if (lane < 32) v1 = qraw[(size_t)t * 768 + h * 96 + 64 + lane]; }
        else { v0 = kvraw[(size_t)t * 1024 + h * 128 + lane]; if (lane < 32) v1 = krope[(size_t)t * 32 + lane]; }
        const float ss = wave_sum(v0 * v0 + v1 * v1, c.lane);
        const float r = rsqrtf(ss * (1.f / 96.f) + EPS) * (which == 0 ? QSCALE : 1.f);
        const float* gg = which == 0 ? gq : gk;
        v0 = v0 * r * gg[lane]; if (lane < 32) v1 = v1 * r * gg[64 + lane];
        const float partner = bperm(v1, lane ^ 16);
        float sn, cs; sincos_rev((double)s * c_invrev[lane & 15], sn, cs);
        const float rot = (lane < 16) ? (v1 * cs - partner * sn) : (v1 * cs + partner * sn);
        bf16_t* op = (which == 0 ? Qn : Kn) + orow * 96;
        op[lane] = (bf16_t)f2bf(v0);
        if (lane < 32) op[64 + lane] = (bf16_t)f2bf(rot);
        if (which == 1) Vn[orow * 64 + lane] = (bf16_t)f2bf(kvraw[(size_t)t * 1024 + h * 128 + 64 + lane]);
    }
}
__device__ __forceinline__ void s_attn(const Ctx& c, int aw, int NAW, const bf16_t* __restrict__ Qn, const bf16_t* __restrict__ Kn, const bf16_t* __restrict__ Vn, bf16_t* __restrict__ att) {
    for (int base2 = aw * 64; base2 < 2 * BATCH * NH * SEQ; base2 += NAW * 64) {
        const int half = base2 & 64 ? 1 : 0;
        const int base = (base2 >> 7) * 64;
        const int id = base + c.lane;
        const int bh = base / SEQ, qi = id % SEQ;
        const int qmax = (base % SEQ) + 63;
        unsigned q[48];
        { const u32x4* qp = (const u32x4*)(Qn + (size_t)id * 96);
#pragma unroll
          for (int i = 0; i < 12; ++i) { const u32x4 w = qp[i]; q[4 * i] = w[0]; q[4 * i + 1] = w[1]; q[4 * i + 2] = w[2]; q[4 * i + 3] = w[3]; } }
        float o[32];
#pragma unroll
        for (int i = 0; i < 32; ++i) o[i] = 0.f;
        float m = -1e30f, l = 0.f;
        const bf16_t* kb = Kn + (size_t)bh * SEQ * 96; const bf16_t* vb = Vn + (size_t)bh * SEQ * 64 + half * 32;
        for (int j = 0; j <= qmax; ++j) {
            const u32x4* kp = (const u32x4*)(kb + (size_t)j * 96);
            float s = 0.f;
#pragma unroll
            for (int i = 0; i < 12; ++i) { const u32x4 w = kp[i];
#pragma unroll
                for (int jj = 0; jj < 4; ++jj) { s += bflo(q[4 * i + jj]) * bflo(w[jj]); s += bfhi(q[4 * i + jj]) * bfhi(w[jj]); } }
            if (j <= qi) {
                const float mn = fmaxf(m, s);
                const float al = exp2f(m - mn), p = exp2f(s - mn);
                l = l * al + p; m = mn;
                const u32x4* vp = (const u32x4*)(vb + (size_t)j * 64);
#pragma unroll
                for (int i = 0; i < 4; ++i) { const u32x4 w = vp[i];
#pragma unroll
                    for (int jj = 0; jj < 4; ++jj) { o[i * 8 + 2 * jj] = o[i * 8 + 2 * jj] * al + p * bflo(w[jj]); o[i * 8 + 2 * jj + 1] = o[i * 8 + 2 * jj + 1] * al + p * bfhi(w[jj]); } }
            }
        }
        const float rl = 1.f / l;
        const int b = bh / NH, h = bh % NH;
        bf16_t* op = att + ((size_t)(b * SEQ + qi)) * 512 + h * 64 + half * 32;
#pragma unroll
        for (int i = 0; i < 4; ++i) { u32x4 w;
#pragma unroll
            for (int j = 0; j < 4; ++j) w[j] = f2bf(o[i * 8 + 2 * j] * rl) | (f2bf(o[i * 8 + 2 * j + 1] * rl) << 16);
            *(u32x4*)(op + i * 8) = w; }
    }
}
__device__ __forceinline__ void s_s5(const Ctx& c, const bf16_t* __restrict__ U, const float* __restrict__ lam_re, const float* __restrict__ lam_im, const float* __restrict__ log_step,
                                     const float* __restrict__ b_re, const float* __restrict__ b_im, const float* __restrict__ c_re, const float* __restrict__ c_im,
                                     const float* __restrict__ dsk, bf16_t* __restrict__ YG) {
    if (c.gw >= BATCH * S5G) return;
    const int b = c.gw / S5G, g = c.gw % S5G, p = c.lane;
    const float lre = lam_re[g * 64 + p], lim = lam_im[g * 64 + p], st = __expf(log_step[g]);
    const float mag = __expf(lre * st);
    float sn, cs; sincos_rev((double)lim * (double)st * 0.15915494309189535, sn, cs);
    const float lbr = mag * cs, lbi = mag * sn;
    const float nr = lbr - 1.f, ni = lbi, den = 1.f / (lre * lre + lim * lim);
    const float cr = (nr * lre + ni * lim) * den, ci = (ni * lre - nr * lim) * den;
    float Br[16], Bi[16], Cr[16], Ci[16];
#pragma unroll
    for (int k = 0; k < 16; ++k) {
        const float br = b_re[(g * 64 + p) * 16 + k], bi = b_im[(g * 64 + p) * 16 + k];
        Br[k] = cr * br - ci * bi; Bi[k] = cr * bi + ci * br;
        Cr[k] = c_re[(g * 16 + k) * 64 + p]; Ci[k] = c_im[(g * 16 + k) * 64 + p];
    }
    const float dk = dsk[g * 16 + (p & 15)];
    float xr = 0.f, xi = 0.f;
    const bf16_t* up = U + (size_t)b * SEQ * 512 + g * 16;
    bf16_t* yp = YG + (size_t)b * SEQ * 512 + g * 16;
#pragma unroll 2
    for (int t = 0; t < SEQ; ++t) {
        const u32x4 w0 = *(const u32x4*)(up + (size_t)t * 512), w1 = *(const u32x4*)(up + (size_t)t * 512 + 8);
        float u[16];
#pragma unroll
        for (int j = 0; j < 4; ++j) { u[2 * j] = bflo(w0[j]); u[2 * j + 1] = bfhi(w0[j]); u[8 + 2 * j] = bflo(w1[j]); u[8 + 2 * j + 1] = bfhi(w1[j]); }
        float br = 0.f, bi = 0.f;
#pragma unroll
        for (int k = 0; k < 16; ++k) { br += Br[k] * u[k]; bi += Bi[k] * u[k]; }
        const float nxr = lbr * xr - lbi * xi + br, nxi = lbr * xi + lbi * xr + bi;
        xr = nxr; xi = nxi;
        float mine = 0.f, um = 0.f;
#pragma unroll
        for (int k = 0; k < 16; ++k) {
            const float y = wave_sum(Cr[k] * xr - Ci[k] * xi, p);
            if ((p & 15) == k) { mine = y; um = u[k]; }
        }
        if (p < 16) yp[(size_t)t * 512 + p] = (bf16_t)f2bf(gelu_tanh(mine + dk * um));
    }
}
__device__ __forceinline__ void s_router(const Ctx& c, const float* __restrict__ x, const float* __restrict__ g, const float* __restrict__ rw, const float* __restrict__ rb, int* __restrict__ tope, float* __restrict__ topw) {
    for (int t = c.gw; t < T; t += c.NGW) {
        const float* xr = x + (size_t)t * D;
        float h[16]; float s = 0.f;
#pragma unroll
        for (int j = 0; j < 16; ++j) { h[j] = xr[c.lane + 64 * j]; s += h[j] * h[j]; }
        const float r = rsqrtf(wave_sum(s, c.lane) * (1.f / D) + EPS);
        float lg[8];
#pragma unroll
        for (int e = 0; e < 8; ++e) lg[e] = 0.f;
#pragma unroll
        for (int j = 0; j < 16; ++j) { const int k = c.lane + 64 * j; const float hv = h[j] * r * g[k];
#pragma unroll
            for (int e = 0; e < 8; ++e) lg[e] += hv * rw[k * 8 + e]; }
#pragma unroll
        for (int e = 0; e < 8; ++e) lg[e] = wave_sum(lg[e], c.lane) + rb[e];
        int e0 = 0; float v0 = lg[0];
#pragma unroll
        for (int e = 1; e < 8; ++e) if (lg[e] > v0) { v0 = lg[e]; e0 = e; }
        int e1 = -1; float v1 = -3.0e38f;
#pragma unroll
        for (int e = 0; e < 8; ++e) if (e != e0 && lg[e] > v1) { v1 = lg[e]; e1 = e; }
        if (c.lane == 0) { const float w1 = 1.f / (1.f + __expf(v0 - v1)); tope[t * 2] = e0; tope[t * 2 + 1] = e1; topw[t * 2] = 1.f - w1; topw[t * 2 + 1] = w1; }
    }
}
__device__ __forceinline__ void s_route_build(const Ctx& c, const int* __restrict__ tope, int* __restrict__ rowtok, int* __restrict__ pos, int* __restrict__ tile32e) {
    for (int r = blockIdx.x * NTHREADS + c.tid; r < RCAP; r += c.G * NTHREADS) rowtok[r] = -1;
    if (blockIdx.x != 0) return;
    LAS int* wcnt = (LAS int*)(c.lds);
    LAS int* base = wcnt + 64;
    LAS int* segoff = base + 8;
    const int tid = c.tid, lane = c.lane, wv = c.wave;
    if (tid < 8) base[tid] = 0;
    __syncthreads();
    for (int c0 = 0; c0 < T; c0 += NTHREADS) {
        const int t = c0 + tid; const int e0 = tope[t * 2], e1 = tope[t * 2 + 1];
        for (int e = 0; e < 8; ++e) { const unsigned long long m = __ballot(e0 == e || e1 == e); if (lane == 0) wcnt[wv * 8 + e] = __popcll(m); }
        __syncthreads();
        if (tid < 8) { int s = 0; for (int w = 0; w < 8; ++w) s += wcnt[w * 8 + tid]; base[tid] += s; }
        __syncthreads();
    }
    if (tid == 0) { int o = 0; for (int e = 0; e < 8; ++e) { segoff[e] = o; o += (base[e] + 255) & ~255; } segoff[8] = o; }
    __syncthreads();
    for (int i = tid; i < RCAP / 32; i += NTHREADS) { int e = -1; for (int k = 0; k < 8; ++k) if (i * 32 >= segoff[k] && i * 32 < segoff[k + 1]) e = k; tile32e[i] = e; }
    __syncthreads();
    if (tid < 8) base[tid] = segoff[tid];
    __syncthreads();
    for (int c0 = 0; c0 < T; c0 += NTHREADS) {
        const int t = c0 + tid; const int e0 = tope[t * 2], e1 = tope[t * 2 + 1];
        int rank0 = 0, rank1 = 0;
        for (int e = 0; e < 8; ++e) { const bool f = (e0 == e || e1 == e); const unsigned long long m = __ballot(f);
            const int pre = __popcll(m & ((1ull << lane) - 1ull)); if (lane == 0) wcnt[wv * 8 + e] = __popcll(m);
            if (e0 == e) rank0 = pre; if (e1 == e) rank1 = pre; }
        __syncthreads();
        { int off = base[e0]; for (int w = 0; w < wv; ++w) off += wcnt[w * 8 + e0]; pos[t * 2] = off + rank0; }
        { int off = base[e1]; for (int w = 0; w < wv; ++w) off += wcnt[w * 8 + e1]; pos[t * 2 + 1] = off + rank1; }
        __syncthreads();
        if (tid < 8) { int s = 0; for (int w = 0; w < 8; ++w) s += wcnt[w * 8 + tid]; base[tid] += s; }
        __syncthreads();
    }
}
__device__ __forceinline__ void s_rowtok(const Ctx& c, const int* __restrict__ pos, int* __restrict__ rowtok) {
    for (int i = blockIdx.x * NTHREADS + c.tid; i < T * 2; i += c.G * NTHREADS) rowtok[pos[i]] = i >> 1;
}
__device__ __forceinline__ void s_moe_combine(const Ctx& c, float* __restrict__ x, const float* __restrict__ Y, const int* __restrict__ pos, const float* __restrict__ topw) {
    for (int i = blockIdx.x * NTHREADS + c.tid; i < T * 256; i += c.G * NTHREADS) {
        const int t = i >> 8, cc = (i & 255) * 4;
        const int p0 = pos[t * 2], p1 = pos[t * 2 + 1]; const float w0 = topw[t * 2], w1 = topw[t * 2 + 1];
        f32x4 xv = *(f32x4*)(x + (size_t)t * D + cc); const f32x4 y0 = *(const f32x4*)(Y + (size_t)p0 * D + cc), y1 = *(const f32x4*)(Y + (size_t)p1 * D + cc);
        xv = xv + y0 * w0 + y1 * w1; *(f32x4*)(x + (size_t)t * D + cc) = xv;
    }
}
namespace pg8 {
#define PG8_LAS __attribute__((address_space(3)))
typedef unsigned short bf16_t;
typedef short bf16x8 __attribute__((ext_vector_type(8)));
typedef float f32x4 __attribute__((ext_vector_type(4)));
typedef unsigned u32x4 __attribute__((ext_vector_type(4)));
constexpr int BM = 256, BK = 64, HALF = 128, HTB = HALF * BK * 2  , STAGE_BYTES = 8 * HTB, NXCD = 8, WGM = 8;

__host__ __device__ __forceinline__ int lds_byte(int r, int c) { const int st = (r >> 4) * 2 + (c >> 5), rr = r & 15, cc = c & 31, ob = rr * 64 + cc * 2; return st * 1024 + (ob ^ (((ob >> 9) & 1) << 5)); }
__host__ __device__ __forceinline__ void stage_rc(int b, int& R, int& C) { const int st = b / 1024, sb = b % 1024, swz = sb ^ (((sb >> 9) & 1) << 5); R = (st >> 1) * 16 + swz / 64; C = (st & 1) * 32 + (swz % 64) / 2; }
__host__ __device__ __forceinline__ int perm32(int rho) { const int n = rho >> 4, i = rho & 15; return 8 * (i >> 2) + 4 * n + (i & 3); }

struct Unit { int pm, pn; };
struct Gemm { const bf16_t* A; const bf16_t* Bt; int M, N, K; };

struct StaticOrder {
    int nM, nN, nwg, G, c;
    __host__ __device__ void init(int M, int N, int G_, int c_) { nM = M / BM; nN = N / BM; nwg = nM * nN; G = G_; c = c_; }
    __host__ __device__ bool next(int i, Unit& u) const {
        const long L = (long)i * G + c; if (L >= nwg) return false;
        int wgid = (int)L; { const int q = nwg / NXCD, r = nwg % NXCD, xcd = wgid % NXCD, off = wgid / NXCD; wgid = (xcd < r ? xcd * (q + 1) : r * (q + 1) + (xcd - r) * q) + off; }
        const int nig = WGM * nN, gid = wgid / nig, fm = gid * WGM, gsz = (nM - fm) < WGM ? (nM - fm) : WGM;
        u.pm = fm + ((wgid % nig) % gsz); u.pn = (wgid % nig) / gsz; return true;
    }
    __device__ __forceinline__ void a_ready(const Unit&) const {}
    __device__ __forceinline__ void done(const Unit&) const {}
};
__device__ __forceinline__ unsigned cvt_pk_bf16(float lo, float hi) { unsigned r; asm volatile("v_cvt_pk_bf16_f32 %0, %1, %2" : "=v"(r) : "v"(lo), "v"(hi)); return r; }
typedef float f32x2 __attribute__((ext_vector_type(2)));
template <class Epi, class Sched, bool ALIGN_EPI = false, bool SP2 = false>
__device__ __forceinline__ void gemm_phase(PG8_LAS unsigned char* lds, const Gemm g, const Sched& S, const Epi& E, const int tid) {
    const int wid = __builtin_amdgcn_readfirstlane(tid >> 6), lane = tid & 63, wr = wid >> 2, wc = wid & 3, fr = lane & 15, fq = lane >> 4;
    const int K = g.K, nt = K / BK;
    unsigned voffA[2], voffB[2];
#pragma unroll
    for (int i = 0; i < 2; ++i) { int R, C; stage_rc(tid * 16 + i * 8192, R, C); const int Rb = Epi::PERM ? ((R & ~31) + perm32(R & 31)) : R;
        voffA[i] = (unsigned)(R * K + C) * 2u; voffB[i] = (unsigned)(Rb * K + C) * 2u; }
    const size_t kstep = (size_t)(BK * 2);
    const size_t hstep = (size_t)HALF * K * 2;
    const size_t tstep = 2 * hstep;
    const unsigned ldsw = (unsigned)wid * 1024u;
    const int aoff = lds_byte(wr * 64 + fr, fq * 8), boff = lds_byte(wc * 32 + fr, fq * 8);
#define PG8_SA(b, h) (((b) * 2 + (h)) * HTB)
#define PG8_SB(b, h) ((4 + (b) * 2 + (h)) * HTB)
#define PG8_STAGE(bufoff, gbase, voff) do { _Pragma("unroll") for (int _i = 0; _i < 2; ++_i) \
        __builtin_amdgcn_global_load_lds((const unsigned*)((const char*)(gbase) + (voff)[_i]), (PG8_LAS unsigned*)(lds + (bufoff) + ldsw + _i * 8192), 16, 0, 0); } while (0)
#define PG8_LDA(dst, b, h) do { _Pragma("unroll") for (int m = 0; m < 4; ++m) _Pragma("unroll") for (int k = 0; k < 2; ++k) dst[m][k] = *(const PG8_LAS bf16x8*)(lds + PG8_SA(b, h) + aoff + m * 2048 + k * 1024); } while (0)
#define PG8_LDB(dst, b, h) do { _Pragma("unroll") for (int n = 0; n < 2; ++n) _Pragma("unroll") for (int k = 0; k < 2; ++k) dst[n][k] = *(const PG8_LAS bf16x8*)(lds + PG8_SB(b, h) + boff + n * 2048 + k * 1024); } while (0)
#define PG8_MMA(ai, bj, At, Bt) do { __builtin_amdgcn_s_setprio(1); _Pragma("unroll") for (int m = 0; m < 4; ++m) _Pragma("unroll") for (int n = 0; n < 2; ++n) _Pragma("unroll") for (int k = 0; k < 2; ++k) \
        acc[ai][bj][m][n] = __builtin_amdgcn_mfma_f32_16x16x32_bf16(Bt[n][k], At[m][k], acc[ai][bj][m][n], 0, 0, 0); __builtin_amdgcn_s_setprio(0); } while (0)
#define PG8_WAIT_V(n) asm volatile("s_waitcnt vmcnt(" #n ")" ::: "memory")
#define PG8_WAIT_L(n) asm volatile("s_waitcnt lgkmcnt(" #n ")" ::: "memory")
#define PG8_BAR __builtin_amdgcn_s_barrier()
#define PG8_SCHED __builtin_amdgcn_sched_barrier(0)
    Unit cur, nxt; int ui = 0;
    if (!S.next(0, cur)) return;
    f32x4 acc[2][2][4][2];
#pragma unroll
    for (int a = 0; a < 2; ++a)
#pragma unroll
        for (int b = 0; b < 2; ++b)
#pragma unroll
            for (int m = 0; m < 4; ++m)
#pragma unroll
                for (int n = 0; n < 2; ++n) acc[a][b][m][n] = (f32x4){0.f, 0.f, 0.f, 0.f};
    bf16x8 At[4][2], B0[2][2], B1[2][2];
    const char* cA = (const char*)g.A + (size_t)cur.pm * tstep; const char* cB = (const char*)g.Bt + (size_t)cur.pn * tstep;
    S.a_ready(cur);
    if constexpr (SP2) {
        PG8_STAGE(PG8_SB(0, 0), cB, voffB); PG8_STAGE(PG8_SB(0, 1), cB + hstep, voffB); PG8_STAGE(PG8_SA(0, 0), cA, voffA); PG8_STAGE(PG8_SA(0, 1), cA + hstep, voffA);
        if (wr == 1) PG8_BAR;
        PG8_WAIT_V(2); PG8_BAR;
        PG8_STAGE(PG8_SB(1, 0), cB + kstep, voffB); PG8_STAGE(PG8_SA(1, 0), cA + kstep, voffA); PG8_STAGE(PG8_SB(1, 1), cB + hstep + kstep, voffB);
        PG8_WAIT_V(6); PG8_BAR;
    } else {
        PG8_STAGE(PG8_SB(0, 0), cB, voffB); PG8_STAGE(PG8_SA(0, 0), cA, voffA); PG8_STAGE(PG8_SB(0, 1), cB + hstep, voffB); PG8_STAGE(PG8_SA(0, 1), cA + hstep, voffA);
        if (wr == 1) PG8_BAR;
        PG8_WAIT_V(4); PG8_BAR;
        PG8_STAGE(PG8_SB(1, 0), cB + kstep, voffB); PG8_STAGE(PG8_SA(1, 0), cA + kstep, voffA); PG8_STAGE(PG8_SB(1, 1), cB + hstep + kstep, voffB);
        PG8_WAIT_V(6); PG8_BAR;
    }
    for (;;) {
        const bool has_next = S.next(ui + 1, nxt);
        const char* nA = has_next ? (const char*)g.A + (size_t)nxt.pm * tstep : cA; const char* nB = has_next ? (const char*)g.Bt + (size_t)nxt.pn * tstep : cB;
        for (int t = 0; t < nt; t += 2) {
            const bool last = (t == nt - 2);
            const char* a1 = cA + (size_t)(t + 1) * kstep;
            const char* a2 = last ? nA : cA + (size_t)(t + 2) * kstep; const char* b2 = last ? nB : cB + (size_t)(t + 2) * kstep;
            const char* a3 = a2 + kstep; const char* b3 = b2 + kstep;
            if (last && has_next) S.a_ready(nxt);
            if constexpr (SP2) {
            PG8_LDB(B0, 0, 0); PG8_LDB(B1, 0, 1); PG8_SCHED; PG8_LDA(At, 0, 0); PG8_STAGE(PG8_SA(1, 1), a1 + hstep, voffA);
            PG8_WAIT_V(8); PG8_WAIT_L(0); PG8_BAR; PG8_MMA(0, 0, At, B0); PG8_MMA(0, 1, At, B1); PG8_BAR; PG8_SCHED;
            PG8_LDA(At, 0, 1); PG8_STAGE(PG8_SB(0, 0), b2, voffB); PG8_STAGE(PG8_SB(0, 1), b2 + hstep, voffB); PG8_STAGE(PG8_SA(0, 0), a2, voffA);
            PG8_WAIT_V(8); PG8_WAIT_L(0); PG8_BAR; PG8_MMA(1, 0, At, B0); PG8_MMA(1, 1, At, B1); PG8_BAR; PG8_SCHED;
            PG8_LDB(B0, 1, 0); PG8_LDB(B1, 1, 1); PG8_SCHED; PG8_LDA(At, 1, 0); PG8_STAGE(PG8_SA(0, 1), a2 + hstep, voffA);
            PG8_WAIT_V(8); PG8_WAIT_L(0); PG8_BAR; PG8_MMA(0, 0, At, B0); PG8_MMA(0, 1, At, B1); PG8_BAR; PG8_SCHED;
            PG8_LDA(At, 1, 1); PG8_STAGE(PG8_SB(1, 0), b3, voffB); PG8_STAGE(PG8_SB(1, 1), b3 + hstep, voffB); PG8_STAGE(PG8_SA(1, 0), a3, voffA);
            PG8_WAIT_V(8); PG8_WAIT_L(0); PG8_BAR; PG8_MMA(1, 0, At, B0); PG8_MMA(1, 1, At, B1); PG8_BAR; PG8_SCHED;
            } else {
            PG8_LDB(B0, 0, 0); PG8_SCHED; PG8_LDA(At, 0, 0); PG8_STAGE(PG8_SA(1, 1), a1 + hstep, voffA);
            PG8_WAIT_L(8); PG8_BAR; PG8_WAIT_L(0); PG8_MMA(0, 0, At, B0); PG8_BAR; PG8_SCHED;
            PG8_LDB(B1, 0, 1); PG8_STAGE(PG8_SB(0, 0), b2, voffB);
            PG8_BAR; PG8_WAIT_L(0); PG8_MMA(0, 1, At, B1); PG8_BAR;
            PG8_LDA(At, 0, 1); PG8_STAGE(PG8_SA(0, 0), a2, voffA);
            PG8_BAR; PG8_WAIT_L(0); PG8_MMA(1, 0, At, B0); PG8_BAR; PG8_SCHED;
            PG8_STAGE(PG8_SB(0, 1), b2 + hstep, voffB);
            PG8_WAIT_V(6); PG8_BAR; PG8_MMA(1, 1, At, B1); PG8_BAR;
            PG8_LDB(B0, 1, 0); PG8_SCHED; PG8_LDA(At, 1, 0); PG8_STAGE(PG8_SA(0, 1), a2 + hstep, voffA);
            PG8_WAIT_L(8); PG8_BAR; PG8_WAIT_L(0); PG8_MMA(0, 0, At, B0); PG8_BAR; PG8_SCHED;
            PG8_LDB(B1, 1, 1); PG8_STAGE(PG8_SB(1, 0), b3, voffB);
            PG8_BAR; PG8_WAIT_L(0); PG8_MMA(0, 1, At, B1); PG8_BAR;
            PG8_LDA(At, 1, 1); PG8_STAGE(PG8_SA(1, 0), a3, voffA);
            PG8_BAR; PG8_WAIT_L(0); PG8_MMA(1, 0, At, B0); PG8_BAR; PG8_SCHED;
            PG8_STAGE(PG8_SB(1, 1), b3 + hstep, voffB);
            PG8_WAIT_V(6); PG8_BAR; PG8_MMA(1, 1, At, B1); PG8_BAR;
            }
        }
        if constexpr (ALIGN_EPI) { if (wr == 0) PG8_BAR; }
        if constexpr (!Epi::AFTER_DRAIN) { E(acc, cur, wr, wc, fr, fq); S.done(cur); }
        if (!has_next) break;
#pragma unroll
        for (int a = 0; a < 2; ++a)
#pragma unroll
            for (int b = 0; b < 2; ++b)
#pragma unroll
                for (int m = 0; m < 4; ++m)
#pragma unroll
                    for (int n = 0; n < 2; ++n) acc[a][b][m][n] = (f32x4){0.f, 0.f, 0.f, 0.f};
        cur = nxt; cA = nA; cB = nB; ++ui;
        if constexpr (ALIGN_EPI) { if (wr == 1) PG8_BAR; }
    }
    PG8_WAIT_V(0);
    if constexpr (!ALIGN_EPI) { if (wr == 0) PG8_BAR; }
    PG8_BAR;
    if constexpr (Epi::AFTER_DRAIN) { E.fused(acc, cur, wr, wc, fr, fq, lds, wid, lane); S.done(cur); }
#undef PG8_SA
#undef PG8_SB
#undef PG8_STAGE
#undef PG8_LDA
#undef PG8_LDB
#undef PG8_MMA
#undef PG8_WAIT_V
#undef PG8_WAIT_L
#undef PG8_BAR
#undef PG8_SCHED
}
}
using pg8::cvt_pk_bf16;
__device__ __forceinline__ u32x4 pack8(const f32x4 a, const f32x4 b) { u32x4 w; w.x = cvt_pk_bf16(a[0], a[1]); w.y = cvt_pk_bf16(a[2], a[3]); w.z = cvt_pk_bf16(b[0], b[1]); w.w = cvt_pk_bf16(b[2], b[3]); return w; }
__device__ __forceinline__ void unpack8(const u32x4 w, f32x4& a, f32x4& b) { a = (f32x4){bflo(w.x), bfhi(w.x), bflo(w.y), bfhi(w.y)}; b = (f32x4){bflo(w.z), bfhi(w.z), bflo(w.w), bfhi(w.w)}; }
__device__ __forceinline__ float sum4sq(const f32x4 v) { return (v[0] * v[0] + v[1] * v[1]) + (v[2] * v[2] + v[3] * v[3]); }
__device__ __forceinline__ f32x4 sig4(const f32x4 v) { return (f32x4){sigmoidf_(v[0]), sigmoidf_(v[1]), sigmoidf_(v[2]), sigmoidf_(v[3])}; }

__device__ __forceinline__ void conv_item(const float* __restrict__ W, int ldw, int Ksrc, bf16_t* __restrict__ WT, int Kdst, const float* __restrict__ gain, LAS float* scr, int kb, int nb, int src, int lane) {
    const int k0 = 64 * kb;
    const bool live = (src >= 0) && (k0 < Ksrc);
#pragma unroll 8
    for (int i = 0; i < 32; ++i) { const int kk = 2 * i + (lane >> 5); scr[kk * 33 + (lane & 31)] = live ? W[(size_t)(k0 + kk) * ldw + src] : 0.f; }
    asm volatile("s_waitcnt lgkmcnt(0)" ::: "memory");
    const int c = lane & 7;
    f32x4 g0 = (f32x4){1.f, 1.f, 1.f, 1.f}, g1 = g0;
    if (gain && k0 < Ksrc) { g0 = *(const f32x4*)(gain + k0 + 8 * c); g1 = *(const f32x4*)(gain + k0 + 8 * c + 4); }
#pragma unroll
    for (int j = 0; j < 4; ++j) { const int n = (lane >> 3) + 8 * j; const LAS float* s = scr + (8 * c) * 33 + n;
        u32x4 o; o.x = cvt_pk_bf16(s[0 * 33] * g0[0], s[1 * 33] * g0[1]); o.y = cvt_pk_bf16(s[2 * 33] * g0[2], s[3 * 33] * g0[3]); o.z = cvt_pk_bf16(s[4 * 33] * g1[0], s[5 * 33] * g1[1]); o.w = cvt_pk_bf16(s[6 * 33] * g1[2], s[7 * 33] * g1[3]);
        *(u32x4*)(WT + (size_t)(32 * nb + n) * Kdst + k0 + 8 * c) = o; }
    asm volatile("s_waitcnt lgkmcnt(0)" ::: "memory");
}
__device__ __forceinline__ int lcol(int rho) { return (rho & ~31) + pg8::perm32(rho & 31); }
__device__ __forceinline__ void conv_plain(const Ctx& c, LAS float* scr, const float* W, int Ksrc, int Nsrc, bf16_t* WT, int Kdst, const float* gain) {
    const int nK = Kdst / 64, nN = Nsrc / 32, items = nK * nN;
    for (int it = c.gw; it < items; it += c.NGW) { const int kb = it / nN, nb = it % nN; conv_item(W, Nsrc, Ksrc, WT, Kdst, gain, scr, kb, nb, lcol(32 * nb + (c.lane & 31)), c.lane); }
}
__device__ __forceinline__ void conv_gateup(const Ctx& c, LAS float* scr, const float* Wg, const float* Wu, int FF, bf16_t* WT, const float* gain) {
    const int nK = D / 64, nN = 2 * FF / 32, items = nK * nN;
    for (int it = c.gw; it < items; it += c.NGW) { const int kb = it / nN, nb = it % nN; const int rho = 32 * nb + (c.lane & 31); const int t = rho >> 8, half = (rho >> 7) & 1, w = rho & 127;
        conv_item(half ? Wu : Wg, FF, D, WT, D, gain, scr, kb, nb, 128 * t + lcol(w), c.lane); }
}
__device__ __forceinline__ int proj_src(int L) { return L < 416 ? L : (L < 512 ? -1 : L - 96); }
__device__ __forceinline__ void conv_proj(const Ctx& c, LAS float* scr, const float* W, bf16_t* WT, const float* gain) {
    const int nK = D / 64, nN = 3072 / 32, items = nK * nN;
    for (int it = c.gw; it < items; it += c.NGW) { const int kb = it / nN, nb = it % nN; conv_item(W, INC, D, WT, D, gain, scr, kb, nb, proj_src(lcol(32 * nb + (c.lane & 31))), c.lane); }
}
__device__ __forceinline__ void f_xbss(const Ctx& c, const float* __restrict__ x, bf16_t* __restrict__ xb, unsigned long long* __restrict__ xss) {
    for (int row = c.gw; row < T; row += c.NGW) {
        const f32x4* xr = (const f32x4*)(x + (size_t)row * D) + 2 * c.lane;
        float s = 0.f;
#pragma unroll
        for (int j = 0; j < 2; ++j) { const f32x4 a = xr[128 * j], b = xr[128 * j + 1]; s += sum4sq(a) + sum4sq(b); *((u32x4*)(xb + (size_t)row * D) + c.lane + 64 * j) = pack8(a, b); }
        s = wave_sum(s, c.lane);
        if (c.lane == 0) xss[row] = (unsigned long long)(s * 65536.f + 0.5f);
    }
}

typedef unsigned long long u64;
__device__ __forceinline__ u64 ss_fix(float s) { return (u64)(s * 65536.f + 0.5f); }
__device__ __forceinline__ float ss_val(u64 v) { return (float)v * (1.f / 65536.f); }
#define EPI_ROW(un, ai, m) ((un).pm * 256 + (ai) * 128 + wr * 64 + (m) * 16 + fr)
struct EpiProjF {
    static constexpr bool PERM = false, AFTER_DRAIN = false;
    const u64* xss; const float* bias; bf16_t* qlat; bf16_t* kvlat; bf16_t* u; bf16_t* ga; bf16_t* gb; u64* qss; u64* kvss; float* krss;
    __device__ __forceinline__ void operator()(const f32x4 (&acc)[2][2][4][2], const pg8::Unit& un, int wr, int wc, int fr, int fq) const { auto xss_ = xss; asm volatile("" : "+s"(xss_)); auto bias_ = bias; asm volatile("" : "+s"(bias_)); auto qlat_ = qlat; asm volatile("" : "+s"(qlat_)); auto kvlat_ = kvlat; asm volatile("" : "+s"(kvlat_)); auto u_ = u; asm volatile("" : "+s"(u_)); auto ga_ = ga; asm volatile("" : "+s"(ga_)); auto gb_ = gb; asm volatile("" : "+s"(gb_)); auto qss_ = qss; asm volatile("" : "+s"(qss_)); auto kvss_ = kvss; asm volatile("" : "+s"(kvss_)); auto krss_ = krss; asm volatile("" : "+s"(krss_));
        const int pn = un.pn, cl = wc * 32 + 8 * fq;
        f32x4 bv[2][2];
#pragma unroll
        for (int bj = 0; bj < 2; ++bj)
#pragma unroll
            for (int n = 0; n < 2; ++n) bv[bj][n] = *(const f32x4*)(bias_ + pn * 256 + bj * 128 + cl + 4 * n);
#pragma unroll
        for (int ai = 0; ai < 2; ++ai)
#pragma unroll
            for (int m = 0; m < 4; ++m) {
                const int row = EPI_ROW(un, ai, m);
                const float r = rsqrtf(ss_val(xss_[row]) * (1.f / D) + EPS);
                f32x4 v[2][2];
#pragma unroll
                for (int bj = 0; bj < 2; ++bj)
#pragma unroll
                    for (int n = 0; n < 2; ++n) v[bj][n] = acc[ai][bj][m][n] * r + bv[bj][n];
                if (pn == 0) {
                    *(u32x4*)(qlat_ + (size_t)row * 256 + cl) = pack8(v[0][0], v[0][1]); *(u32x4*)(qlat_ + (size_t)row * 256 + 128 + cl) = pack8(v[1][0], v[1][1]);
                    float s = (sum4sq(v[0][0]) + sum4sq(v[0][1])) + (sum4sq(v[1][0]) + sum4sq(v[1][1]));
                    s = xadd<32>(xadd<16>(s, fq * 16 + fr), fq * 16 + fr);
                    if (fq == 0) atomicAdd(qss_ + row, ss_fix(s));
                } else if (pn == 1) {
                    *(u32x4*)(kvlat_ + (size_t)row * 256 + cl) = pack8(v[0][0], v[0][1]); *(u32x4*)(kvlat_ + (size_t)row * 256 + 128 + cl) = pack8(v[1][0], v[1][1]);
                    float s = sum4sq(v[0][0]) + sum4sq(v[0][1]);
                    s = xadd<32>(xadd<16>(s, fq * 16 + fr), fq * 16 + fr);
                    if (fq == 0) atomicAdd(kvss_ + row, ss_fix(s));
                    if (wc == 0) { float s2 = sum4sq(v[1][0]) + sum4sq(v[1][1]); s2 = xadd<32>(xadd<16>(s2, fq * 16 + fr), fq * 16 + fr); if (fq == 0) krss_[row] = s2; }
                } else if (pn < 4) {
                    bf16_t* p = u_ + (size_t)row * 512 + (pn - 2) * 256 + cl;
                    *(u32x4*)p = pack8(v[0][0], v[0][1]); *(u32x4*)(p + 128) = pack8(v[1][0], v[1][1]);
                } else {
                    bf16_t* p = (pn < 8 ? ga_ + (size_t)row * 1024 + (pn - 4) * 256 : gb_ + (size_t)row * 1024 + (pn - 8) * 256) + cl;
                    *(u32x4*)p = pack8(sig4(v[0][0]), sig4(v[0][1])); *(u32x4*)(p + 128) = pack8(sig4(v[1][0]), sig4(v[1][1]));
                }
            }
    }
};
struct EpiRowScale {
    static constexpr bool PERM = false, AFTER_DRAIN = false;
    bf16_t* O; const u64* ss; int ldc; float invn;
    __device__ __forceinline__ void operator()(const f32x4 (&acc)[2][2][4][2], const pg8::Unit& un, int wr, int wc, int fr, int fq) const { auto O_ = O; asm volatile("" : "+s"(O_)); auto ss_ = ss; asm volatile("" : "+s"(ss_));
        const int c0 = un.pn * 256 + wc * 32 + 8 * fq;
#pragma unroll
        for (int ai = 0; ai < 2; ++ai)
#pragma unroll
            for (int m = 0; m < 4; ++m) { const int row = EPI_ROW(un, ai, m); const float r = rsqrtf(ss_val(ss_[row]) * invn + EPS);
#pragma unroll
                for (int bj = 0; bj < 2; ++bj) *(u32x4*)(O_ + (size_t)row * ldc + c0 + bj * 128) = pack8(acc[ai][bj][m][0] * r, acc[ai][bj][m][1] * r); }
    }
};
struct EpiGluF {
    static constexpr bool PERM = false, AFTER_DRAIN = false;
    const bf16_t* yg; const float* b; bf16_t* out;
    __device__ __forceinline__ void operator()(const f32x4 (&acc)[2][2][4][2], const pg8::Unit& un, int wr, int wc, int fr, int fq) const { auto yg_ = yg; asm volatile("" : "+s"(yg_)); auto b_ = b; asm volatile("" : "+s"(b_)); auto out_ = out; asm volatile("" : "+s"(out_));
        const int c0 = un.pn * 256 + wc * 32 + 8 * fq;
        f32x4 bv[2][2];
#pragma unroll
        for (int bj = 0; bj < 2; ++bj)
#pragma unroll
            for (int n = 0; n < 2; ++n) bv[bj][n] = *(const f32x4*)(b_ + c0 + bj * 128 + 4 * n);
#pragma unroll
        for (int ai = 0; ai < 2; ++ai)
#pragma unroll
            for (int m = 0; m < 4; ++m) { const int row = EPI_ROW(un, ai, m);
#pragma unroll
                for (int bj = 0; bj < 2; ++bj) { const size_t o = (size_t)row * 512 + c0 + bj * 128; f32x4 y0, y1; unpack8(*(const u32x4*)(yg_ + o), y0, y1);
                    *(u32x4*)(out_ + o) = pack8(y0 * sig4(acc[ai][bj][m][0] + bv[bj][0]), y1 * sig4(acc[ai][bj][m][1] + bv[bj][1])); } }
    }
};
template <bool SECOND> struct EpiMixF {
    static constexpr bool PERM = false, AFTER_DRAIN = false;
    const bf16_t* gate; const bf16_t* tmp; bf16_t* out;
    __device__ __forceinline__ void operator()(const f32x4 (&acc)[2][2][4][2], const pg8::Unit& un, int wr, int wc, int fr, int fq) const { auto gate_ = gate; asm volatile("" : "+s"(gate_)); auto tmp_ = tmp; asm volatile("" : "+s"(tmp_)); auto out_ = out; asm volatile("" : "+s"(out_));
        const int c0 = un.pn * 256 + wc * 32 + 8 * fq;
#pragma unroll
        for (int ai = 0; ai < 2; ++ai)
#pragma unroll
            for (int m = 0; m < 4; ++m) { const int row = EPI_ROW(un, ai, m);
#pragma unroll
                for (int bj = 0; bj < 2; ++bj) { const size_t o = (size_t)row * 1024 + c0 + bj * 128; f32x4 g0, g1; unpack8(*(const u32x4*)(gate_ + o), g0, g1);
                    f32x4 r0 = g0 * acc[ai][bj][m][0], r1 = g1 * acc[ai][bj][m][1];
                    if (SECOND) { f32x4 t0, t1; unpack8(*(const u32x4*)(tmp_ + o), t0, t1); r0 = r0 + t0; r1 = r1 + t1; }
                    *(u32x4*)(out_ + o) = pack8(r0, r1); } }
    }
};
struct EpiResidF {
    static constexpr bool PERM = false, AFTER_DRAIN = false;
    const float* xin; float* xout; bf16_t* xb; u64* xssn;
    __device__ __forceinline__ void operator()(const f32x4 (&acc)[2][2][4][2], const pg8::Unit& un, int wr, int wc, int fr, int fq) const { auto xin_ = xin; asm volatile("" : "+s"(xin_)); auto xout_ = xout; asm volatile("" : "+s"(xout_)); auto xb_ = xb; asm volatile("" : "+s"(xb_)); auto xssn_ = xssn; asm volatile("" : "+s"(xssn_));
        const int c0 = un.pn * 256 + wc * 32 + 8 * fq;
#pragma unroll
        for (int ai = 0; ai < 2; ++ai)
#pragma unroll
            for (int m = 0; m < 4; ++m) { const int row = EPI_ROW(un, ai, m); float s = 0.f;
#pragma unroll
                for (int bj = 0; bj < 2; ++bj) { const size_t o = (size_t)row * 1024 + c0 + bj * 128;
                    const f32x4 y0 = *(const f32x4*)(xin_ + o) + acc[ai][bj][m][0], y1 = *(const f32x4*)(xin_ + o + 4) + acc[ai][bj][m][1];
                    *(f32x4*)(xout_ + o) = y0; *(f32x4*)(xout_ + o + 4) = y1; *(u32x4*)(xb_ + o) = pack8(y0, y1); s += sum4sq(y0) + sum4sq(y1); }
                s = xadd<32>(xadd<16>(s, fq * 16 + fr), fq * 16 + fr);
                if (fq == 0) atomicAdd(xssn_ + row, ss_fix(s)); }
    }
};
struct EpiSwigluF {
    static constexpr bool PERM = false, AFTER_DRAIN = false;
    bf16_t* h; const u64* xss; const int* rowtok; int ldh; int tiles_per_group;
    __device__ __forceinline__ void operator()(const f32x4 (&acc)[2][2][4][2], const pg8::Unit& un, int wr, int wc, int fr, int fq) const { auto h_ = h; asm volatile("" : "+s"(h_)); auto xss_ = xss; asm volatile("" : "+s"(xss_)); auto rowtok_ = rowtok; asm volatile("" : "+s"(rowtok_));
        const int c0 = (un.pn % tiles_per_group) * 128 + wc * 32 + 8 * fq;
#pragma unroll
        for (int ai = 0; ai < 2; ++ai)
#pragma unroll
            for (int m = 0; m < 4; ++m) { const int row = EPI_ROW(un, ai, m); int tok = row; if (rowtok_) { tok = rowtok_[row]; tok = tok < 0 ? 0 : tok; }
                const float r = rsqrtf(ss_val(xss_[tok]) * (1.f / D) + EPS);
                f32x4 o[2];
#pragma unroll
                for (int n = 0; n < 2; ++n) { const f32x4 g = acc[ai][0][m][n] * r, uu = acc[ai][1][m][n] * r; o[n] = (f32x4){siluf_(g[0]) * uu[0], siluf_(g[1]) * uu[1], siluf_(g[2]) * uu[2], siluf_(g[3]) * uu[3]}; }
                *(u32x4*)(h_ + (size_t)row * ldh + c0) = pack8(o[0], o[1]); }
    }
};
struct EpiStoreBf16 {
    static constexpr bool PERM = false, AFTER_DRAIN = false;
    bf16_t* O; int ldc; int tiles_per_group;
    __device__ __forceinline__ void operator()(const f32x4 (&acc)[2][2][4][2], const pg8::Unit& un, int wr, int wc, int fr, int fq) const { auto O_ = O; asm volatile("" : "+s"(O_));
        const int c0 = (un.pn % tiles_per_group) * 256 + wc * 32 + 8 * fq;
#pragma unroll
        for (int ai = 0; ai < 2; ++ai)
#pragma unroll
            for (int m = 0; m < 4; ++m) { const int row = EPI_ROW(un, ai, m);
#pragma unroll
                for (int bj = 0; bj < 2; ++bj) *(u32x4*)(O_ + (size_t)row * ldc + c0 + bj * 128) = pack8(acc[ai][bj][m][0], acc[ai][bj][m][1]); }
    }
};

__device__ __forceinline__ void f_heads(const Ctx& c, const bf16_t* __restrict__ qraw, const bf16_t* __restrict__ kvraw, const bf16_t* __restrict__ kvlat, const float* __restrict__ krss,
                                        const float* __restrict__ gq, const float* __restrict__ gk, bf16_t* __restrict__ Qn, bf16_t* __restrict__ Kn, bf16_t* __restrict__ Vn) {
    const int lane = c.lane, h = lane >> 3, sub = lane & 7;
    const int d0 = sub < 4 ? 16 * sub : 64 + 4 * (sub - 4);
    float gqv[16], gkv[16];
#pragma unroll
    for (int i = 0; i < 16; ++i) { const int d = sub < 4 ? d0 + i : (i < 4 ? d0 + i : (i < 8 ? d0 + 16 + (i - 4) : d0)); gqv[i] = gq[d]; gkv[i] = gk[d]; }
    for (int t = c.gw; t < T; t += c.NGW) {
        const int b = t / SEQ, s = t % SEQ;
        const size_t orow = ((size_t)(b * NH + h) * SEQ + s);
        float cs[4], sn[4];
        if (sub >= 4) {
#pragma unroll
            for (int j = 0; j < 4; ++j) sincos_rev((double)s * c_invrev[4 * (sub - 4) + j], sn[j], cs[j]);
        }
        {
            float v[16];
            const bf16_t* qp = qraw + (size_t)t * 768 + h * 96 + d0;
            if (sub < 4) { f32x4 a, bb; unpack8(*(const u32x4*)qp, a, bb); f32x4 c2, d2; unpack8(*(const u32x4*)(qp + 8), c2, d2);
#pragma unroll
                for (int i = 0; i < 4; ++i) { v[i] = a[i]; v[4 + i] = bb[i]; v[8 + i] = c2[i]; v[12 + i] = d2[i]; } }
            else { const uint2 w0 = *(const uint2*)qp, w1 = *(const uint2*)(qp + 16);
                v[0] = bflo(w0.x); v[1] = bfhi(w0.x); v[2] = bflo(w0.y); v[3] = bfhi(w0.y); v[4] = bflo(w1.x); v[5] = bfhi(w1.x); v[6] = bflo(w1.y); v[7] = bfhi(w1.y);
#pragma unroll
                for (int i = 8; i < 16; ++i) v[i] = 0.f; }
            float ss = 0.f;
#pragma unroll
            for (int i = 0; i < 16; ++i) ss += v[i] * v[i];
            ss = xadd<4>(xadd<2>(xadd<1>(ss, lane), lane), lane);
            const float r = rsqrtf(ss * (1.f / 96.f) + EPS) * QSCALE;
#pragma unroll
            for (int i = 0; i < 16; ++i) v[i] = v[i] * r * gqv[i];
            bf16_t* op = Qn + orow * 96 + d0;
            if (sub < 4) { *(u32x4*)op = pack8((f32x4){v[0], v[1], v[2], v[3]}, (f32x4){v[4], v[5], v[6], v[7]}); *(u32x4*)(op + 8) = pack8((f32x4){v[8], v[9], v[10], v[11]}, (f32x4){v[12], v[13], v[14], v[15]}); }
            else { float o1[4], o2[4];
#pragma unroll
                for (int j = 0; j < 4; ++j) { o1[j] = v[j] * cs[j] - v[4 + j] * sn[j]; o2[j] = v[4 + j] * cs[j] + v[j] * sn[j]; }
                *(uint2*)op = make_uint2(cvt_pk_bf16(o1[0], o1[1]), cvt_pk_bf16(o1[2], o1[3])); *(uint2*)(op + 16) = make_uint2(cvt_pk_bf16(o2[0], o2[1]), cvt_pk_bf16(o2[2], o2[3])); }
        }
        {
            float v[16];
            if (sub < 4) { const bf16_t* kp = kvraw + (size_t)t * 1024 + h * 128 + d0; f32x4 a, bb; unpack8(*(const u32x4*)kp, a, bb); f32x4 c2, d2; unpack8(*(const u32x4*)(kp + 8), c2, d2);
#pragma unroll
                for (int i = 0; i < 4; ++i) { v[i] = a[i]; v[4 + i] = bb[i]; v[8 + i] = c2[i]; v[12 + i] = d2[i]; } }
            else { const bf16_t* kp = kvlat + (size_t)t * 256 + 128 + 4 * (sub - 4); const uint2 w0 = *(const uint2*)kp, w1 = *(const uint2*)(kp + 16);
                v[0] = bflo(w0.x); v[1] = bfhi(w0.x); v[2] = bflo(w0.y); v[3] = bfhi(w0.y); v[4] = bflo(w1.x); v[5] = bfhi(w1.x); v[6] = bflo(w1.y); v[7] = bfhi(w1.y);
#pragma unroll
                for (int i = 8; i < 16; ++i) v[i] = 0.f; }
            float ss = 0.f;
            if (sub < 4) {
#pragma unroll
                for (int i = 0; i < 16; ++i) ss += v[i] * v[i]; }
            ss = xadd<4>(xadd<2>(xadd<1>(ss, lane), lane), lane);
            const float r = rsqrtf((ss + krss[t]) * (1.f / 96.f) + EPS);
#pragma unroll
            for (int i = 0; i < 16; ++i) v[i] = v[i] * r * gkv[i];
            bf16_t* op = Kn + orow * 96 + d0;
            if (sub < 4) { *(u32x4*)op = pack8((f32x4){v[0], v[1], v[2], v[3]}, (f32x4){v[4], v[5], v[6], v[7]}); *(u32x4*)(op + 8) = pack8((f32x4){v[8], v[9], v[10], v[11]}, (f32x4){v[12], v[13], v[14], v[15]}); }
            else { float o1[4], o2[4];
#pragma unroll
                for (int j = 0; j < 4; ++j) { o1[j] = v[j] * cs[j] - v[4 + j] * sn[j]; o2[j] = v[4 + j] * cs[j] + v[j] * sn[j]; }
                *(uint2*)op = make_uint2(cvt_pk_bf16(o1[0], o1[1]), cvt_pk_bf16(o1[2], o1[3])); *(uint2*)(op + 16) = make_uint2(cvt_pk_bf16(o2[0], o2[1]), cvt_pk_bf16(o2[2], o2[3])); }
        }
        *(u32x4*)(Vn + orow * 64 + 8 * sub) = *(const u32x4*)(kvraw + (size_t)t * 1024 + h * 128 + 64 + 8 * sub);
    }
}
namespace pg8 {
template <class Epi, class Sched>
__device__ __forceinline__ void gemm_phase_gather(PG8_LAS unsigned char* lds, const Gemm g, const int* __restrict__ rowtok, const Sched& S, const Epi& E, const int tid) {
    const int wid = __builtin_amdgcn_readfirstlane(tid >> 6), lane = tid & 63, wr = wid >> 2, wc = wid & 3, fr = lane & 15, fq = lane >> 4;
    const int K = g.K, nt = K / BK;
    int RA[2]; unsigned CA[2], voffB[2];
#pragma unroll
    for (int i = 0; i < 2; ++i) { int R, C; stage_rc(tid * 16 + i * 8192, R, C); RA[i] = R; CA[i] = (unsigned)C * 2u; voffB[i] = (unsigned)(R * K + C) * 2u; }
    const size_t kstep = (size_t)(BK * 2);
    const size_t hstep = (size_t)HALF * K * 2;
    const size_t tstep = 2 * hstep;
    const unsigned ldsw = (unsigned)wid * 1024u;
    const int aoff = lds_byte(wr * 64 + fr, fq * 8), boff = lds_byte(wc * 32 + fr, fq * 8);
#define PG8_SA(b, h) (((b) * 2 + (h)) * HTB)
#define PG8_SB(b, h) ((4 + (b) * 2 + (h)) * HTB)
#define PG8_STAGE(bufoff, gbase, voff) do { _Pragma("unroll") for (int _i = 0; _i < 2; ++_i) \
        __builtin_amdgcn_global_load_lds((const unsigned*)((const char*)(gbase) + (voff)[_i]), (PG8_LAS unsigned*)(lds + (bufoff) + ldsw + _i * 8192), 16, 0, 0); } while (0)
#define PG8_LDA(dst, b, h) do { _Pragma("unroll") for (int m = 0; m < 4; ++m) _Pragma("unroll") for (int k = 0; k < 2; ++k) dst[m][k] = *(const PG8_LAS bf16x8*)(lds + PG8_SA(b, h) + aoff + m * 2048 + k * 1024); } while (0)
#define PG8_LDB(dst, b, h) do { _Pragma("unroll") for (int n = 0; n < 2; ++n) _Pragma("unroll") for (int k = 0; k < 2; ++k) dst[n][k] = *(const PG8_LAS bf16x8*)(lds + PG8_SB(b, h) + boff + n * 2048 + k * 1024); } while (0)
#define PG8_MMA(ai, bj, At, Bt) do { __builtin_amdgcn_s_setprio(1); _Pragma("unroll") for (int m = 0; m < 4; ++m) _Pragma("unroll") for (int n = 0; n < 2; ++n) _Pragma("unroll") for (int k = 0; k < 2; ++k) \
        acc[ai][bj][m][n] = __builtin_amdgcn_mfma_f32_16x16x32_bf16(Bt[n][k], At[m][k], acc[ai][bj][m][n], 0, 0, 0); __builtin_amdgcn_s_setprio(0); } while (0)
#define PG8_WAIT_V(n) asm volatile("s_waitcnt vmcnt(" #n ")" ::: "memory")
#define PG8_WAIT_L(n) asm volatile("s_waitcnt lgkmcnt(" #n ")" ::: "memory")
#define PG8_BAR __builtin_amdgcn_s_barrier()
#define PG8_SCHED __builtin_amdgcn_sched_barrier(0)
#define PG8_GVOFF(u, v0, v1) do { _Pragma("unroll") for (int _i = 0; _i < 2; ++_i) { int t0_ = rowtok[(u).pm * BM + RA[_i]], t1_ = rowtok[(u).pm * BM + HALF + RA[_i]]; t0_ = t0_ < 0 ? 0 : t0_; t1_ = t1_ < 0 ? 0 : t1_; \
        v0[_i] = (unsigned)t0_ * (unsigned)(K * 2) + CA[_i]; v1[_i] = (unsigned)t1_ * (unsigned)(K * 2) + CA[_i]; } } while (0)
    Unit cur, nxt; int ui = 0;
    if (!S.next(0, cur)) return;
    f32x4 acc[2][2][4][2];
#pragma unroll
    for (int a = 0; a < 2; ++a)
#pragma unroll
        for (int b = 0; b < 2; ++b)
#pragma unroll
            for (int m = 0; m < 4; ++m)
#pragma unroll
                for (int n = 0; n < 2; ++n) acc[a][b][m][n] = (f32x4){0.f, 0.f, 0.f, 0.f};
    bf16x8 At[4][2], B0[2][2], B1[2][2];
    const char* gA = (const char*)g.A; const char* cB = (const char*)g.Bt + (size_t)cur.pn * tstep;
    unsigned cv0[2], cv1[2], nv0[2], nv1[2];
    PG8_GVOFF(cur, cv0, cv1);
    S.a_ready(cur);
    PG8_STAGE(PG8_SB(0, 0), cB, voffB); PG8_STAGE(PG8_SB(0, 1), cB + hstep, voffB); PG8_STAGE(PG8_SA(0, 0), gA, cv0); PG8_STAGE(PG8_SA(0, 1), gA, cv1);
    if (wr == 1) PG8_BAR;
    PG8_WAIT_V(2); PG8_BAR;
    PG8_STAGE(PG8_SB(1, 0), cB + kstep, voffB); PG8_STAGE(PG8_SA(1, 0), gA + kstep, cv0); PG8_STAGE(PG8_SB(1, 1), cB + hstep + kstep, voffB);
    PG8_WAIT_V(6); PG8_BAR;
    for (;;) {
        const bool has_next = S.next(ui + 1, nxt);
        const char* nB = has_next ? (const char*)g.Bt + (size_t)nxt.pn * tstep : cB;
        if (has_next) { PG8_GVOFF(nxt, nv0, nv1); } else {
#pragma unroll
            for (int i = 0; i < 2; ++i) { nv0[i] = cv0[i]; nv1[i] = cv1[i]; } }
        for (int t = 0; t < nt; t += 2) {
            const bool last = (t == nt - 2);
            const char* a1 = gA + (size_t)(t + 1) * kstep;
            const char* a2 = last ? gA : gA + (size_t)(t + 2) * kstep; const char* b2 = last ? nB : cB + (size_t)(t + 2) * kstep;
            const char* a3 = a2 + kstep; const char* b3 = b2 + kstep;
            unsigned s0[2], s1[2];
#pragma unroll
            for (int i = 0; i < 2; ++i) { s0[i] = last ? nv0[i] : cv0[i]; s1[i] = last ? nv1[i] : cv1[i]; }
            if (last && has_next) S.a_ready(nxt);
            PG8_LDB(B0, 0, 0); PG8_LDB(B1, 0, 1); PG8_SCHED; PG8_LDA(At, 0, 0); PG8_STAGE(PG8_SA(1, 1), a1, cv1);
            PG8_WAIT_V(8); PG8_WAIT_L(0); PG8_BAR; PG8_MMA(0, 0, At, B0); PG8_MMA(0, 1, At, B1); PG8_BAR; PG8_SCHED;
            PG8_LDA(At, 0, 1); PG8_STAGE(PG8_SB(0, 0), b2, voffB); PG8_STAGE(PG8_SB(0, 1), b2 + hstep, voffB); PG8_STAGE(PG8_SA(0, 0), a2, s0);
            PG8_WAIT_V(8); PG8_WAIT_L(0); PG8_BAR; PG8_MMA(1, 0, At, B0); PG8_MMA(1, 1, At, B1); PG8_BAR; PG8_SCHED;
            PG8_LDB(B0, 1, 0); PG8_LDB(B1, 1, 1); PG8_SCHED; PG8_LDA(At, 1, 0); PG8_STAGE(PG8_SA(0, 1), a2, s1);
            PG8_WAIT_V(8); PG8_WAIT_L(0); PG8_BAR; PG8_MMA(0, 0, At, B0); PG8_MMA(0, 1, At, B1); PG8_BAR; PG8_SCHED;
            PG8_LDA(At, 1, 1); PG8_STAGE(PG8_SB(1, 0), b3, voffB); PG8_STAGE(PG8_SB(1, 1), b3 + hstep, voffB); PG8_STAGE(PG8_SA(1, 0), a3, s0);
            PG8_WAIT_V(8); PG8_WAIT_L(0); PG8_BAR; PG8_MMA(1, 0, At, B0); PG8_MMA(1, 1, At, B1); PG8_BAR; PG8_SCHED;
        }
        if (wr == 0) PG8_BAR;
        E(acc, cur, wr, wc, fr, fq); S.done(cur);
        if (!has_next) break;
#pragma unroll
        for (int a = 0; a < 2; ++a)
#pragma unroll
            for (int b = 0; b < 2; ++b)
#pragma unroll
                for (int m = 0; m < 4; ++m)
#pragma unroll
                    for (int n = 0; n < 2; ++n) acc[a][b][m][n] = (f32x4){0.f, 0.f, 0.f, 0.f};
        cur = nxt; cB = nB; ++ui;
#pragma unroll
        for (int i = 0; i < 2; ++i) { cv0[i] = nv0[i]; cv1[i] = nv1[i]; }
        if (wr == 1) PG8_BAR;
    }
    PG8_WAIT_V(0);
    PG8_BAR;
#undef PG8_SA
#undef PG8_SB
#undef PG8_STAGE
#undef PG8_LDA
#undef PG8_LDB
#undef PG8_MMA
#undef PG8_WAIT_V
#undef PG8_WAIT_L
#undef PG8_BAR
#undef PG8_SCHED
#undef PG8_GVOFF
}
struct MoeOrder : StaticOrder {
    const int* tile_e; int per_e;
    __device__ __forceinline__ bool next(int i, Unit& u) const { if (!StaticOrder::next(i, u)) return false; u.pn += tile_e[u.pm] * per_e; return true; }
};
}

__device__ __forceinline__ void f_route1(const Ctx& c, const float* __restrict__ x, const float* __restrict__ g, const float* __restrict__ rw, const float* __restrict__ rb,
                                         int* __restrict__ tope, float* __restrict__ topw, int* __restrict__ rank, int* __restrict__ cnt, int* __restrict__ rowtok) {
    for (int r = blockIdx.x * NTHREADS + c.tid; r < RCAP; r += c.G * NTHREADS) rowtok[r] = -1;
    LAS int* le = (LAS int*)c.lds;
    for (int ck = blockIdx.x; ck < T / 64; ck += c.G) {
        for (int j = 0; j < 8; ++j) {
            const int tl = c.wave * 8 + j, t = ck * 64 + tl;
            const float* xr = x + (size_t)t * D;
            float h[16]; float s = 0.f;
#pragma unroll
            for (int q = 0; q < 16; ++q) { h[q] = xr[c.lane + 64 * q]; s += h[q] * h[q]; }
            const float r = rsqrtf(wave_sum(s, c.lane) * (1.f / D) + EPS);
            float lg[8];
#pragma unroll
            for (int e = 0; e < 8; ++e) lg[e] = 0.f;
#pragma unroll
            for (int q = 0; q < 16; ++q) { const int k = c.lane + 64 * q; const float hv = h[q] * r * g[k];
#pragma unroll
                for (int e = 0; e < 8; ++e) lg[e] += hv * rw[k * 8 + e]; }
#pragma unroll
            for (int e = 0; e < 8; ++e) lg[e] = wave_sum(lg[e], c.lane) + rb[e];
            int e0 = 0; float v0 = lg[0];
#pragma unroll
            for (int e = 1; e < 8; ++e) if (lg[e] > v0) { v0 = lg[e]; e0 = e; }
            int e1 = -1; float v1 = -3.0e38f;
#pragma unroll
            for (int e = 0; e < 8; ++e) if (e != e0 && lg[e] > v1) { v1 = lg[e]; e1 = e; }
            if (c.lane == 0) { const float w1 = 1.f / (1.f + __expf(v0 - v1)); le[tl * 2] = e0; le[tl * 2 + 1] = e1; tope[t * 2] = e0; tope[t * 2 + 1] = e1; topw[t * 2] = 1.f - w1; topw[t * 2 + 1] = w1; }
        }
        __syncthreads();
        if (c.wave == 0) {
            const int t = ck * 64 + c.lane; const int e0 = le[c.lane * 2], e1 = le[c.lane * 2 + 1];
            int r0 = 0, r1 = 0;
#pragma unroll
            for (int e = 0; e < 8; ++e) { const unsigned long long m = __ballot(e0 == e || e1 == e); const int pre = __popcll(m & ((1ull << c.lane) - 1ull));
                if (e0 == e) r0 = pre; if (e1 == e) r1 = pre; if (c.lane == e) cnt[ck * 8 + e] = __popcll(m); }
            rank[t * 2] = r0; rank[t * 2 + 1] = r1;
        }
        __syncthreads();
    }
}
__device__ __forceinline__ void f_route2(const Ctx& c, const int* __restrict__ tope, const int* __restrict__ rank, const int* __restrict__ cnt, int* __restrict__ pos, int* __restrict__ rowtok, int* __restrict__ tile_e, int* __restrict__ ntiles) {
    LAS int* lbase = (LAS int*)c.lds;
    LAS int* ltot = lbase + 2048;
    {
        const int e = c.wave; int v[4]; int s = 0;
#pragma unroll
        for (int j = 0; j < 4; ++j) { v[j] = cnt[(4 * c.lane + j) * 8 + e]; s += v[j]; }
        int inc = s;
#pragma unroll
        for (int o = 1; o < 64; o <<= 1) { const int up = __builtin_amdgcn_ds_bpermute((c.lane - o) << 2, inc); if (c.lane >= o) inc += up; }
        int ex = inc - s;
#pragma unroll
        for (int j = 0; j < 4; ++j) { lbase[(4 * c.lane + j) * 8 + e] = ex; ex += v[j]; }
        if (c.lane == 63) ltot[e] = inc;
    }
    __syncthreads();
    int segoff[9]; segoff[0] = 0;
#pragma unroll
    for (int e = 0; e < 8; ++e) segoff[e + 1] = segoff[e] + ((ltot[e] + 255) & ~255);
    for (int ck = blockIdx.x; ck < T / 64; ck += c.G) {
        if (c.tid < 128) { const int tl = c.tid >> 1, k = c.tid & 1, t = ck * 64 + tl; const int e = tope[t * 2 + k];
            int so = 0;
#pragma unroll
            for (int q = 0; q < 8; ++q) so = (e == q) ? segoff[q] : so;
            const int p = so + lbase[ck * 8 + e] + rank[t * 2 + k]; pos[t * 2 + k] = p; rowtok[p] = t; }
    }
    if (blockIdx.x == 0) {
        for (int rt = c.tid; rt < RCAP / 256; rt += NTHREADS) { int e = -1;
#pragma unroll
            for (int q = 0; q < 8; ++q) if (rt * 256 >= segoff[q] && rt * 256 < segoff[q + 1]) e = q;
            tile_e[rt] = e; }
        if (c.tid == 0) ntiles[0] = segoff[8] / 256;
    }
}
__device__ __forceinline__ void f_combine(const Ctx& c, float* __restrict__ x, const bf16_t* __restrict__ Y, const int* __restrict__ pos, const float* __restrict__ topw) {
    for (int i = blockIdx.x * NTHREADS + c.tid; i < T * 128; i += c.G * NTHREADS) {
        const int t = i >> 7, cc = (i & 127) * 8;
        const int p0 = pos[t * 2], p1 = pos[t * 2 + 1]; const float w0 = topw[t * 2], w1 = topw[t * 2 + 1];
        f32x4 a0, a1, b0, b1; unpack8(*(const u32x4*)(Y + (size_t)p0 * D + cc), a0, a1); unpack8(*(const u32x4*)(Y + (size_t)p1 * D + cc), b0, b1);
        f32x4* xp = (f32x4*)(x + (size_t)t * D + cc);
        xp[0] = xp[0] + a0 * w0 + b0 * w1; xp[1] = xp[1] + a1 * w0 + b1 * w1;
    }
}
namespace att {
using s16x4 = __attribute__((ext_vector_type(4))) short;
using f32x16 = __attribute__((ext_vector_type(16))) float;
constexpr int QBLK = 32, KVBLK = 64, SHM_K = 64 * 256, SHM_V = 64 * 64 * 2, SHM_ATTN = 2 * SHM_K + 2 * SHM_V + 8 * 64 * 4;
constexpr float THR = 8.f;
#define KSWZ(row, colB) ((row) * 256 + ((colB) ^ (((row) & 7) << 4)))
#define SBAR() __builtin_amdgcn_sched_barrier(0)
__device__ __forceinline__ int crow(int r, int hi) { return (r & 3) + 8 * (r >> 2) + 4 * hi; }
__device__ __forceinline__ void cmask(f32x16& p0, f32x16& p1, int jb, int qrel, int hi) {
    const int kb = 64 * jb + 4 * hi;
#pragma unroll
    for (int r = 0; r < 16; ++r) { const int kv = kb + (r & 3) + 8 * (r >> 2); if (kv > qrel) p0[r] = -INFINITY; if (kv + 32 > qrel) p1[r] = -INFINITY; }
}
__device__ __forceinline__ void partialSM(f32x16& p0, f32x16& p1, float& m_reg, float& alpha) {
    float pmax = p0[0];
#pragma unroll
    for (int r = 1; r < 16; ++r) pmax = fmaxf(pmax, p0[r]);
#pragma unroll
    for (int r = 0; r < 16; ++r) pmax = fmaxf(pmax, p1[r]);
    { auto rr = __builtin_amdgcn_permlane32_swap(__float_as_uint(pmax), __float_as_uint(pmax), false, false); pmax = fmaxf(__uint_as_float(rr[0]), __uint_as_float(rr[1])); }
    float mn;
    if (__builtin_expect(__all(pmax - m_reg <= THR), 1)) { mn = m_reg; alpha = 1.f; }
    else { mn = fmaxf(m_reg, pmax); alpha = __builtin_amdgcn_exp2f(m_reg - mn); m_reg = mn; }
#pragma unroll
    for (int r = 0; r < 16; ++r) { p0[r] = p0[r] - mn; p1[r] = p1[r] - mn; }
#pragma unroll
    for (int r = 0; r < 16; ++r) p0[r] = __builtin_amdgcn_exp2f(p0[r]);
}
__device__ __forceinline__ void finishSM(f32x16& p0, f32x16& p1, float alpha, float& l_reg, bf16x8& pa0, bf16x8& pa1, bf16x8& pa2, bf16x8& pa3) {
#pragma unroll
    for (int r = 0; r < 16; ++r) p1[r] = __builtin_amdgcn_exp2f(p1[r]);
    float ps = 0;
#pragma unroll
    for (int r = 0; r < 16; ++r) ps += p0[r];
#pragma unroll
    for (int r = 0; r < 16; ++r) ps += p1[r];
    { auto rr = __builtin_amdgcn_permlane32_swap(__float_as_uint(ps), __float_as_uint(ps), false, false); ps = __uint_as_float(rr[0]) + __uint_as_float(rr[1]); }
    l_reg = l_reg * alpha + ps;
#define PK4(P, BASE, OUT) do { unsigned a0 = cvt_pk_bf16(P[BASE + 0], P[BASE + 1]), a1 = cvt_pk_bf16(P[BASE + 2], P[BASE + 3]);   \
    unsigned b0 = cvt_pk_bf16(P[BASE + 4], P[BASE + 5]), b1 = cvt_pk_bf16(P[BASE + 6], P[BASE + 7]);                              \
    auto r0 = __builtin_amdgcn_permlane32_swap(a0, b0, false, false); auto r1 = __builtin_amdgcn_permlane32_swap(a1, b1, false, false); \
    u32x4 w = {r0[0], r1[0], r0[1], r1[1]}; OUT = *reinterpret_cast<bf16x8*>(&w); } while (0)
    PK4(p0, 0, pa0); PK4(p0, 8, pa1); PK4(p1, 0, pa2); PK4(p1, 8, pa3);
#undef PK4
}
__device__ __forceinline__ void qkt(f32x16& p0, f32x16& p1, const char* Ks, const bf16x8* qr, int r32, int hi) {
    p0 = f32x16{}; p1 = f32x16{};
#pragma unroll
    for (int d0 = 0; d0 < 6; ++d0) { const int cb = (d0 * 16 + hi * 8) * 2;
        const bf16x8 b0 = *reinterpret_cast<const bf16x8*>(Ks + KSWZ(r32, cb));
        const bf16x8 b1 = *reinterpret_cast<const bf16x8*>(Ks + KSWZ(32 + r32, cb));
        p0 = __builtin_amdgcn_mfma_f32_32x32x16_bf16(b0, qr[d0], p0, 0, 0, 0);
        p1 = __builtin_amdgcn_mfma_f32_32x32x16_bf16(b1, qr[d0], p1, 0, 0, 0); }
}
__device__ __forceinline__ int v_st(int k, int c) { const int kk = (k & ~0xC) | ((k & 4) << 1) | ((k & 8) >> 1); return ((kk >> 3) * 2 + (c >> 5)) * 512 + ((kk & 7) * 32 + (c & 31)) * 2; }
__device__ __forceinline__ int v_rd_base(int lane) { return ((lane & 3) << 3) | (((lane >> 2) & 3) << 6) | (((lane >> 4) & 1) << 5) | (((lane >> 5) & 1) << 8); }
constexpr int v_rd_off(int d0, int ks, int half) { return d0 * 512 + ks * 2048 + half * 1024; }
template <int OFF> __device__ __forceinline__ s16x4 tr_read(int vb) { s16x4 r; asm volatile("ds_read_b64_tr_b16 %0, %1 offset:%2" : "=&v"(r) : "v"(vb), "i"(OFF) : "memory"); return r; }
template <int D0> __device__ __forceinline__ void pv_one(f32x16& od, int vb, bf16x8 pa0, bf16x8 pa1, bf16x8 pa2, bf16x8 pa3) {
    const s16x4 l0 = tr_read<v_rd_off(D0, 0, 0)>(vb), h0 = tr_read<v_rd_off(D0, 0, 1)>(vb), l1 = tr_read<v_rd_off(D0, 1, 0)>(vb), h1 = tr_read<v_rd_off(D0, 1, 1)>(vb);
    const s16x4 l2 = tr_read<v_rd_off(D0, 2, 0)>(vb), h2 = tr_read<v_rd_off(D0, 2, 1)>(vb), l3 = tr_read<v_rd_off(D0, 3, 0)>(vb), h3 = tr_read<v_rd_off(D0, 3, 1)>(vb);
    asm volatile("s_waitcnt lgkmcnt(0)" ::: "memory"); SBAR();
#define PK(L, H) (bf16x8){L[0], L[1], L[2], L[3], H[0], H[1], H[2], H[3]}
    od = __builtin_amdgcn_mfma_f32_32x32x16_bf16(pa0, PK(l0, h0), od, 0, 0, 0);
    od = __builtin_amdgcn_mfma_f32_32x32x16_bf16(pa1, PK(l1, h1), od, 0, 0, 0);
    od = __builtin_amdgcn_mfma_f32_32x32x16_bf16(pa2, PK(l2, h2), od, 0, 0, 0);
    od = __builtin_amdgcn_mfma_f32_32x32x16_bf16(pa3, PK(l3, h3), od, 0, 0, 0);
#undef PK
}
__device__ __forceinline__ void attn_unit(const bf16_t* __restrict__ Qn, const bf16_t* __restrict__ Kn, const bf16_t* __restrict__ Vn, bf16_t* __restrict__ att, int bh, int qb, char* lds, int tid) {
    const int wid = __builtin_amdgcn_readfirstlane(tid >> 6), lane = tid & 63, r32 = lane & 31, hi = lane >> 5;
    char* V_lds = lds; char* K_lds = lds + 2 * SHM_V;
    float* ws = (float*)(lds + 2 * SHM_V + 2 * SHM_K) + wid * 64; float* li_l = ws; float* al_l = ws + 32;
    float m_reg = -1e30f, l_reg = 0; f32x16 o[2] = {}; bf16x8 qr[6];
    const int q0 = qb * 256;
    const bf16_t* Qw = Qn + ((size_t)bh * SEQ + q0 + wid * QBLK + r32) * 96 + hi * 8;
#pragma unroll
    for (int d0 = 0; d0 < 6; ++d0) qr[d0] = *reinterpret_cast<const bf16x8*>(Qw + d0 * 16);
    const char* Kh = (const char*)(Kn + (size_t)bh * SEQ * 96); const char* Vh = (const char*)(Vn + (size_t)bh * SEQ * 64);
    const int kc0 = tid, kc1 = 512 + tid;
    const int kst0 = KSWZ(kc0 / 12, (kc0 % 12) * 16), kst1 = KSWZ(kc1 / 12, (kc1 % 12) * 16), vst = v_st(tid >> 3, (tid & 7) * 8);
    const bool two = wid < 4;
    const int vb0 = (int)(uintptr_t)V_lds + v_rd_base(lane);
    struct { bf16x8 v, k0, k1; } sr_[2];
#define SLOAD(i, t) do { sr_[i].v = *reinterpret_cast<const bf16x8*>(Vh + (size_t)(t) * (KVBLK * 128) + tid * 16); sr_[i].k0 = *reinterpret_cast<const bf16x8*>(Kh + (size_t)(t) * (KVBLK * 192) + kc0 * 16); \
    if (two) sr_[i].k1 = *reinterpret_cast<const bf16x8*>(Kh + (size_t)(t) * (KVBLK * 192) + kc1 * 16); } while (0)
#define SWRITE(b, i) do { *(bf16x8*)(V_lds + (b) * SHM_V + vst) = sr_[i].v; *(bf16x8*)(K_lds + (b) * SHM_K + kst0) = sr_[i].k0; if (two) *(bf16x8*)(K_lds + (b) * SHM_K + kst1) = sr_[i].k1; } while (0)
#define SWAIT() do { if (two) asm volatile("s_waitcnt vmcnt(3)" ::: "memory"); else asm volatile("s_waitcnt vmcnt(2)" ::: "memory"); } while (0)
#define RESC(a) do { if (__any((a) < 1.f)) { if (hi == 0) al_l[r32] = (a); asm volatile("s_waitcnt lgkmcnt(0)" ::: "memory"); \
    _Pragma("unroll") for (int d = 0; d < 2; ++d) _Pragma("unroll") for (int r = 0; r < 16; ++r) o[d][r] *= al_l[crow(r, hi)]; } } while (0)
#define CMASK(P0, P1, t) do { const int jb_ = (t) - (NT - 4); if (jb_ >= 0) cmask(P0, P1, jb_, qrel, hi); } while (0)
    f32x16 pA0, pA1, pB0, pB1; float alA, alB; bf16x8 pa0, pa1, pa2, pa3;
    const int NT = (q0 + 256) / KVBLK; const int qrel = wid * QBLK + r32;
    SLOAD(0, 0); asm volatile("s_waitcnt vmcnt(0)" ::: "memory"); SWRITE(0, 0); __syncthreads();
    qkt(pA0, pA1, K_lds, qr, r32, hi); CMASK(pA0, pA1, 0); partialSM(pA0, pA1, m_reg, alA);
    SLOAD(1, 1); if (2 < NT) SLOAD(0, 2);
    SWAIT(); SWRITE(1, 1); __syncthreads();
    for (int j = 1; j + 1 < NT; j += 2) {
        SBAR(); qkt(pB0, pB1, K_lds + SHM_K, qr, r32, hi); CMASK(pB0, pB1, j);
        finishSM(pA0, pA1, alA, l_reg, pa0, pa1, pa2, pa3); SBAR();
        SLOAD(1, j + 2); SBAR();
        pv_one<0>(o[0], vb0, pa0, pa1, pa2, pa3); pv_one<1>(o[1], vb0, pa0, pa1, pa2, pa3); partialSM(pB0, pB1, m_reg, alB);
        __syncthreads(); SWAIT(); SWRITE(0, 0);
        RESC(alB); __syncthreads();
        SBAR(); qkt(pA0, pA1, K_lds, qr, r32, hi); CMASK(pA0, pA1, j + 1);
        finishSM(pB0, pB1, alB, l_reg, pa0, pa1, pa2, pa3); SBAR();
        if (j + 3 < NT) SLOAD(0, j + 3); SBAR();
        pv_one<0>(o[0], vb0 + SHM_V, pa0, pa1, pa2, pa3); pv_one<1>(o[1], vb0 + SHM_V, pa0, pa1, pa2, pa3); partialSM(pA0, pA1, m_reg, alA);
        __syncthreads(); SWAIT(); SWRITE(1, 1);
        RESC(alA); __syncthreads();
    }
    SBAR(); qkt(pB0, pB1, K_lds + SHM_K, qr, r32, hi); CMASK(pB0, pB1, NT - 1);
    finishSM(pA0, pA1, alA, l_reg, pa0, pa1, pa2, pa3); SBAR();
    pv_one<0>(o[0], vb0, pa0, pa1, pa2, pa3); pv_one<1>(o[1], vb0, pa0, pa1, pa2, pa3); partialSM(pB0, pB1, m_reg, alB);
    __syncthreads(); RESC(alB);
    finishSM(pB0, pB1, alB, l_reg, pa0, pa1, pa2, pa3); SBAR();
    pv_one<0>(o[0], vb0 + SHM_V, pa0, pa1, pa2, pa3); pv_one<1>(o[1], vb0 + SHM_V, pa0, pa1, pa2, pa3);
    if (hi == 0) li_l[r32] = l_reg; asm volatile("s_waitcnt lgkmcnt(0)" ::: "memory");
    float rli[16];
#pragma unroll
    for (int r = 0; r < 16; ++r) rli[r] = __builtin_amdgcn_rcpf(li_l[crow(r, hi)]);
    const int b = bh >> 3, h = bh & 7;
    bf16_t* Ow = att + ((size_t)b * SEQ + q0 + wid * QBLK) * 512 + h * 64;
#pragma unroll
    for (int r = 0; r < 16; ++r) { const int orow = crow(r, hi);
#pragma unroll
        for (int d0 = 0; d0 < 2; ++d0) Ow[(size_t)orow * 512 + d0 * 32 + r32] = (bf16_t)f2bf(o[d0][r] * rli[r]); }
    __syncthreads();
#undef SLOAD
#undef SWRITE
#undef SWAIT
#undef RESC
#undef CMASK
}
#undef KSWZ
#undef SBAR
}
__device__ __forceinline__ void f_attn(const Ctx& c, const bf16_t* Qn, const bf16_t* Kn, const bf16_t* Vn, bf16_t* att_out) {
    const int bx = blockIdx.x, G = c.G;
    const int vcu = (G % 8 == 0) ? (bx % 8) * (G / 8) + bx / 8 : bx;
    for (int p = vcu; p < 256; p += G) {
        const int bh = p >> 4, j = p & 15;
#pragma unroll 1
        for (int u = 0; u < 2; ++u) { int tid_ = c.tid; asm volatile("" : "+v"(tid_)); att::attn_unit(Qn, Kn, Vn, att_out, bh, u ? j : 31 - j, (char*)c.lds, tid_); }
    }
}
typedef float f32x2_ __attribute__((ext_vector_type(2)));
constexpr int S5_MT_ELEMS = 256 * 384, S5_W_ELEMS = 128 * 256, S5_APITCH = 784;
__device__ __forceinline__ void s5_tables(const Ctx& c, int g, const float* __restrict__ lam_re, const float* __restrict__ lam_im, const float* __restrict__ log_step, const float* __restrict__ b_re, const float* __restrict__ b_im,
                                          const float* __restrict__ c_re, const float* __restrict__ c_im, bf16_t* __restrict__ MT, bf16_t* __restrict__ W, float* __restrict__ LB16) {
    LAS f32x2_* pw = (LAS f32x2_*)c.lds;
    LAS f32x2_* Bb = pw + 17 * 64;
    LAS f32x2_* Cm = Bb + 64 * 16;
    LAS float* Kt = (LAS float*)(Cm + 16 * 64);
    const int tid = c.tid;
    if (tid < 64) {
        const int p = tid;
        const float lre = lam_re[g * 64 + p], lim = lam_im[g * 64 + p], st = __expf(log_step[g]);
        const float mag = __expf(lre * st);
        float sn, cs; sincos_rev((double)lim * (double)st * 0.15915494309189535, sn, cs);
        const float lbr = mag * cs, lbi = mag * sn;
        const float nr = lbr - 1.f, ni = lbi, den = 1.f / (lre * lre + lim * lim);
        const float cr = (nr * lre + ni * lim) * den, ci = (ni * lre - nr * lim) * den;
        float pr = 1.f, pi = 0.f;
        for (int tau = 0; tau <= 16; ++tau) { pw[tau * 64 + p] = (f32x2_){pr, pi}; const float nr2 = pr * lbr - pi * lbi, ni2 = pr * lbi + pi * lbr; pr = nr2; pi = ni2; }
        const f32x2_ l16 = pw[16 * 64 + p]; LB16[(g * 64 + p) * 2] = l16.x; LB16[(g * 64 + p) * 2 + 1] = l16.y;
        for (int k = 0; k < 16; ++k) { const float br = b_re[(g * 64 + p) * 16 + k], bi = b_im[(g * 64 + p) * 16 + k]; Bb[p * 16 + k] = (f32x2_){cr * br - ci * bi, cr * bi + ci * br};
            Cm[k * 64 + p] = (f32x2_){c_re[(g * 16 + k) * 64 + p], c_im[(g * 16 + k) * 64 + p]}; }
    }
    __syncthreads();
    for (int e = tid; e < 4096; e += NTHREADS) { const int tau = e >> 8, cc = (e >> 4) & 15, c2 = e & 15; float s = 0.f;
        for (int p = 0; p < 64; ++p) { const f32x2_ cm = Cm[cc * 64 + p], w = pw[tau * 64 + p], b = Bb[p * 16 + c2]; const float ar = cm.x * w.x - cm.y * w.y, ai = cm.x * w.y + cm.y * w.x; s += ar * b.x - ai * b.y; }
        Kt[e] = s; }
    __syncthreads();
    for (int e = tid; e < S5_MT_ELEMS; e += NTHREADS) { const int n = e / 384, k = e % 384, j = n >> 4, cc = n & 15; float v;
        if (k < 256) { const int s = k >> 4, c2 = k & 15; v = (s <= j) ? Kt[((j - s) << 8) + (cc << 4) + c2] : 0.f; }
        else { const int kk = k - 256, ri = kk >> 6, p = kk & 63; const f32x2_ cm = Cm[cc * 64 + p], w = pw[(j + 1) * 64 + p]; v = ri ? -(cm.x * w.y + cm.y * w.x) : (cm.x * w.x - cm.y * w.y); }
        MT[e] = (bf16_t)f2bf(v); }
    for (int e = tid; e < S5_W_ELEMS; e += NTHREADS) { const int n = e >> 8, k = e & 255, ri = n >> 6, p = n & 63, s = k >> 4, c2 = k & 15; const f32x2_ w = pw[(15 - s) * 64 + p], b = Bb[p * 16 + c2];
        W[e] = (bf16_t)f2bf(ri ? (w.x * b.y + w.y * b.x) : (w.x * b.x - w.y * b.y)); }
    __syncthreads();
}
__device__ __forceinline__ void s5_stage(const Ctx& c, const bf16_t* __restrict__ U, const bf16_t* __restrict__ xin, int b, int blk, int g) {
#pragma unroll
    for (int i = 0; i < 4; ++i) { const int q = c.tid + NTHREADS * i, m = q >> 5, w = q & 31;
        const u32x4 v = *(const u32x4*)(U + ((size_t)b * SEQ + (blk * 64 + m) * 16 + (w >> 1)) * 512 + 16 * g + 8 * (w & 1));
        *(LAS u32x4*)(c.lds + m * S5_APITCH + w * 16) = v; }
    if (xin) {
#pragma unroll
        for (int i = 0; i < 2; ++i) { const int q = c.tid + NTHREADS * i, m = q >> 4, w = q & 15;
            const u32x4 v = *(const u32x4*)(xin + (((size_t)b * 512 + blk * 64 + m) * 32 + g) * 128 + 8 * w);
            *(LAS u32x4*)(c.lds + m * S5_APITCH + 512 + w * 16) = v; }
    }
}
__device__ __forceinline__ void f_s5_e(const Ctx& c, const bf16_t* __restrict__ U, const bf16_t* __restrict__ Wt, float* __restrict__ E) {
    const int lane = c.lane, r16 = lane & 15, q = lane >> 4, w = c.wave;
    for (int it = blockIdx.x; it < 512; it += c.G) {
        const int g = it & 31, blk = (it >> 5) & 7, b = it >> 8;
        s5_stage(c, U, nullptr, b, blk, g);
        __syncthreads();
        f32x4 acc[4];
#pragma unroll
        for (int mt = 0; mt < 4; ++mt) acc[mt] = (f32x4){0.f, 0.f, 0.f, 0.f};
        const bf16_t* wp = Wt + (size_t)g * S5_W_ELEMS + (16 * w + r16) * 256 + 8 * q;
#pragma unroll
        for (int ks = 0; ks < 8; ++ks) {
            const bf16x8 bfr = *(const bf16x8*)(wp + 32 * ks);
#pragma unroll
            for (int mt = 0; mt < 4; ++mt) { const bf16x8 a = *(const LAS bf16x8*)(c.lds + (16 * mt + r16) * S5_APITCH + (32 * ks + 8 * q) * 2); acc[mt] = __builtin_amdgcn_mfma_f32_16x16x32_bf16(a, bfr, acc[mt], 0, 0, 0); }
        }
#pragma unroll
        for (int mt = 0; mt < 4; ++mt)
#pragma unroll
            for (int r = 0; r < 4; ++r) E[(((size_t)b * 512 + blk * 64 + 16 * mt + 4 * q + r) * 32 + g) * 128 + 16 * w + r16] = acc[mt][r];
        __syncthreads();
    }
}
__device__ __forceinline__ void f_s5_scan(const Ctx& c, const float* __restrict__ E, const float* __restrict__ LB16, bf16_t* __restrict__ xin) {
    if (c.gw >= BATCH * S5G) return;
    const int b = c.gw / S5G, g = c.gw % S5G, p = c.lane;
    const float lr = LB16[(g * 64 + p) * 2], li = LB16[(g * 64 + p) * 2 + 1];
    float xr = 0.f, xi = 0.f;
    const float* ep = E + (((size_t)b * 512) * 32 + g) * 128 + p; bf16_t* xp = xin + (((size_t)b * 512) * 32 + g) * 128 + p;
    for (int ch0 = 0; ch0 < 512; ch0 += 8) {
        float er[8], ei[8];
#pragma unroll
        for (int i = 0; i < 8; ++i) { er[i] = ep[(size_t)(ch0 + i) * 4096]; ei[i] = ep[(size_t)(ch0 + i) * 4096 + 64]; }
#pragma unroll
        for (int i = 0; i < 8; ++i) { xp[(size_t)(ch0 + i) * 4096] = (bf16_t)f2bf(xr); xp[(size_t)(ch0 + i) * 4096 + 64] = (bf16_t)f2bf(xi);
            const float nr = lr * xr - li * xi + er[i], ni = lr * xi + li * xr + ei[i]; xr = nr; xi = ni; }
    }
}
__device__ __forceinline__ void f_s5_y(const Ctx& c, const bf16_t* __restrict__ U, const bf16_t* __restrict__ xin, const bf16_t* __restrict__ MTt, const float* __restrict__ dsk, bf16_t* __restrict__ YG) {
    const int lane = c.lane, r16 = lane & 15, q = lane >> 4, w = c.wave;
    for (int it = blockIdx.x; it < 512; it += c.G) {
        const int g = it & 31, blk = (it >> 5) & 7, b = it >> 8;
        s5_stage(c, U, xin, b, blk, g);
        __syncthreads();
        f32x4 acc[4][2];
#pragma unroll
        for (int mt = 0; mt < 4; ++mt) { acc[mt][0] = (f32x4){0.f, 0.f, 0.f, 0.f}; acc[mt][1] = (f32x4){0.f, 0.f, 0.f, 0.f}; }
        const bf16_t* mp = MTt + (size_t)g * S5_MT_ELEMS + (32 * w + r16) * 384 + 8 * q;
        for (int ks = 0; ks < 12; ++ks) {
            if (ks > w && ks < 8) continue;
            const bf16x8 b0 = *(const bf16x8*)(mp + 32 * ks), b1 = *(const bf16x8*)(mp + 16 * 384 + 32 * ks);
#pragma unroll
            for (int mt = 0; mt < 4; ++mt) { const bf16x8 a = *(const LAS bf16x8*)(c.lds + (16 * mt + r16) * S5_APITCH + (32 * ks + 8 * q) * 2);
                acc[mt][0] = __builtin_amdgcn_mfma_f32_16x16x32_bf16(a, b0, acc[mt][0], 0, 0, 0); acc[mt][1] = __builtin_amdgcn_mfma_f32_16x16x32_bf16(a, b1, acc[mt][1], 0, 0, 0); }
        }
        const float dk = dsk[16 * g + r16];
#pragma unroll
        for (int mt = 0; mt < 4; ++mt)
#pragma unroll
            for (int jj = 0; jj < 2; ++jj)
#pragma unroll
                for (int r = 0; r < 4; ++r) { const int m = 16 * mt + 4 * q + r, j = 2 * w + jj;
                    const float uv = bf2f(*(const LAS bf16_t*)(c.lds + m * S5_APITCH + (16 * j + r16) * 2));
                    YG[((size_t)b * SEQ + (blk * 64 + m) * 16 + j) * 512 + 16 * g + r16] = (bf16_t)f2bf(gelu_tanh(acc[mt][jj][r] + dk * uv)); }
        __syncthreads();
    }
}
#ifndef NEW_S5
#define NEW_S5 1
#endif
struct Args { const float* in[32]; float* out; unsigned char* ws; int ph_lo, ph_hi; };
constexpr size_t WS_CTL = 0, CTL_ZERO_BYTES = 2 * MiB;
constexpr int CW_BAR = 4096;
constexpr size_t WS_XSSM = 64 * 1024, WS_XSSF = WS_XSSM + 2 * 131072, WS_QSS = WS_XSSF + 2 * 131072, WS_KVSS = WS_QSS + 2 * 131072, WS_KRSS = WS_KVSS + 2 * 131072;
constexpr size_t WS_XB = 2 * MiB;
constexpr size_t WS_WIN = 34 * MiB, WS_WUQ = 46 * MiB, WS_WUKV = 47 * MiB, WS_WGLU = 48 * MiB, WS_WPA = 49 * MiB, WS_WPS = 51 * MiB, WS_WOUT = 53 * MiB, WS_WFGU = 57 * MiB, WS_WFD = 68 * MiB, WS_BIASL = 74 * MiB,
    WS_S5MT = 75 * MiB, WS_S5W = 87 * MiB, WS_S5LB = 91 * MiB;
constexpr size_t WS_U = 92 * MiB, WS_GA = 108 * MiB, WS_GB = 140 * MiB, WS_QLAT = 172 * MiB, WS_KVLAT = 180 * MiB, WS_QRAW = 188 * MiB, WS_KVRAW = 212 * MiB, WS_Q = 244 * MiB, WS_K = 268 * MiB, WS_V = 292 * MiB,
    WS_ATT = 308 * MiB, WS_YG = 324 * MiB, WS_SSM = 340 * MiB, WS_TMPB = 356 * MiB, WS_MIX = 388 * MiB, WS_S5E = 420 * MiB, WS_S5X = 436 * MiB, WS_HD = 92 * MiB;
constexpr size_t WS_WMGU = 34 * MiB, WS_WMD = 146 * MiB, WS_H1 = 202 * MiB, WS_YB = 34 * MiB, WS_MT = 440 * MiB, WS_TOPE = WS_MT, WS_TOPW = WS_MT + 256 * 1024, WS_RANK = WS_MT + 512 * 1024, WS_CNT = WS_MT + 768 * 1024,
    WS_TILEE = WS_MT + 800 * 1024, WS_NTILES = WS_MT + 804 * 1024, WS_POS = 441 * MiB, WS_ROWTOK = 442 * MiB, WS_END = 477 * MiB;

__global__ void __launch_bounds__(NTHREADS, 2) mk_fwd(Args a) {
    extern __shared__ __attribute__((aligned(16))) unsigned char lds_raw[];
    Ctx c0; c0.lds = (LAS unsigned char*)lds_raw;
    c0.tid = threadIdx.x; c0.lane = c0.tid & 63; c0.wave = __builtin_amdgcn_readfirstlane(c0.tid >> 6); c0.G = gridDim.x; c0.gw = blockIdx.x * NWAVES + c0.wave; c0.NGW = c0.G * NWAVES;
    volatile LAS unsigned* MISC = (volatile LAS unsigned*)(c0.lds + LDSCTL_OFF);
    for (int u = c0.tid; u < (LDS_BYTES - LDSCTL_OFF) / 4; u += NTHREADS) ((LAS unsigned*)(c0.lds + LDSCTL_OFF))[u] = 0u;
    __syncthreads();
    unsigned char* ws0 = a.ws;
    XcdBarrier bar = xcd_barrier_post((unsigned*)(ws0 + WS_CTL) + CW_BAR, MISC + 8); bar.w = (unsigned)c0.wave;
    const int lo = a.ph_lo, hi = a.ph_hi; int ph = 0;
#define PH_BEGIN if (ph >= lo && ph < hi) { Ctx c = c0; c.lane = hw_lane(); asm volatile("" : "+s"(c.wave), "+s"(c.gw), "+s"(c.G), "+s"(c.NGW)); c.tid = c.wave * 64 + c.lane; unsigned char* ws = ws0; asm volatile("" : "+s"(ws)); float* X = a.out; asm volatile("" : "+s"(X)); const int bid = __builtin_amdgcn_readfirstlane(blockIdx.x);
#define PH_END if (ph + 1 < hi) xcd_barrier(bar); } ++ph;
#define IN(k) ({ const float* p_ = a.in[k]; asm volatile("" : "+s"(p_)); p_; })
#define WSP(type, off) ((type*)(ws + (off)))
#define GEMM(EpiT, Aptr, Bptr, N_, K_, ...) do { pg8::Gemm g_{(const pg8::bf16_t*)(Aptr), (const pg8::bf16_t*)(Bptr), T, (N_), (K_)}; pg8::StaticOrder S_; S_.init(T, (N_), c.G, bid); EpiT E_{__VA_ARGS__}; \
        int tid_ = c.tid; asm volatile("" : "+v"(tid_)); pg8::gemm_phase<EpiT, pg8::StaticOrder, true, true>(c.lds, g_, S_, E_, tid_); } while (0)

    PH_BEGIN {
        for (int wgi = bid; wgi < DEPTH * S5G; wgi += c.G) { const int l = wgi >> 5, g = wgi & 31;
            s5_tables(c, g, IN(10) + l * 2048, IN(11) + l * 2048, IN(12) + l * 32, IN(13) + (size_t)l * 32768, IN(14) + (size_t)l * 32768, IN(15) + (size_t)l * 32768, IN(16) + (size_t)l * 32768,
                      WSP(bf16_t, WS_S5MT) + (size_t)wgi * S5_MT_ELEMS, WSP(bf16_t, WS_S5W) + (size_t)wgi * S5_W_ELEMS, WSP(float, WS_S5LB) + l * 4096); }
        LAS float* scr = (LAS float*)(c.lds + c.wave * 16384);
        for (int l = 0; l < DEPTH; ++l) {
            conv_proj(c, scr, IN(2) + (size_t)l * D * INC, WSP(bf16_t, WS_WIN) + (size_t)l * 3072 * D, IN(1) + l * D);
            conv_plain(c, scr, IN(5) + (size_t)l * QLR * 768, QLR, 768, WSP(bf16_t, WS_WUQ) + (size_t)l * 768 * 256, 256, IN(4) + l * QLR);
            conv_plain(c, scr, IN(7) + (size_t)l * KVLR * 1024, KVLR, 1024, WSP(bf16_t, WS_WUKV) + (size_t)l * 1024 * 256, 256, IN(6) + l * KVLR);
            conv_plain(c, scr, IN(18) + (size_t)l * 512 * 512, 512, 512, WSP(bf16_t, WS_WGLU) + (size_t)l * 512 * 512, 512, nullptr);
            conv_plain(c, scr, IN(20) + (size_t)l * 512 * 1024, 512, 1024, WSP(bf16_t, WS_WPA) + (size_t)l * 1024 * 512, 512, nullptr);
            conv_plain(c, scr, IN(21) + (size_t)l * 512 * 1024, 512, 1024, WSP(bf16_t, WS_WPS) + (size_t)l * 1024 * 512, 512, nullptr);
            conv_plain(c, scr, IN(22) + (size_t)l * D * D, D, D, WSP(bf16_t, WS_WOUT) + (size_t)l * D * D, D, nullptr);
            for (int i = blockIdx.x * NTHREADS + c.tid; i < 3072; i += c.G * NTHREADS) { const int s_ = proj_src(i); WSP(float, WS_BIASL)[l * 3072 + i] = s_ >= 0 ? IN(3)[l * INC + s_] : 0.f; }
        }
        conv_gateup(c, scr, IN(24), IN(25), FFD, WSP(bf16_t, WS_WFGU), IN(23));
        conv_plain(c, scr, IN(26), FFD, D, WSP(bf16_t, WS_WFD), FFD, nullptr);
        f_xbss(c, IN(0), WSP(bf16_t, WS_XB), WSP(u64, WS_XSSM));
    } PH_END

    for (int l = 0; l < DEPTH; ++l) {
        PH_BEGIN GEMM(EpiProjF, WSP(bf16_t, WS_XB), WSP(bf16_t, WS_WIN) + (size_t)l * 3072 * D, 3072, D, WSP(u64, WS_XSSM) + l * T, WSP(float, WS_BIASL) + l * 3072, WSP(bf16_t, WS_QLAT), WSP(bf16_t, WS_KVLAT),
                      WSP(bf16_t, WS_U), WSP(bf16_t, WS_GA), WSP(bf16_t, WS_GB), WSP(u64, WS_QSS) + l * T, WSP(u64, WS_KVSS) + l * T, WSP(float, WS_KRSS)); PH_END
        PH_BEGIN GEMM(EpiRowScale, WSP(bf16_t, WS_QLAT), WSP(bf16_t, WS_WUQ) + (size_t)l * 768 * 256, 768, 256, WSP(bf16_t, WS_QRAW), WSP(u64, WS_QSS) + l * T, 768, 1.f / 256.f);
                 __syncthreads();
                 GEMM(EpiRowScale, WSP(bf16_t, WS_KVLAT), WSP(bf16_t, WS_WUKV) + (size_t)l * 1024 * 256, 1024, 256, WSP(bf16_t, WS_KVRAW), WSP(u64, WS_KVSS) + l * T, 1024, 1.f / 128.f);
#if NEW_S5
                 __syncthreads();
                 f_s5_e(c, WSP(bf16_t, WS_U), WSP(bf16_t, WS_S5W) + (size_t)l * 32 * S5_W_ELEMS, WSP(float, WS_S5E));
#endif
                 PH_END
        PH_BEGIN
#if NEW_S5
                 f_s5_scan(c, WSP(float, WS_S5E), WSP(float, WS_S5LB) + l * 4096, WSP(bf16_t, WS_S5X));
#endif
                 f_heads(c, WSP(bf16_t, WS_QRAW), WSP(bf16_t, WS_KVRAW), WSP(bf16_t, WS_KVLAT), WSP(float, WS_KRSS), IN(8) + l * QKD, IN(9) + l * QKD, WSP(bf16_t, WS_Q), WSP(bf16_t, WS_K), WSP(bf16_t, WS_V)); PH_END
#if NEW_S5
        PH_BEGIN f_s5_y(c, WSP(bf16_t, WS_U), WSP(bf16_t, WS_S5X), WSP(bf16_t, WS_S5MT) + (size_t)l * 32 * S5_MT_ELEMS, IN(17) + l * 512, WSP(bf16_t, WS_YG));
                 f_attn(c, WSP(bf16_t, WS_Q), WSP(bf16_t, WS_K), WSP(bf16_t, WS_V), WSP(bf16_t, WS_ATT)); PH_END
#else
        PH_BEGIN s_s5(c, WSP(bf16_t, WS_U), IN(10) + l * 2048, IN(11) + l * 2048, IN(12) + l * 32, IN(13) + (size_t)l * 32768, IN(14) + (size_t)l * 32768, IN(15) + (size_t)l * 32768, IN(16) + (size_t)l * 32768, IN(17) + l * 512, WSP(bf16_t, WS_YG)); PH_END
        PH_BEGIN f_attn(c, WSP(bf16_t, WS_Q), WSP(bf16_t, WS_K), WSP(bf16_t, WS_V), WSP(bf16_t, WS_ATT)); PH_END
#endif
        PH_BEGIN GEMM(EpiGluF, WSP(bf16_t, WS_YG), WSP(bf16_t, WS_WGLU) + (size_t)l * 512 * 512, 512, 512, WSP(bf16_t, WS_YG), IN(19) + l * 512, WSP(bf16_t, WS_SSM));
                 __syncthreads();
                 GEMM(EpiMixF<false>, WSP(bf16_t, WS_ATT), WSP(bf16_t, WS_WPA) + (size_t)l * 1024 * 512, 1024, 512, WSP(bf16_t, WS_GA), nullptr, WSP(bf16_t, WS_TMPB)); PH_END
        PH_BEGIN GEMM(EpiMixF<true>, WSP(bf16_t, WS_SSM), WSP(bf16_t, WS_WPS) + (size_t)l * 1024 * 512, 1024, 512, WSP(bf16_t, WS_GB), WSP(bf16_t, WS_TMPB), WSP(bf16_t, WS_MIX)); PH_END
        PH_BEGIN GEMM(EpiResidF, WSP(bf16_t, WS_MIX), WSP(bf16_t, WS_WOUT) + (size_t)l * D * D, D, D, l == 0 ? IN(0) : X, X, WSP(bf16_t, WS_XB), WSP(u64, WS_XSSF) + l * T); PH_END
        if (l == 0) {
            PH_BEGIN GEMM(EpiSwigluF, WSP(bf16_t, WS_XB), WSP(bf16_t, WS_WFGU), 2 * FFD, D, WSP(bf16_t, WS_HD), WSP(u64, WS_XSSF), nullptr, FFD, 22); PH_END
            PH_BEGIN GEMM(EpiResidF, WSP(bf16_t, WS_HD), WSP(bf16_t, WS_WFD), D, FFD, X, X, WSP(bf16_t, WS_XB), WSP(u64, WS_XSSM) + T); PH_END
        } else {
            PH_BEGIN f_route1(c, X, IN(23) + l * D, IN(27), IN(28), WSP(int, WS_TOPE), WSP(float, WS_TOPW), WSP(int, WS_RANK), WSP(int, WS_CNT), WSP(int, WS_ROWTOK));
                 {
                     LAS float* scr = (LAS float*)(c.lds + c.wave * 16384);
                     for (int e = 0; e < NE; ++e) {
                         conv_gateup(c, scr, IN(29) + (size_t)e * D * FFE, IN(30) + (size_t)e * D * FFE, FFE, WSP(bf16_t, WS_WMGU) + (size_t)e * 2 * FFE * D, IN(23) + D);
                         conv_plain(c, scr, IN(31) + (size_t)e * FFE * D, FFE, D, WSP(bf16_t, WS_WMD) + (size_t)e * D * FFE, FFE, nullptr); } } PH_END
            PH_BEGIN f_route2(c, WSP(int, WS_TOPE), WSP(int, WS_RANK), WSP(int, WS_CNT), WSP(int, WS_POS), WSP(int, WS_ROWTOK), WSP(int, WS_TILEE), WSP(int, WS_NTILES)); PH_END
            PH_BEGIN { const int ntl = __builtin_amdgcn_readfirstlane(WSP(int, WS_NTILES)[0]);
                pg8::Gemm g_{(const pg8::bf16_t*)WSP(bf16_t, WS_XB), (const pg8::bf16_t*)WSP(bf16_t, WS_WMGU), ntl * 256, 2 * FFE, D}; pg8::MoeOrder S_; S_.init(ntl * 256, 2 * FFE, c.G, bid); S_.tile_e = WSP(int, WS_TILEE); S_.per_e = 2 * FFE / 256;
                EpiSwigluF E_{WSP(bf16_t, WS_H1), WSP(u64, WS_XSSF) + T, WSP(int, WS_ROWTOK), FFE, 2 * FFE / 256};
                int tid_ = c.tid; asm volatile("" : "+v"(tid_)); pg8::gemm_phase_gather<EpiSwigluF, pg8::MoeOrder>(c.lds, g_, WSP(int, WS_ROWTOK), S_, E_, tid_); } PH_END
            PH_BEGIN { const int ntl = __builtin_amdgcn_readfirstlane(WSP(int, WS_NTILES)[0]);
                pg8::Gemm g_{(const pg8::bf16_t*)WSP(bf16_t, WS_H1), (const pg8::bf16_t*)WSP(bf16_t, WS_WMD), ntl * 256, D, FFE}; pg8::MoeOrder S_; S_.init(ntl * 256, D, c.G, bid); S_.tile_e = WSP(int, WS_TILEE); S_.per_e = D / 256;
                EpiStoreBf16 E_{WSP(bf16_t, WS_YB), D, D / 256};
                int tid_ = c.tid; asm volatile("" : "+v"(tid_)); pg8::gemm_phase<EpiStoreBf16, pg8::MoeOrder, true, true>(c.lds, g_, S_, E_, tid_); } PH_END
            PH_BEGIN f_combine(c, X, WSP(bf16_t, WS_YB), WSP(int, WS_POS), WSP(float, WS_TOPW)); PH_END
        }
    }
}

extern "C" void kernel_launch(void* const* d_in, const int* in_sizes, int n_in, void* d_out, int out_size, void* d_ws, size_t ws_size, hipStream_t stream) {
    static int grid = 0;
    if (grid == 0) {
        if (n_in != 32 || out_size != T * D || ws_size < WS_END) { fprintf(stderr, "kernel_launch: unexpected shapes (n_in %d out %d ws %zu)\n", n_in, out_size, ws_size); grid = -1; return; }
        int dev = 0, cus = 0, per_cu = 0;
        if (hipGetDevice(&dev) != hipSuccess || hipDeviceGetAttribute(&cus, hipDeviceAttributeMultiprocessorCount, dev) != hipSuccess) { grid = -1; return; }
        if (hipFuncSetAttribute((const void*)mk_fwd, hipFuncAttributeMaxDynamicSharedMemorySize, LDS_BYTES) != hipSuccess) { fprintf(stderr, "kernel_launch: hipFuncSetAttribute failed\n"); grid = -1; return; }
        if (hipOccupancyMaxActiveBlocksPerMultiprocessor(&per_cu, (const void*)mk_fwd, NTHREADS, LDS_BYTES) != hipSuccess || per_cu < 1) { fprintf(stderr, "kernel_launch: occupancy query says %d\n", per_cu); }
        (void)hipGetLastError();
        grid = cus;
    }
    if (grid < 0) return;
    (void)hipMemsetAsync((char*)d_ws + WS_CTL, 0, CTL_ZERO_BYTES, stream);
    Args a{};
    for (int i = 0; i < 32; ++i) a.in[i] = (const float*)d_in[i];
    a.out = (float*)d_out; a.ws = (unsigned char*)d_ws; a.ph_lo = 0; a.ph_hi = 1000;
    hipLaunchKernelGGL(mk_fwd, dim3(grid), dim3(NTHREADS), LDS_BYTES, stream, a);
}
```

```cpp
#include <hip/hip_runtime.h>
#ifndef PROBE_K2
#define PROBE_K2 0
#endif
#include <cstdio>
#include <cstdint>

typedef unsigned short bf16_t;
typedef short bf16x8 __attribute__((ext_vector_type(8)));
typedef float f32x4 __attribute__((ext_vector_type(4)));
typedef unsigned u32x4 __attribute__((ext_vector_type(4)));
#define LAS __attribute__((address_space(3)))
#define GAS __attribute__((address_space(1)))

constexpr int D = 1024, BATCH = 2, SEQ = 8192, T = BATCH * SEQ, DEPTH = 2;
constexpr int NH = 8, QKD = 96, QLR = 256, KVLR = 128;
constexpr int S5G = 32;
constexpr int FFD = 2816, NE = 8, FFE = 3584, INC = 2976;
constexpr int RCAP = 34816;
constexpr float EPS = 1e-6f;
constexpr float QSCALE = 0.14724444602590306f;
constexpr int NWAVES = 8, NTHREADS = 512;
constexpr int LDS_BYTES = 147456;
constexpr int LDSCTL_OFF = 143360;
constexpr size_t MiB = 1u << 20;

__device__ __forceinline__ unsigned f2bf(float f) { unsigned u = __builtin_bit_cast(unsigned, f); return (u + 0x7fffu + ((u >> 16) & 1u)) >> 16; }
__device__ __forceinline__ float bf2f(unsigned h) { return __builtin_bit_cast(float, h << 16); }
__device__ __forceinline__ float bflo(unsigned w) { return __builtin_bit_cast(float, w << 16); }
__device__ __forceinline__ float bfhi(unsigned w) { return __builtin_bit_cast(float, w & 0xffff0000u); }
__device__ __forceinline__ int hw_lane() { int l; asm volatile("v_mbcnt_lo_u32_b32 %0, -1, 0\n\tv_mbcnt_hi_u32_b32 %0, -1, %0" : "=v"(l)); return l; }
__device__ __forceinline__ float bperm(float v, int lane_src) { return __builtin_bit_cast(float, __builtin_amdgcn_ds_bpermute(lane_src << 2, __builtin_bit_cast(int, v))); }
template <int M> __device__ __forceinline__ float xadd(float v, int lane) { return v + bperm(v, lane ^ M); }
__device__ __forceinline__ float wave_sum(float v, int lane) { v = xadd<1>(v, lane); v = xadd<2>(v, lane); v = xadd<4>(v, lane); v = xadd<8>(v, lane); v = xadd<16>(v, lane); return xadd<32>(v, lane); }
__device__ __forceinline__ float sigmoidf_(float v) { return __builtin_amdgcn_rcpf(1.f + __expf(-v)); }
__device__ __forceinline__ float sigmoid_fast(float v) { return __builtin_amdgcn_rcpf(1.f + __expf(-v)); }
__device__ __forceinline__ float siluf_(float v) { return v * __builtin_amdgcn_rcpf(1.f + __expf(-v)); }
__device__ __forceinline__ float gelu_tanh(float v) {
    const float z = 0.7978845608028654f * (v + 0.044715f * v * v * v);
    const float e = __expf(2.f * z);
    const float th = 1.f - 2.f * __builtin_amdgcn_rcpf(e + 1.f);
    return 0.5f * v * (1.f + th);
}
__device__ __forceinline__ void sincos_rev(double rev, float& s, float& c) {
    const double fr = rev - floor(rev);
    const float f = (float)fr;
    s = __builtin_amdgcn_sinf(f); c = __builtin_amdgcn_cosf(f);
}
__constant__ double c_invrev[16] = {0.15915494309189535, 0.08949940160889101, 0.050329212104487035, 0.0283021958306234, 0.015915494309189534, 0.008949940160889102,
    0.005032921210448704, 0.00283021958306234, 0.0015915494309189536, 0.0008949940160889102, 0.0005032921210448703, 0.00028302195830623395, 0.00015915494309189535,
    8.949940160889102e-05, 5.0329212104487035e-05, 2.8302195830623396e-05};

#define XB_TMO      128
#define XB_XCNT(j)  (256  + 64 * (j))
#define XB_XSUB(j)  (1280 + 64 * (j))
#define XB_XGEN(j)  (2304 + 64 * (j))
#define XB_TOP      3328
#define XB_TOPGEN   3392
#define XCD_BAR_WORDS 3456
#define XB_SPIN_CAP (1u << 18)

__device__ __forceinline__ unsigned xb_ld(unsigned* p)              { return __hip_atomic_load(p, __ATOMIC_RELAXED, __HIP_MEMORY_SCOPE_AGENT); }
__device__ __forceinline__ unsigned xb_add(unsigned* p, unsigned v) { return __hip_atomic_fetch_add(p, v, __ATOMIC_RELAXED, __HIP_MEMORY_SCOPE_AGENT); }
__device__ __forceinline__ unsigned xb_xcc_id() { return (unsigned)__builtin_amdgcn_s_getreg((3 << 11) | 20) & 0xFu; }
#define XB_SPIN(cond, bar) do { unsigned _sp = 0; while (cond) { __builtin_amdgcn_s_sleep(1); \
    if ((++_sp & 255u) == 0u) { if (xb_ld(&(bar)[XB_TMO])) break; if (_sp > XB_SPIN_CAP) { atomicAdd(&(bar)[XB_TMO], 1u); break; } } } } while (0)

struct XcdBarrier {
    unsigned* bar; unsigned x; unsigned w;
    volatile LAS unsigned* st;
};

__device__ __forceinline__ XcdBarrier xcd_barrier_post(unsigned* bar, volatile LAS unsigned* st) {
    XcdBarrier b; b.bar = bar; b.x = xb_xcc_id(); b.st = st;
    if (threadIdx.x == 0) (void)xb_add(&bar[XB_XCNT(b.x)], 1u);
    return b;
}
__device__ __forceinline__ void xcd_barrier_complete(unsigned* bar, unsigned x, unsigned& nloc, unsigned& nx) {
    const unsigned G = gridDim.x * gridDim.y * gridDim.z;
    unsigned sum, cnt, mine, sp = 0u;
    for (;;) {
        sum = 0u; cnt = 0u; mine = 0u;
#pragma unroll
        for (unsigned j = 0; j < 16; ++j) { const unsigned c = xb_ld(&bar[XB_XCNT(j)]); sum += c; cnt += (c > 0u) ? 1u : 0u; mine = (j == x) ? c : mine; }
        if (sum == G) break;
        __builtin_amdgcn_s_sleep(1);
        if ((++sp & 255u) == 0u) { if (xb_ld(&bar[XB_TMO])) break; if (sp > XB_SPIN_CAP) { atomicAdd(&bar[XB_TMO], 1u); break; } }
    }
    nloc = mine > 0u ? mine : 1u; nx = cnt > 0u ? cnt : 1u;
}

__device__ __forceinline__ void xcd_barrier(const XcdBarrier& b) {
    asm volatile("s_waitcnt vmcnt(0)" ::: "memory");
    __syncthreads();
    if (b.w == 0u && hw_lane() == 0) {
        unsigned* bar = b.bar; asm volatile("" : "+s"(bar));
        __builtin_amdgcn_s_waitcnt(0);
        unsigned nloc = b.st[0], nx = b.st[1];
        if (nloc == 0u) { xcd_barrier_complete(bar, b.x, nloc, nx); b.st[0] = nloc; b.st[1] = nx; }
        const unsigned old = xb_add(&bar[XB_XSUB(b.x)], 1u);
        const unsigned gen = old / nloc;
        if (old + 1u == (gen + 1u) * nloc) {
            __builtin_amdgcn_fence(__ATOMIC_RELEASE, "agent");
            asm volatile("s_waitcnt vmcnt(0)" ::: "memory");
            const unsigned og = xb_add(&bar[XB_TOP], 1u);
            const unsigned tg = og / nx;
            if (og + 1u == (tg + 1u) * nx) xb_add(&bar[XB_TOPGEN], 1u);
            else XB_SPIN(xb_ld(&bar[XB_TOPGEN]) == tg, bar);
            __builtin_amdgcn_fence(__ATOMIC_ACQUIRE, "agent");
            xb_add(&bar[XB_XGEN(b.x)], 1u);
            asm volatile("s_waitcnt vmcnt(0)" ::: "memory");
        } else {
            XB_SPIN(xb_ld(&bar[XB_XGEN(b.x)]) == gen, bar);
            __builtin_amdgcn_fence(__ATOMIC_ACQUIRE, "agent");
            asm volatile("s_waitcnt vmcnt(0)" ::: "memory");
        }
    }
    __syncthreads();
}
struct Ctx { int tid, lane, wave, G, gw, NGW; LAS unsigned char* lds; };
namespace pg8 {
#define PG8_LAS __attribute__((address_space(3)))
typedef unsigned short bf16_t;
typedef short bf16x8 __attribute__((ext_vector_type(8)));
typedef float f32x4 __attribute__((ext_vector_type(4)));
typedef unsigned u32x4 __attribute__((ext_vector_type(4)));
typedef int i32x4v __attribute__((ext_vector_type(4)));
typedef int i32x8v __attribute__((ext_vector_type(8)));
__device__ __forceinline__ i32x8v cat8(const bf16x8 a, const bf16x8 b) { return __builtin_shufflevector(__builtin_bit_cast(i32x4v, a), __builtin_bit_cast(i32x4v, b), 0, 1, 2, 3, 4, 5, 6, 7); }
constexpr int BM = 256, BK = 64, HALF = 128, HTB = HALF * BK * 2  , STAGE_BYTES = 8 * HTB, NXCD = 8, WGM = 8;

__host__ __device__ __forceinline__ int lds_byte(int r, int c) { const int st = (r >> 4) * 2 + (c >> 5), rr = r & 15, cc = c & 31, ob = rr * 64 + cc * 2; return st * 1024 + (ob ^ (((ob >> 9) & 1) << 5)); }
__host__ __device__ __forceinline__ void stage_rc(int b, int& R, int& C) { const int st = b / 1024, sb = b % 1024, swz = sb ^ (((sb >> 9) & 1) << 5); R = (st >> 1) * 16 + swz / 64; C = (st & 1) * 32 + (swz % 64) / 2; }
__host__ __device__ __forceinline__ int perm32(int rho) { const int n = rho >> 4, i = rho & 15; return 8 * (i >> 2) + 4 * n + (i & 3); }

struct Unit { int pm, pn; int koff = 0; unsigned side = 0; };
struct Gemm { const bf16_t* A; const bf16_t* Bt; int M, N, K, Kp; };

struct StaticOrder {
    int nM, nN, nwg, G, c;
    __host__ __device__ void init(int M, int N, int G_, int c_) { nM = M / BM; nN = N / BM; nwg = nM * nN; G = G_; c = c_; }
    __host__ __device__ bool next(int i, Unit& u) const {
        const long L = (long)i * G + c; if (L >= nwg) return false;
        int wgid = (int)L; { const int q = nwg / NXCD, r = nwg % NXCD, xcd = wgid % NXCD, off = wgid / NXCD; wgid = (xcd < r ? xcd * (q + 1) : r * (q + 1) + (xcd - r) * q) + off; }
        const int nig = WGM * nN, gid = wgid / nig, fm = gid * WGM, gsz = (nM - fm) < WGM ? (nM - fm) : WGM;
        u.pm = fm + ((wgid % nig) % gsz); u.pn = (wgid % nig) / gsz; return true;
    }
    __device__ __forceinline__ void a_ready(const Unit&) const {}
    __device__ __forceinline__ void done(const Unit&) const {}
};
typedef float f32x2 __attribute__((ext_vector_type(2)));
typedef __bf16 bf16x2_t __attribute__((ext_vector_type(2)));
__device__ __forceinline__ unsigned cvt_pk_bf16(float lo, float hi) { const f32x2 v = {lo, hi}; return __builtin_bit_cast(unsigned, __builtin_convertvector(v, bf16x2_t)); }
__device__ __forceinline__ void glds16(const void* base, unsigned voff, unsigned lds_addr) {
    asm volatile("s_mov_b32 m0, %2\n\ts_nop 0\n\tglobal_load_lds_dwordx4 %0, %1" :: "v"(voff), "s"(base), "s"(lds_addr) : "memory", "m0");
}
template <class E, class = void> struct EpiSide { static constexpr bool v = false; };
template <class E> struct EpiSide<E, decltype((void)E::SIDE)> { static constexpr bool v = E::SIDE; };
constexpr int SIDE_OFF = 8 * 128 * 64 * 2 + 1024, SIDE_BYTES = 4096;
template <class Epi, class Sched, bool ALIGN_EPI = false, bool SP2 = false, bool F8 = false>
__device__ __forceinline__ void gemm_phase(PG8_LAS unsigned char* lds, const Gemm g, const Sched& S, const Epi& E, const int tid) {
    const int wid = __builtin_amdgcn_readfirstlane(tid >> 6), lane = tid & 63, wr = wid >> 2, wc = wid & 3, fr = lane & 15, fq = lane >> 4;
    const int K = g.Kp; int nt = g.K / BK; if constexpr (F8) asm volatile("" : "+s"(nt));
    unsigned voffA[2], voffB[2];
#pragma unroll
    for (int i = 0; i < 2; ++i) { int R, C; stage_rc(tid * 16 + i * 8192, R, C); const int Rb = Epi::PERM ? ((R & ~31) + perm32(R & 31)) : R;
        voffA[i] = (unsigned)(R * K + C) * 2u; voffB[i] = (unsigned)(Rb * K + C) * 2u; }
    const size_t kstep = (size_t)(BK * 2);
    const size_t hstep = (size_t)HALF * K * 2;
    const size_t tstep = 2 * hstep;
    const unsigned ldsw = (unsigned)wid * 1024u;
    const unsigned ldsb = (unsigned)(size_t)lds + ldsw;
    const int aoff = lds_byte(wr * 64 + fr, fq * 8), boff = lds_byte(wc * 32 + fr, fq * 8);
#define PG8_SA(b, h) (((b) * 2 + (h)) * HTB)
#define PG8_SB(b, h) ((4 + (b) * 2 + (h)) * HTB)
#define PG8_STAGE(bufoff, gbase, voff) do { _Pragma("unroll") for (int _i = 0; _i < 2; ++_i) glds16((gbase), (voff)[_i], ldsb + (unsigned)((bufoff) + _i * 8192)); } while (0)
#define PG8_LDA(dst, b, h) do { _Pragma("unroll") for (int m = 0; m < 4; ++m) _Pragma("unroll") for (int k = 0; k < 2; ++k) dst[m][k] = *(const PG8_LAS bf16x8*)(lds + PG8_SA(b, h) + aoff + m * 2048 + k * 1024); } while (0)
#define PG8_LDB(dst, b, h) do { _Pragma("unroll") for (int n = 0; n < 2; ++n) _Pragma("unroll") for (int k = 0; k < 2; ++k) dst[n][k] = *(const PG8_LAS bf16x8*)(lds + PG8_SB(b, h) + boff + n * 2048 + k * 1024); } while (0)
#define PG8_MMA(ai, bj, At, Bt) do { __builtin_amdgcn_s_setprio(1); _Pragma("unroll") for (int m = 0; m < 4; ++m) _Pragma("unroll") for (int n = 0; n < 2; ++n) { \
        if constexpr (F8) acc[ai][bj][m][n] = __builtin_amdgcn_mfma_scale_f32_16x16x128_f8f6f4(cat8(Bt[n][0], Bt[n][1]), cat8(At[m][0], At[m][1]), acc[ai][bj][m][n], 0, 0, 0, 0, 0, 0); \
        else { _Pragma("unroll") for (int k = 0; k < 2; ++k) acc[ai][bj][m][n] = __builtin_amdgcn_mfma_f32_16x16x32_bf16(Bt[n][k], At[m][k], acc[ai][bj][m][n], 0, 0, 0); } } __builtin_amdgcn_s_setprio(0); } while (0)
#define PG8_WAIT_V(n) asm volatile("s_waitcnt vmcnt(" #n ")" ::: "memory")
#define PG8_WAIT_L(n) asm volatile("s_waitcnt lgkmcnt(" #n ")" ::: "memory")
#define PG8_BAR __builtin_amdgcn_s_barrier()
#define PG8_SCHED __builtin_amdgcn_sched_barrier(0)
    Unit cur, nxt; int ui = 0;
    if (!S.next(0, cur)) return;
    f32x4 acc[2][2][4][2];
#pragma unroll
    for (int a = 0; a < 2; ++a)
#pragma unroll
        for (int b = 0; b < 2; ++b)
#pragma unroll
            for (int m = 0; m < 4; ++m)
#pragma unroll
                for (int n = 0; n < 2; ++n) acc[a][b][m][n] = (f32x4){0.f, 0.f, 0.f, 0.f};
    bf16x8 At[4][2], B0[2][2], B1[2][2];
    const char* cA = (const char*)g.A + (size_t)cur.pm * tstep + cur.koff; const char* cB = (const char*)g.Bt + (size_t)cur.pn * tstep + cur.koff;
    if constexpr (EpiSide<Epi>::v) { cur.side = (unsigned)(size_t)lds + SIDE_OFF; E.side_issue(cur, wid); }
    S.a_ready(cur);
    if constexpr (SP2) {
        PG8_STAGE(PG8_SB(0, 0), cB, voffB); PG8_STAGE(PG8_SB(0, 1), cB + hstep, voffB); PG8_STAGE(PG8_SA(0, 0), cA, voffA); PG8_STAGE(PG8_SA(0, 1), cA + hstep, voffA);
        if (wr == 1) PG8_BAR;
        PG8_WAIT_V(2); PG8_BAR;
        PG8_STAGE(PG8_SB(1, 0), cB + kstep, voffB); PG8_STAGE(PG8_SA(1, 0), cA + kstep, voffA); PG8_STAGE(PG8_SB(1, 1), cB + hstep + kstep, voffB);
        PG8_WAIT_V(6); PG8_BAR;
    } else {
        PG8_STAGE(PG8_SB(0, 0), cB, voffB); PG8_STAGE(PG8_SA(0, 0), cA, voffA); PG8_STAGE(PG8_SB(0, 1), cB + hstep, voffB); PG8_STAGE(PG8_SA(0, 1), cA + hstep, voffA);
        if (wr == 1) PG8_BAR;
        PG8_WAIT_V(4); PG8_BAR;
        PG8_STAGE(PG8_SB(1, 0), cB + kstep, voffB); PG8_STAGE(PG8_SA(1, 0), cA + kstep, voffA); PG8_STAGE(PG8_SB(1, 1), cB + hstep + kstep, voffB);
        PG8_WAIT_V(6); PG8_BAR;
    }
    for (;;) {
        const bool has_next = S.next(ui + 1, nxt);
        const char* nA = has_next ? (const char*)g.A + (size_t)nxt.pm * tstep + nxt.koff : cA; const char* nB = has_next ? (const char*)g.Bt + (size_t)nxt.pn * tstep + nxt.koff : cB;
        for (int t = 0; t < nt; t += 2) {
            if constexpr (Epi::MID) { if (2 * t == nt) E.mid(acc, cur, wr, wc, fr, fq); }
            const bool last = (t == nt - 2);
            const char* a1 = cA + (size_t)(t + 1) * kstep;
            const char* a2 = last ? nA : cA + (size_t)(t + 2) * kstep; const char* b2 = last ? nB : cB + (size_t)(t + 2) * kstep;
            const char* a3 = a2 + kstep; const char* b3 = b2 + kstep;
            if (last && has_next) S.a_ready(nxt);
            if constexpr (SP2) {
            PG8_LDB(B0, 0, 0); PG8_LDB(B1, 0, 1); PG8_SCHED; PG8_LDA(At, 0, 0); PG8_STAGE(PG8_SA(1, 1), a1 + hstep, voffA);
            PG8_WAIT_V(8); PG8_WAIT_L(0); PG8_BAR; PG8_MMA(0, 0, At, B0); PG8_MMA(0, 1, At, B1); PG8_BAR; PG8_SCHED;
            PG8_LDA(At, 0, 1); PG8_STAGE(PG8_SB(0, 0), b2, voffB); PG8_STAGE(PG8_SB(0, 1), b2 + hstep, voffB); PG8_STAGE(PG8_SA(0, 0), a2, voffA);
            PG8_WAIT_V(8); PG8_WAIT_L(0); PG8_BAR; PG8_MMA(1, 0, At, B0); PG8_MMA(1, 1, At, B1); PG8_BAR; PG8_SCHED;
            PG8_LDB(B0, 1, 0); PG8_LDB(B1, 1, 1); PG8_SCHED; PG8_LDA(At, 1, 0); PG8_STAGE(PG8_SA(0, 1), a2 + hstep, voffA);
            PG8_WAIT_V(8); PG8_WAIT_L(0); PG8_BAR; PG8_MMA(0, 0, At, B0); PG8_MMA(0, 1, At, B1); PG8_BAR; PG8_SCHED;
            PG8_LDA(At, 1, 1); PG8_STAGE(PG8_SB(1, 0), b3, voffB); PG8_STAGE(PG8_SB(1, 1), b3 + hstep, voffB); PG8_STAGE(PG8_SA(1, 0), a3, voffA);
            PG8_WAIT_V(8); PG8_WAIT_L(0); PG8_BAR; PG8_MMA(1, 0, At, B0); PG8_MMA(1, 1, At, B1); PG8_BAR; PG8_SCHED;
            } else {
            PG8_LDB(B0, 0, 0); PG8_SCHED; PG8_LDA(At, 0, 0); PG8_STAGE(PG8_SA(1, 1), a1 + hstep, voffA);
            PG8_WAIT_L(8); PG8_BAR; PG8_WAIT_L(0); PG8_MMA(0, 0, At, B0); PG8_BAR; PG8_SCHED;
            PG8_LDB(B1, 0, 1); PG8_STAGE(PG8_SB(0, 0), b2, voffB);
            PG8_BAR; PG8_WAIT_L(0); PG8_MMA(0, 1, At, B1); PG8_BAR;
            PG8_LDA(At, 0, 1); PG8_STAGE(PG8_SA(0, 0), a2, voffA);
            PG8_BAR; PG8_WAIT_L(0); PG8_MMA(1, 0, At, B0); PG8_BAR; PG8_SCHED;
            PG8_STAGE(PG8_SB(0, 1), b2 + hstep, voffB);
            PG8_WAIT_V(6); PG8_BAR; PG8_MMA(1, 1, At, B1); PG8_BAR;
            PG8_LDB(B0, 1, 0); PG8_SCHED; PG8_LDA(At, 1, 0); PG8_STAGE(PG8_SA(0, 1), a2 + hstep, voffA);
            PG8_WAIT_L(8); PG8_BAR; PG8_WAIT_L(0); PG8_MMA(0, 0, At, B0); PG8_BAR; PG8_SCHED;
            PG8_LDB(B1, 1, 1); PG8_STAGE(PG8_SB(1, 0), b3, voffB);
            PG8_BAR; PG8_WAIT_L(0); PG8_MMA(0, 1, At, B1); PG8_BAR;
            PG8_LDA(At, 1, 1); PG8_STAGE(PG8_SA(1, 0), a3, voffA);
            PG8_BAR; PG8_WAIT_L(0); PG8_MMA(1, 0, At, B0); PG8_BAR; PG8_SCHED;
            PG8_STAGE(PG8_SB(1, 1), b3 + hstep, voffB);
            PG8_WAIT_V(6); PG8_BAR; PG8_MMA(1, 1, At, B1); PG8_BAR;
            }
        }
        if constexpr (ALIGN_EPI) { if (wr == 0) PG8_BAR; }
        if constexpr (!Epi::AFTER_DRAIN) { E(acc, cur, wr, wc, fr, fq); S.done(cur); }
        if (!has_next) break;
#pragma unroll
        for (int a = 0; a < 2; ++a)
#pragma unroll
            for (int b = 0; b < 2; ++b)
#pragma unroll
                for (int m = 0; m < 4; ++m)
#pragma unroll
                    for (int n = 0; n < 2; ++n) acc[a][b][m][n] = (f32x4){0.f, 0.f, 0.f, 0.f};
        cur = nxt; cA = nA; cB = nB; ++ui;
        if constexpr (EpiSide<Epi>::v) { cur.side = (unsigned)(size_t)lds + SIDE_OFF + (ui & 1) * SIDE_BYTES; E.side_issue(cur, wid); }
        if constexpr (ALIGN_EPI) { if (wr == 1) PG8_BAR; }
    }
    PG8_WAIT_V(0);
    if constexpr (!ALIGN_EPI) { if (wr == 0) PG8_BAR; }
    PG8_BAR;
    if constexpr (Epi::AFTER_DRAIN) { E.fused(acc, cur, wr, wc, fr, fq, lds, wid, lane); S.done(cur); }
#undef PG8_SA
#undef PG8_SB
#undef PG8_STAGE
#undef PG8_LDA
#undef PG8_LDB
#undef PG8_MMA
#undef PG8_WAIT_V
#undef PG8_WAIT_L
#undef PG8_BAR
#undef PG8_SCHED
}
}
using pg8::cvt_pk_bf16;
__device__ __forceinline__ u32x4 pack8(const f32x4 a, const f32x4 b) { u32x4 w; w.x = cvt_pk_bf16(a[0], a[1]); w.y = cvt_pk_bf16(a[2], a[3]); w.z = cvt_pk_bf16(b[0], b[1]); w.w = cvt_pk_bf16(b[2], b[3]); return w; }
__device__ __forceinline__ void unpack8(const u32x4 w, f32x4& a, f32x4& b) { a = (f32x4){bflo(w.x), bfhi(w.x), bflo(w.y), bfhi(w.y)}; b = (f32x4){bflo(w.z), bfhi(w.z), bflo(w.w), bfhi(w.w)}; }
constexpr float MOE_WGU_SCALE = 64.f, MOE_WD_SCALE = 128.f;
__device__ __forceinline__ unsigned pk4_f8(float a, float b, float c, float d) { const int w = __builtin_amdgcn_cvt_pk_fp8_f32(a, b, 0, false); return (unsigned)__builtin_amdgcn_cvt_pk_fp8_f32(c, d, w, true); }
__device__ __forceinline__ uint2 pack8_f8(const f32x4 a, const f32x4 b) { return make_uint2(pk4_f8(a[0], a[1], a[2], a[3]), pk4_f8(b[0], b[1], b[2], b[3])); }
__device__ __forceinline__ f32x4 clamp_f8(const f32x4 v) { return (f32x4){__builtin_amdgcn_fmed3f(v[0], -448.f, 448.f), __builtin_amdgcn_fmed3f(v[1], -448.f, 448.f), __builtin_amdgcn_fmed3f(v[2], -448.f, 448.f), __builtin_amdgcn_fmed3f(v[3], -448.f, 448.f)}; }
__device__ __forceinline__ float sum4sq(const f32x4 v) { return (v[0] * v[0] + v[1] * v[1]) + (v[2] * v[2] + v[3] * v[3]); }
__device__ __forceinline__ f32x4 sig4(const f32x4 v) { return (f32x4){sigmoidf_(v[0]), sigmoidf_(v[1]), sigmoidf_(v[2]), sigmoidf_(v[3])}; }
__device__ __forceinline__ f32x4 sig4f(const f32x4 v) { return (f32x4){sigmoid_fast(v[0]), sigmoid_fast(v[1]), sigmoid_fast(v[2]), sigmoid_fast(v[3])}; }

constexpr int CONV_SCR_BYTES = 64 * 65 * 4;
__device__ __forceinline__ int inv32(int lam) { return 16 * ((lam >> 2) & 1) + 4 * (lam >> 3) + (lam & 3); }
__device__ __forceinline__ void conv_load(const float* __restrict__ W, int ldw, int Ksrc, int Nsrc, int k0, int n0, int lane, f32x4 (&v)[16]) {
    const int r4 = lane >> 4, c4 = lane & 15;
    const bool colok = (n0 + 4 * c4) < Nsrc;
#pragma unroll
    for (int i = 0; i < 16; ++i) { const int k = k0 + 4 * i + r4; v[i] = (f32x4){0.f, 0.f, 0.f, 0.f}; if (colok && k < Ksrc) v[i] = *(const f32x4*)(W + (size_t)k * ldw + n0 + 4 * c4); }
}
template <class DstRow, bool F8 = false>
__device__ __forceinline__ void conv_emit(const f32x4 (&v)[16], int Ksrc, int Nsrc, bf16_t* __restrict__ WT, int Kdst, const float* __restrict__ gain, LAS float* scr, int k0, int n0, int lane, const DstRow& dstrow, float scale = 1.f) {
    const int r4 = lane >> 4, c4 = lane & 15;
#pragma unroll
    for (int i = 0; i < 16; ++i)
#pragma unroll
        for (int j = 0; j < 4; ++j) scr[(4 * i + r4) * 65 + 4 * c4 + j] = v[i][j];
    asm volatile("s_waitcnt lgkmcnt(0)" ::: "memory");
    const int kc = lane & 7;
    f32x4 g0 = (f32x4){1.f, 1.f, 1.f, 1.f}, g1 = g0;
    if (gain && k0 < Ksrc) { g0 = *(const f32x4*)(gain + k0 + 8 * kc); g1 = *(const f32x4*)(gain + k0 + 8 * kc + 4); }
    if constexpr (F8) { g0 = g0 * scale; g1 = g1 * scale; }
#pragma unroll
    for (int it = 0; it < 8; ++it) { const int nn = (lane >> 3) + 8 * it; const LAS float* s = scr + (8 * kc) * 65 + nn;
        const int dr = (n0 + nn) < Nsrc ? dstrow(n0 + nn) : -1;
        if constexpr (F8) { if (dr >= 0) *(uint2*)((unsigned char*)WT + (size_t)dr * Kdst + k0 + 8 * kc) = make_uint2(pk4_f8(s[0 * 65] * g0[0], s[1 * 65] * g0[1], s[2 * 65] * g0[2], s[3 * 65] * g0[3]), pk4_f8(s[4 * 65] * g1[0], s[5 * 65] * g1[1], s[6 * 65] * g1[2], s[7 * 65] * g1[3])); }
        else { u32x4 o; o.x = cvt_pk_bf16(s[0 * 65] * g0[0], s[1 * 65] * g0[1]); o.y = cvt_pk_bf16(s[2 * 65] * g0[2], s[3 * 65] * g0[3]); o.z = cvt_pk_bf16(s[4 * 65] * g1[0], s[5 * 65] * g1[1]); o.w = cvt_pk_bf16(s[6 * 65] * g1[2], s[7 * 65] * g1[3]);
            if (dr >= 0) *(u32x4*)(WT + (size_t)dr * Kdst + k0 + 8 * kc) = o; } }
    asm volatile("s_waitcnt lgkmcnt(0)" ::: "memory");
}
template <class DstRow, bool F8 = false>
__device__ __forceinline__ void conv_tile(const float* __restrict__ W, int ldw, int Ksrc, int Nsrc, bf16_t* __restrict__ WT, int Kdst, const float* __restrict__ gain, LAS float* scr, int k0, int n0, int lane, const DstRow& dstrow, float scale = 1.f) {
    f32x4 v[16]; conv_load(W, ldw, Ksrc, Nsrc, k0, n0, lane, v); conv_emit<DstRow, F8>(v, Ksrc, Nsrc, WT, Kdst, gain, scr, k0, n0, lane, dstrow, scale);
}
struct ConvDist { int w, nw, off, lo = 0, hi = 0x7fffffff;
    __device__ __forceinline__ int first(int items) { const int f = w < 0 ? items : (w - off % nw + nw) % nw; off += items; return f; }
    __device__ __forceinline__ void range(int items, int& first, int& end) {
        const int a = lo - off > 0 ? lo - off : 0; end = hi - off < items ? (hi - off > 0 ? hi - off : 0) : items;
        if (w < 0 || a >= end) first = end; else first = a + (w - (off + a - lo) % nw + nw) % nw;
        off += items; } };
template <class Job>
__device__ __forceinline__ void conv_run(const Job& J, int items, int first, int stride, int lane, LAS float* scr) {
    int it = first; if (it >= items) return;
    f32x4 va[16], vb[16];
    J.load(it, lane, va);
    for (;;) {
        const int it2 = it + stride;
        if (it2 < items) J.load(it2, lane, vb);
        J.emit(it, lane, scr, va);
        if (it2 >= items) break;
        const int it3 = it2 + stride;
        if (it3 < items) J.load(it3, lane, va);
        J.emit(it2, lane, scr, vb);
        if (it3 >= items) break;
        it = it3;
    }
}
__device__ __forceinline__ int lcol(int rho) { return (rho & ~31) + pg8::perm32(rho & 31); }
struct DstPlain { __device__ __forceinline__ int operator()(int n) const { return (n & ~31) + inv32(n & 31); } };
struct DstGateUp { int half; __device__ __forceinline__ int operator()(int n) const { return 256 * (n >> 7) + 128 * half + (n & 96) + inv32(n & 31); } };
struct DstProj { __device__ __forceinline__ int operator()(int n) const { const int L = n < 416 ? n : n + 96; return (L & ~31) + inv32(L & 31); } };
template <bool F8> struct JobPlain { const float* W; int Ksrc, Nsrc; bf16_t* WT; int Kdst; const float* gain; float scale; int nN; int ldw;
    __device__ __forceinline__ void load(int it, int lane, f32x4 (&v)[16]) const { conv_load(W, ldw, Ksrc, Nsrc, 64 * (it / nN), 64 * (it % nN), lane, v); }
    __device__ __forceinline__ void emit(int it, int lane, LAS float* scr, const f32x4 (&v)[16]) const { conv_emit<DstPlain, F8>(v, Ksrc, Nsrc, WT, Kdst, gain, scr, 64 * (it / nN), 64 * (it % nN), lane, DstPlain{}, scale); } };
template <bool F8 = false>
__device__ __forceinline__ void conv_plain(const Ctx& c, ConvDist& cd, LAS float* scr, const float* W, int Ksrc, int Nsrc, bf16_t* WT, int Kdst, const float* gain, float scale = 1.f, int ldw = 0  ) {
    const int nK = Kdst / 64, nN = (Nsrc + 63) / 64; JobPlain<F8> J{W, Ksrc, Nsrc, WT, Kdst, gain, scale, nN, ldw ? ldw : Nsrc}; conv_run(J, nK * nN, cd.first(nK * nN), cd.nw, c.lane, scr);
}
template <bool F8> struct JobGateUp { const float* Wg; size_t dWu  ; int FF; bf16_t* WT; const float* gain; float scale; int nN, per;
    __device__ __forceinline__ void load(int it, int lane, f32x4 (&v)[16]) const { const int e = it / per, r = it % per, half = r & 1, kb = (r >> 1) / nN, nb = (r >> 1) % nN; conv_load((const float*)((const char*)Wg + (size_t)half * dWu) + (size_t)e * D * FF, FF, D, FF, 64 * kb, 64 * nb, lane, v); }
    __device__ __forceinline__ void emit(int it, int lane, LAS float* scr, const f32x4 (&v)[16]) const { const int e = it / per, r = it % per, half = r & 1, kb = (r >> 1) / nN, nb = (r >> 1) % nN;
        conv_emit<DstGateUp, F8>(v, D, FF, (bf16_t*)((unsigned char*)WT + (size_t)e * 2 * FF * D * (F8 ? 1 : 2)), D, gain, scr, 64 * kb, 64 * nb, lane, DstGateUp{half}, scale); } };
template <bool F8 = false>
__device__ __forceinline__ void conv_gateup(const Ctx& c, ConvDist& cd, LAS float* scr, const float* Wg, const float* Wu, int FF, bf16_t* WT, const float* gain, int ne, float scale = 1.f) {
    const int nK = D / 64, nN = FF / 64, per = nK * nN * 2; JobGateUp<F8> J{Wg, (size_t)((const char*)Wu - (const char*)Wg), FF, WT, gain, scale, nN, per}; int f_, e_; cd.range(per * ne, f_, e_); conv_run(J, e_, f_, cd.nw, c.lane, scr);
}
struct DstKV { __device__ __forceinline__ int operator()(int n) const { const int head = n >> 7, part = (n >> 6) & 1, d = n & 63; return 256 * (head >> 1) + 128 * (d >> 5) + 32 * (2 * (head & 1) + part) + inv32(d & 31); } };
__device__ __forceinline__ void conv_kv(const Ctx& c, ConvDist& cd, LAS float* scr, const float* W, bf16_t* WT, const float* gain) {
    const int nK = 256 / 64, nN = 1024 / 64, items = nK * nN;
    for (int it = cd.first(items); it < items; it += cd.nw) { const int kb = it / nN, nb = it % nN; conv_tile(W, 1024, KVLR, 1024, WT, 256, gain, scr, 64 * kb, 64 * nb, c.lane, DstKV{}); }
}
__device__ __forceinline__ void conv_plain_at(const Ctx& c, ConvDist& cd, LAS float* scr, const float* W, int Ksrc, int Nsrc, bf16_t* WT, int Kdst, int k_at) {
    const int nK = Ksrc / 64, nN = Nsrc / 64, items = nK * nN;
    for (int it = cd.first(items); it < items; it += cd.nw) { const int kb = it / nN, nb = it % nN; conv_tile(W, Nsrc, Ksrc, Nsrc, WT + k_at, Kdst, nullptr, scr, 64 * kb, 64 * nb, c.lane, DstPlain{}); }
}
template <bool F8> struct JobPlainN { const float* W; int Ksrc, Nsrc; bf16_t* WT; float scale; int nN, per;
    __device__ __forceinline__ void load(int it, int lane, f32x4 (&v)[16]) const { const int e = it / per, r = it % per; conv_load(W + (size_t)e * Ksrc * Nsrc, Nsrc, Ksrc, Nsrc, 64 * (r / nN), 64 * (r % nN), lane, v); }
    __device__ __forceinline__ void emit(int it, int lane, LAS float* scr, const f32x4 (&v)[16]) const { const int e = it / per, r = it % per;
        conv_emit<DstPlain, F8>(v, Ksrc, Nsrc, (bf16_t*)((unsigned char*)WT + (size_t)e * Nsrc * Ksrc * (F8 ? 1 : 2)), Ksrc, nullptr, scr, 64 * (r / nN), 64 * (r % nN), lane, DstPlain{}, scale); } };
template <bool F8 = false>
__device__ __forceinline__ void conv_plain_n(const Ctx& c, ConvDist& cd, LAS float* scr, const float* W, int Ksrc, int Nsrc, bf16_t* WT, int ne, float scale = 1.f) {
    const int nK = Ksrc / 64, nN = Nsrc / 64, per = nK * nN; JobPlainN<F8> J{W, Ksrc, Nsrc, WT, scale, nN, per}; int f_, e_; cd.range(per * ne, f_, e_); conv_run(J, e_, f_, cd.nw, c.lane, scr);
}
__device__ __forceinline__ int proj_src(int L) { return L < 416 ? L : (L < 512 ? -1 : L - 96); }
__device__ __forceinline__ void conv_proj(const Ctx& c, ConvDist& cd, LAS float* scr, const float* W, bf16_t* WT, const float* gain) {
    { bf16_t* zp = WT + (size_t)416 * D; asm volatile("" : "+s"(zp));
      for (int i = blockIdx.x * NTHREADS + c.tid; i < 96 * D / 8; i += c.G * NTHREADS) *(u32x4*)(zp + (size_t)i * 8) = (u32x4){0u, 0u, 0u, 0u}; }
    const int nK = D / 64, nN = (928 + 63) / 64  , items = nK * nN;
    for (int it = cd.first(items); it < items; it += cd.nw) { const int kb = it / nN, nb = it % nN; conv_tile(W, INC, D, INC, WT, D, gain, scr, 64 * kb, 64 * nb, c.lane, DstProj{}); }
}
__device__ __forceinline__ void f_xbss(const Ctx& c, const float* __restrict__ x, bf16_t* __restrict__ xb, unsigned char* __restrict__ xb8, unsigned long long* __restrict__ xss, int first_wg) {
    if ((int)blockIdx.x < first_wg) return;
    const int gw = ((int)blockIdx.x - first_wg) * NWAVES + c.wave, ngw = (c.G - first_wg) * NWAVES;
    for (int row0 = gw; row0 < T; row0 += 4 * ngw) {
        f32x4 a[4][2], b[4][2];
#pragma unroll
        for (int k = 0; k < 4; ++k) { const int row = row0 + k * ngw < T ? row0 + k * ngw : row0; const f32x4* xr = (const f32x4*)(x + (size_t)row * D) + 2 * c.lane;
#pragma unroll
            for (int j = 0; j < 2; ++j) { a[k][j] = xr[128 * j]; b[k][j] = xr[128 * j + 1]; } }
#pragma unroll
        for (int k = 0; k < 4; ++k) { const int row = row0 + k * ngw; if (row >= T) break;
            float s = 0.f;
#pragma unroll
            for (int j = 0; j < 2; ++j) { s += sum4sq(a[k][j]) + sum4sq(b[k][j]); *((u32x4*)(xb + (size_t)row * D) + c.lane + 64 * j) = pack8(a[k][j], b[k][j]); *((uint2*)(xb8 + (size_t)row * D) + c.lane + 64 * j) = pack8_f8(a[k][j], b[k][j]); }
            s = wave_sum(s, c.lane);
            if (c.lane == 0) xss[row] = (unsigned long long)(s * 65536.f + 0.5f); }
    }
}

typedef unsigned long long u64;
__device__ __forceinline__ u64 ss_fix(float s) { return (u64)(s * 65536.f + 0.5f); }
__device__ __forceinline__ float ss_val(u64 v) { return (float)v * (1.f / 65536.f); }
#define EPI_ROW(un, ai, m) ((un).pm * 256 + (ai) * 128 + wr * 64 + (m) * 16 + fr)
struct EpiProjF {
    static constexpr bool PERM = false, AFTER_DRAIN = false, MID = false, SIDE = true;
    __device__ __forceinline__ void side_issue(const pg8::Unit& un, int wid) const {
        if (wid < 2) pg8::glds16(xss + (size_t)un.pm * 256, (unsigned)wid * 1024u + (unsigned)hw_lane() * 16u, un.side + (unsigned)wid * 1024u);
        else if (wid == 2) pg8::glds16(bias + (size_t)(un.pn + pn0) * 256, (unsigned)hw_lane() * 16u, un.side + 2048u); }
    const u64* xss; const float* bias; bf16_t* qlat; bf16_t* kvlat; bf16_t* u; bf16_t* ga; bf16_t* gb; u64* qss; u64* kvss; float* krss; int pn0  ; float asc  ;
    __device__ __forceinline__ void operator()(const f32x4 (&acc)[2][2][4][2], const pg8::Unit& un, int wr, int wc, int fr, int fq) const { auto xss_ = xss; asm volatile("" : "+s"(xss_)); auto bias_ = bias; asm volatile("" : "+s"(bias_)); auto qlat_ = qlat; asm volatile("" : "+s"(qlat_)); auto kvlat_ = kvlat; asm volatile("" : "+s"(kvlat_)); auto u_ = u; asm volatile("" : "+s"(u_)); auto ga_ = ga; asm volatile("" : "+s"(ga_)); auto gb_ = gb; asm volatile("" : "+s"(gb_)); auto qss_ = qss; asm volatile("" : "+s"(qss_)); auto kvss_ = kvss; asm volatile("" : "+s"(kvss_)); auto krss_ = krss; asm volatile("" : "+s"(krss_));
        { const int l_ = hw_lane(); fr = l_ & 15; fq = l_ >> 4; }
        const int pn = un.pn + pn0, cl = wc * 32 + 8 * fq;
        f32x4 bv[2][2];
#pragma unroll
        for (int bj = 0; bj < 2; ++bj)
#pragma unroll
            for (int n = 0; n < 2; ++n) bv[bj][n] = *(const LAS f32x4*)((const LAS float*)(size_t)(un.side + 2048u) + bj * 128 + cl + 4 * n);
#pragma unroll
        for (int ai = 0; ai < 2; ++ai)
#pragma unroll
            for (int m = 0; m < 4; ++m) {
                const int row = EPI_ROW(un, ai, m);
                const float r = rsqrtf(ss_val(((const LAS u64*)(size_t)un.side)[ai * 128 + wr * 64 + m * 16 + fr]) * (1.f / D) + EPS) * asc;
                f32x4 v[2][2];
#pragma unroll
                for (int bj = 0; bj < 2; ++bj)
#pragma unroll
                    for (int n = 0; n < 2; ++n) v[bj][n] = acc[ai][bj][m][n] * r + bv[bj][n];
                if (pn == 0) {
                    *(u32x4*)(qlat_ + (size_t)row * 256 + cl) = pack8(v[0][0], v[0][1]); *(u32x4*)(qlat_ + (size_t)row * 256 + 128 + cl) = pack8(v[1][0], v[1][1]);
                    float s = (sum4sq(v[0][0]) + sum4sq(v[0][1])) + (sum4sq(v[1][0]) + sum4sq(v[1][1]));
                    s = xadd<32>(xadd<16>(s, fq * 16 + fr), fq * 16 + fr);
                    if (fq == 0) atomicAdd(qss_ + row, ss_fix(s));
                } else if (pn == 1) {
                    *(u32x4*)(kvlat_ + (size_t)row * 256 + cl) = pack8(v[0][0], v[0][1]); *(u32x4*)(kvlat_ + (size_t)row * 256 + 128 + cl) = pack8(v[1][0], v[1][1]);
                    float s = sum4sq(v[0][0]) + sum4sq(v[0][1]);
                    s = xadd<32>(xadd<16>(s, fq * 16 + fr), fq * 16 + fr);
                    if (fq == 0) atomicAdd(kvss_ + row, ss_fix(s));
                    if (wc == 0) { float s2 = sum4sq(v[1][0]) + sum4sq(v[1][1]); s2 = xadd<32>(xadd<16>(s2, fq * 16 + fr), fq * 16 + fr); if (fq == 0) krss_[row] = s2; }
                } else if (pn < 4) {
                    bf16_t* p = u_ + (size_t)row * 512 + (pn - 2) * 256 + cl;
                    *(u32x4*)p = pack8(v[0][0], v[0][1]); *(u32x4*)(p + 128) = pack8(v[1][0], v[1][1]);
                } else {
                    bf16_t* p = (pn < 8 ? ga_ + (size_t)row * 1024 + (pn - 4) * 256 : gb_ + (size_t)row * 1024 + (pn - 8) * 256) + cl;
                    *(u32x4*)p = pack8(sig4(v[0][0]), sig4(v[0][1])); *(u32x4*)(p + 128) = pack8(sig4(v[1][0]), sig4(v[1][1]));
                }
            }
    }
};
struct EpiRowScale {
    static constexpr bool PERM = false, AFTER_DRAIN = false, MID = false;
    bf16_t* O; const u64* ss; int ldc; float invn;
    __device__ __forceinline__ void operator()(const f32x4 (&acc)[2][2][4][2], const pg8::Unit& un, int wr, int wc, int fr, int fq) const { auto O_ = O; asm volatile("" : "+s"(O_)); auto ss_ = ss; asm volatile("" : "+s"(ss_));
        const int c0 = un.pn * 256 + wc * 32 + 8 * fq;
#pragma unroll
        for (int ai = 0; ai < 2; ++ai)
#pragma unroll
            for (int m = 0; m < 4; ++m) { const int row = EPI_ROW(un, ai, m); const float r = rsqrtf(ss_val(ss_[row]) * invn + EPS);
#pragma unroll
                for (int bj = 0; bj < 2; ++bj) *(u32x4*)(O_ + (size_t)row * ldc + c0 + bj * 128) = pack8(acc[ai][bj][m][0] * r, acc[ai][bj][m][1] * r); }
    }
};
constexpr float ATT_KSC = 0.38372444022488722f;
__device__ __forceinline__ int vt_pos(int kk) { const int u = kk >> 5, c = kk & 31, h = (c >> 2) & 1, jl = (c & 3) + 4 * (c >> 3); return 32 * h + jl + 16 * u; }
constexpr int VT_IMG_PITCH = 68;
template <bool LDSPATH> struct EpiKVT {
    static constexpr bool PERM = false, AFTER_DRAIN = LDSPATH, MID = false;
    const u64* kvss; const float* krss; const bf16_t* kvlat; const float* gk; const float* rope; bf16_t* Kn; bf16_t* Vn;
    __device__ __forceinline__ void operator()(const f32x4 (&acc)[2][2][4][2], const pg8::Unit& un, int wr, int wc, int fr, int fq) const { body(acc, un, wr, wc, fr, fq, nullptr, 0); }
    __device__ __forceinline__ void fused(const f32x4 (&acc)[2][2][4][2], const pg8::Unit& un, int wr, int wc, int fr, int fq, LAS unsigned char* lds, int wid, int lane) const { body(acc, un, wr, wc, fr, fq, lds, wid * 64 + lane); }
    __device__ __forceinline__ void body(const f32x4 (&acc)[2][2][4][2], const pg8::Unit& un, int wr, int wc, int fr, int fq, LAS unsigned char* img, int tid) const {
        asm volatile("" : "+v"(fr), "+v"(fq));
        auto kvss_ = kvss; asm volatile("" : "+s"(kvss_)); auto krss_ = krss; asm volatile("" : "+s"(krss_)); auto kvlat_ = kvlat; asm volatile("" : "+s"(kvlat_)); auto gk_ = gk; asm volatile("" : "+s"(gk_));
        auto rope_ = rope; asm volatile("" : "+s"(rope_)); auto Kn_ = Kn; asm volatile("" : "+s"(Kn_)); auto Vn_ = Vn; asm volatile("" : "+s"(Vn_));
        const int head = 2 * un.pn + (wc >> 1), lane = fq * 16 + fr;
        if ((wc & 1) == 0) {
            f32x4 g[2][2], gr1, gr2;
#pragma unroll
            for (int bj = 0; bj < 2; ++bj)
#pragma unroll
                for (int n = 0; n < 2; ++n) g[bj][n] = *(const f32x4*)(gk_ + 32 * bj + 8 * fq + 4 * n);
            gr1 = *(const f32x4*)(gk_ + 64 + 4 * fq); gr2 = *(const f32x4*)(gk_ + 80 + 4 * fq);
#pragma unroll
            for (int ai = 0; ai < 2; ++ai)
#pragma unroll
                for (int m = 0; m < 4; ++m) { const int row = EPI_ROW(un, ai, m); const float rkv = rsqrtf(ss_val(kvss_[row]) * (1.f / 128.f) + EPS);
                    f32x4 v[2][2]; float s = 0.f;
#pragma unroll
                    for (int bj = 0; bj < 2; ++bj)
#pragma unroll
                        for (int n = 0; n < 2; ++n) { v[bj][n] = acc[ai][bj][m][n] * rkv; s += sum4sq(v[bj][n]); }
                    s = xadd<32>(xadd<16>(s, lane), lane);
                    const float rk = rsqrtf((s + krss_[row]) * (1.f / 96.f) + EPS);
                    const float rks = rk * ATT_KSC; const int b = row / SEQ, sp = row % SEQ; unsigned char* kp = (unsigned char*)Kn_ + ((size_t)(b * NH + head) * SEQ + sp) * 128;
#pragma unroll
                    for (int bj = 0; bj < 2; ++bj) *(uint2*)(kp + 32 * (fq & 1) + 8 * (2 * bj + (fq >> 1))) = pack8_f8(v[bj][0] * g[bj][0] * rks, v[bj][1] * g[bj][1] * rks);
                    const uint2 w1 = *(const uint2*)(kvlat_ + (size_t)row * 256 + 128 + 4 * fq), w2 = *(const uint2*)(kvlat_ + (size_t)row * 256 + 144 + 4 * fq);
                    const f32x4 x1 = (f32x4){bflo(w1.x), bfhi(w1.x), bflo(w1.y), bfhi(w1.y)} * gr1 * rks, x2 = (f32x4){bflo(w2.x), bfhi(w2.x), bflo(w2.y), bfhi(w2.y)} * gr2 * rks;
                    const f32x4* rp = (const f32x4*)(rope_ + ((size_t)sp * 16 + 4 * fq) * 2); const f32x4 c01 = rp[0], c23 = rp[1];
                    const f32x4 cs = (f32x4){c01[0], c01[2], c23[0], c23[2]}, sn = (f32x4){c01[1], c01[3], c23[1], c23[3]};
                    const f32x4 o1 = x1 * cs - x2 * sn, o2 = x2 * cs + x1 * sn;
                    unsigned char* kr = kp + 64 + 32 * (fq >> 1) + 4 * (fq & 1);
                    *(unsigned*)kr = pk4_f8(o1[0], o1[1], o1[2], o1[3]); *(unsigned*)(kr + 8) = pk4_f8(o2[0], o2[1], o2[2], o2[3]);
                    *(uint2*)(kp + 80 + 32 * (fq >> 1) + 8 * (fq & 1)) = make_uint2(fq == 0 ? 0x38u : 0u, 0u); }
        } else {
#pragma unroll
            for (int ai = 0; ai < 2; ++ai)
#pragma unroll
                for (int m = 0; m < 4; ++m) { const int row = EPI_ROW(un, ai, m); const float rkv = rsqrtf(ss_val(kvss_[row]) * (1.f / 128.f) + EPS);
                    const int key = ai * 128 + wr * 64 + m * 16 + fr, pos = vt_pos(key & 63);
#pragma unroll
                    for (int bj = 0; bj < 2; ++bj) { const uint2 w = pack8_f8(acc[ai][bj][m][0] * rkv, acc[ai][bj][m][1] * rkv);
                        if constexpr (LDSPATH) { LAS unsigned char* p = img + ((((wc >> 1) * 4 + (key >> 6)) * 64 + 32 * bj + 8 * fq) * VT_IMG_PITCH) + pos;
#pragma unroll
                            for (int i = 0; i < 4; ++i) { p[i * VT_IMG_PITCH] = (unsigned char)(w.x >> (8 * i)); p[(4 + i) * VT_IMG_PITCH] = (unsigned char)(w.y >> (8 * i)); } }
                        else { const int b = row / SEQ, sp = row % SEQ; unsigned char* p = (unsigned char*)Vn_ + (((size_t)(b * NH + head) * (SEQ / 64) + (sp >> 6)) * 64 + 32 * bj + 8 * fq) * 64 + pos;
#pragma unroll
                            for (int i = 0; i < 4; ++i) { p[i * 64] = (unsigned char)(w.x >> (8 * i)); p[(4 + i) * 64] = (unsigned char)(w.y >> (8 * i)); } } } }
        }
        if constexpr (LDSPATH) {
            __syncthreads();
            const int hl = tid >> 8, tl = (tid >> 6) & 3, d = tid & 63; const int row0 = un.pm * 256, b = row0 / SEQ, sp0 = row0 % SEQ;
            const LAS unsigned* src = (const LAS unsigned*)(img + tid * VT_IMG_PITCH);
            u32x4* dst = (u32x4*)((unsigned char*)Vn_ + (((size_t)(b * NH + 2 * un.pn + hl) * (SEQ / 64) + (sp0 >> 6) + tl) * 64 + d) * 64);
#pragma unroll
            for (int q4 = 0; q4 < 4; ++q4) dst[q4] = (u32x4){src[4 * q4], src[4 * q4 + 1], src[4 * q4 + 2], src[4 * q4 + 3]};
        }
    }
};
typedef EpiKVT<true> EpiKV;
typedef EpiKVT<false> EpiKVslow;
struct EpiGluF {
    static constexpr bool PERM = false, AFTER_DRAIN = false, MID = false;
    const bf16_t* yg; const float* b; bf16_t* out; int ldo, pad_;
    __device__ __forceinline__ void operator()(const f32x4 (&acc)[2][2][4][2], const pg8::Unit& un, int wr, int wc, int fr, int fq) const { auto yg_ = yg; asm volatile("" : "+s"(yg_)); auto b_ = b; asm volatile("" : "+s"(b_)); auto out_ = out; asm volatile("" : "+s"(out_));
        const int c0 = un.pn * 256 + wc * 32 + 8 * fq;
        f32x4 bv[2][2];
#pragma unroll
        for (int bj = 0; bj < 2; ++bj)
#pragma unroll
            for (int n = 0; n < 2; ++n) bv[bj][n] = *(const f32x4*)(b_ + c0 + bj * 128 + 4 * n);
#pragma unroll
        for (int ai = 0; ai < 2; ++ai)
#pragma unroll
            for (int m = 0; m < 4; ++m) { const int row = EPI_ROW(un, ai, m);
#pragma unroll
                for (int bj = 0; bj < 2; ++bj) { const size_t o = (size_t)row * 512 + c0 + bj * 128; f32x4 y0, y1; unpack8(*(const u32x4*)(yg_ + o), y0, y1);
                    *(u32x4*)(out_ + (size_t)row * ldo + c0 + bj * 128) = pack8(y0 * sig4f(acc[ai][bj][m][0] + bv[bj][0]), y1 * sig4f(acc[ai][bj][m][1] + bv[bj][1])); } }
    }
};
struct EpiMixFused {
    static constexpr bool PERM = false, AFTER_DRAIN = false, MID = true;
    const bf16_t* ga; const bf16_t* gb; bf16_t* out;
    __device__ __forceinline__ void mid(f32x4 (&acc)[2][2][4][2], const pg8::Unit& un, int wr, int wc, int fr, int fq) const { auto ga_ = ga; asm volatile("" : "+s"(ga_)); auto gb_ = gb; asm volatile("" : "+s"(gb_));
        const int c0 = un.pn * 256 + wc * 32 + 8 * fq;
#pragma unroll
        for (int ai = 0; ai < 2; ++ai)
#pragma unroll
            for (int m = 0; m < 4; ++m) { const int row = EPI_ROW(un, ai, m);
#pragma unroll
                for (int bj = 0; bj < 2; ++bj) { const size_t o = (size_t)row * 1024 + c0 + bj * 128; f32x4 a0, a1, b0, b1; unpack8(*(const u32x4*)(ga_ + o), a0, a1); unpack8(*(const u32x4*)(gb_ + o), b0, b1);
#pragma unroll
                    for (int j = 0; j < 4; ++j) { acc[ai][bj][m][0][j] *= a0[j] * __builtin_amdgcn_rcpf(fmaxf(b0[j], 8.6736174e-19f)); acc[ai][bj][m][1][j] *= a1[j] * __builtin_amdgcn_rcpf(fmaxf(b1[j], 8.6736174e-19f)); } } }
    }
    __device__ __forceinline__ void operator()(const f32x4 (&acc)[2][2][4][2], const pg8::Unit& un, int wr, int wc, int fr, int fq) const { auto gb_ = gb; asm volatile("" : "+s"(gb_)); auto out_ = out; asm volatile("" : "+s"(out_));
        const int c0 = un.pn * 256 + wc * 32 + 8 * fq;
#pragma unroll
        for (int ai = 0; ai < 2; ++ai)
#pragma unroll
            for (int m = 0; m < 4; ++m) { const int row = EPI_ROW(un, ai, m);
#pragma unroll
                for (int bj = 0; bj < 2; ++bj) { const size_t o = (size_t)row * 1024 + c0 + bj * 128; f32x4 b0, b1; unpack8(*(const u32x4*)(gb_ + o), b0, b1);
#pragma unroll
                    for (int j = 0; j < 4; ++j) { b0[j] = fmaxf(b0[j], 8.6736174e-19f); b1[j] = fmaxf(b1[j], 8.6736174e-19f); }
                    *(u32x4*)(out_ + o) = pack8(acc[ai][bj][m][0] * b0, acc[ai][bj][m][1] * b1); } }
    }
};
template <bool IN_BF16, bool OUT_F32, bool OUT_BF16 = !OUT_F32, bool OUT_F8 = OUT_F32, int ACC_SHIFT = 0> struct EpiResidF {
    static constexpr bool PERM = false, AFTER_DRAIN = false, MID = false;
    const float* xin; float* xout; bf16_t* xb; u64* xssn; unsigned char* xb8;
    __device__ __forceinline__ void operator()(const f32x4 (&acc)[2][2][4][2], const pg8::Unit& un, int wr, int wc, int fr, int fq) const { auto xin_ = xin; asm volatile("" : "+s"(xin_)); auto xout_ = xout; asm volatile("" : "+s"(xout_)); auto xb_ = xb; asm volatile("" : "+s"(xb_)); auto xssn_ = xssn; asm volatile("" : "+s"(xssn_)); auto xb8_ = xb8; asm volatile("" : "+s"(xb8_));
        const int c0 = un.pn * 256 + wc * 32 + 8 * fq;
#pragma unroll
        for (int ai = 0; ai < 2; ++ai)
#pragma unroll
            for (int m = 0; m < 4; ++m) { const int row = EPI_ROW(un, ai, m); float s = 0.f;
#pragma unroll
                for (int bj = 0; bj < 2; ++bj) { const size_t o = (size_t)row * 1024 + c0 + bj * 128;
                    f32x4 x0, x1; if (IN_BF16) unpack8(*(const u32x4*)(xb_ + o), x0, x1); else { x0 = *(const f32x4*)(xin_ + o); x1 = *(const f32x4*)(xin_ + o + 4); }
                    constexpr float asc = 1.f / (float)(1 << ACC_SHIFT);
                    const f32x4 y0 = x0 + acc[ai][bj][m][0] * asc, y1 = x1 + acc[ai][bj][m][1] * asc;
                    if (OUT_F32) { *(f32x4*)(xout_ + o) = y0; *(f32x4*)(xout_ + o + 4) = y1; }
                    if (OUT_F8) *(uint2*)(xb8_ + o) = pack8_f8(y0, y1);
                    if (OUT_BF16) *(u32x4*)(xb_ + o) = pack8(y0, y1);
                    s += sum4sq(y0) + sum4sq(y1); }
                s = xadd<32>(xadd<16>(s, fq * 16 + fr), fq * 16 + fr);
                if (fq == 0) atomicAdd(xssn_ + row, ss_fix(s)); }
    }
};
typedef unsigned u32x2g __attribute__((ext_vector_type(2)));
template <bool OUT_F8> struct EpiSwigluT {
    static constexpr bool PERM = false, AFTER_DRAIN = false, MID = false, SIDE = true;
    __device__ __forceinline__ void side_issue(const pg8::Unit& un, int wid) const {
        if (rrow) { if (wid == 0) pg8::glds16(rrow + (size_t)un.pm * 256, (unsigned)hw_lane() * 16u, un.side); }
        else if (wid < 2) pg8::glds16(xss + (size_t)un.pm * 256, (unsigned)wid * 1024u + (unsigned)hw_lane() * 16u, un.side + (unsigned)wid * 1024u); }
    bf16_t* h; const u64* xss; const float* rrow; int ldh; int tiles_per_group; float oscale  ;
    __device__ __forceinline__ void operator()(const f32x4 (&acc)[2][2][4][2], const pg8::Unit& un, int wr, int wc, int fr, int fq) const { auto h_ = h; asm volatile("" : "+s"(h_)); auto xss_ = xss; asm volatile("" : "+s"(xss_)); auto rrow_ = rrow; asm volatile("" : "+s"(rrow_));
        asm volatile("" : "+v"(fr), "+v"(fq));
        const int c0 = (un.pn % tiles_per_group) * 128 + wc * 32 + 8 * fq;
#pragma unroll
        for (int ai = 0; ai < 2; ++ai)
#pragma unroll
            for (int m = 0; m < 4; ++m) { const int row = EPI_ROW(un, ai, m), rl = ai * 128 + wr * 64 + m * 16 + fr;
                const float r = rrow_ ? ((const LAS float*)(size_t)un.side)[rl] : rsqrtf(ss_val(((const LAS u64*)(size_t)un.side)[rl]) * (1.f / D) + EPS) * oscale;
                f32x4 o[2];
#pragma unroll
                for (int n = 0; n < 2; ++n) { const f32x4 g = acc[ai][0][m][n] * r, uu = acc[ai][1][m][n] * r; o[n] = (f32x4){siluf_(g[0]) * uu[0], siluf_(g[1]) * uu[1], siluf_(g[2]) * uu[2], siluf_(g[3]) * uu[3]}; }
                if constexpr (OUT_F8) { const uint2 pk_ = pack8_f8(clamp_f8(o[0]), clamp_f8(o[1])); *(GAS u32x2g*)((GAS unsigned char*)h_ + (size_t)row * ldh + c0) = (u32x2g){pk_.x, pk_.y}; }
                else *(GAS u32x4*)((GAS bf16_t*)h_ + (size_t)row * ldh + c0) = pack8(o[0], o[1]); }
    }
};
typedef EpiSwigluT<false> EpiSwigluF;
typedef EpiSwigluT<true> EpiSwigluF8;
struct EpiStoreBf16 {
    static constexpr bool PERM = false, AFTER_DRAIN = false, MID = false;
    bf16_t* O; int ldc; int tiles_per_group;
    __device__ __forceinline__ void operator()(const f32x4 (&acc)[2][2][4][2], const pg8::Unit& un, int wr, int wc, int fr, int fq) const { auto O_ = O; asm volatile("" : "+s"(O_));
        const int c0 = (un.pn % tiles_per_group) * 256 + wc * 32 + 8 * fq;
#pragma unroll
        for (int ai = 0; ai < 2; ++ai)
#pragma unroll
            for (int m = 0; m < 4; ++m) { const int row = EPI_ROW(un, ai, m);
#pragma unroll
                for (int bj = 0; bj < 2; ++bj) *(u32x4*)(O_ + (size_t)row * ldc + c0 + bj * 128) = pack8(acc[ai][bj][m][0], acc[ai][bj][m][1]); }
    }
};

__device__ __forceinline__ void f_rope_table(const Ctx& c, float* __restrict__ rope) {
    for (int i = blockIdx.x * NTHREADS + c.tid; i < SEQ * 16; i += c.G * NTHREADS) { float sn, cs; sincos_rev((double)(i >> 4) * c_invrev[i & 15], sn, cs); rope[2 * i] = cs; rope[2 * i + 1] = sn; }
}
template <bool ALLRED> struct EpiSplitKT {
    static constexpr bool PERM = false, AFTER_DRAIN = true, MID = false;
    bf16_t* O; float* slabs; unsigned* tickets; int ldc, per_e, rt0, nsl, kslice_bytes;
    __device__ __forceinline__ void fused(f32x4 (&acc)[2][2][4][2], const pg8::Unit& un, int wr, int wc, int fr, int fq, LAS unsigned char* lds, int wid, int lane) const {
        const int pnl = un.pn % per_e, tu = (un.pm - rt0) * per_e + pnl, sl = un.koff / kslice_bytes;
        float* my = slabs + ((size_t)tu * nsl + sl) * 65536;
#pragma unroll
        for (int ai = 0; ai < 2; ++ai)
#pragma unroll
            for (int m = 0; m < 4; ++m) { const int rl = ai * 128 + wr * 64 + m * 16 + fr;
#pragma unroll
                for (int bj = 0; bj < 2; ++bj)
#pragma unroll
                    for (int n = 0; n < 2; ++n) *(f32x4*)(my + rl * 256 + bj * 128 + wc * 32 + 8 * fq + 4 * n) = acc[ai][bj][m][n]; }
        asm volatile("s_waitcnt vmcnt(0)" ::: "memory");
        __syncthreads();
        LAS unsigned* flag = (LAS unsigned*)lds;
        if (wid == 0 && lane == 0) {
            __builtin_amdgcn_fence(__ATOMIC_RELEASE, "agent"); asm volatile("s_waitcnt vmcnt(0)" ::: "memory");
            const unsigned tk = __hip_atomic_fetch_add(tickets + 64 * tu, 1u, __ATOMIC_RELAXED, __HIP_MEMORY_SCOPE_AGENT);
            unsigned last = (tk == (unsigned)(nsl - 1)) ? 1u : 0u;
            if constexpr (ALLRED) { unsigned sp_ = 0u; while (__hip_atomic_load(tickets + 64 * tu, __ATOMIC_RELAXED, __HIP_MEMORY_SCOPE_AGENT) < (unsigned)nsl) { __builtin_amdgcn_s_sleep(2); if (++sp_ > (1u << 22)) break; } last = 1u; }
            if (last) { __builtin_amdgcn_fence(__ATOMIC_ACQUIRE, "agent"); asm volatile("s_waitcnt vmcnt(0)" ::: "memory"); }
            flag[0] = last;
        }
        asm volatile("s_waitcnt lgkmcnt(0)" ::: "memory");
        __syncthreads();
        if (flag[0] == 0u) return;
        const float* s0 = slabs + (size_t)tu * nsl * 65536;
        if constexpr (ALLRED) {
            const int R = (256 + nsl - 1) / nsl, r0 = sl * R, r1 = r0 + R < 256 ? r0 + R : 256, tid = wid * 64 + lane;
            for (int i = r0 * 64 + tid; i < r1 * 64; i += NTHREADS) { const int rl = i >> 6, cl = (i & 63) * 4;
                f32x4 t0 = *(const f32x4*)(s0 + rl * 256 + cl);
                for (int k = 1; k < nsl; ++k) t0 = t0 + *(const f32x4*)(s0 + (size_t)k * 65536 + rl * 256 + cl);
                *(uint2*)(O + (size_t)(un.pm * 256 + rl) * ldc + pnl * 256 + cl) = make_uint2(cvt_pk_bf16(t0[0], t0[1]), cvt_pk_bf16(t0[2], t0[3])); }
            return;
        }
#pragma unroll
        for (int ai = 0; ai < 2; ++ai)
#pragma unroll
            for (int m = 0; m < 4; ++m) { const int rl = ai * 128 + wr * 64 + m * 16 + fr;
#pragma unroll
                for (int bj = 0; bj < 2; ++bj) { const int cl = bj * 128 + wc * 32 + 8 * fq;
                    f32x4 t0 = *(const f32x4*)(s0 + rl * 256 + cl), t1 = *(const f32x4*)(s0 + rl * 256 + cl + 4);
                    for (int k = 1; k < nsl; ++k) { t0 = t0 + *(const f32x4*)(s0 + (size_t)k * 65536 + rl * 256 + cl); t1 = t1 + *(const f32x4*)(s0 + (size_t)k * 65536 + rl * 256 + cl + 4); }
                    *(u32x4*)(O + (size_t)(un.pm * 256 + rl) * ldc + pnl * 256 + cl) = pack8(t0, t1); } }
    }
};
typedef EpiSplitKT<false> EpiSplitK;
typedef EpiSplitKT<true> EpiSplitKAll;
namespace pg8 {
template <class Epi, class Sched, bool F8 = false>
__device__ __forceinline__ void gemm_phase_gather(PG8_LAS unsigned char* lds, const Gemm g, const int* __restrict__ rowtok, const Sched& S, const Epi& E, const int tid) {
    const int wid = __builtin_amdgcn_readfirstlane(tid >> 6), lane = tid & 63, wr = wid >> 2, wc = wid & 3, fr = lane & 15, fq = lane >> 4;
    const int K = g.Kp; int nt = g.K / BK; int ktm_ = ~0; if (PROBE_K2) { ktm_ = nt - 1; nt *= 2; } if constexpr (F8) asm volatile("" : "+s"(nt));
    unsigned voffB[2];
#pragma unroll
    for (int i = 0; i < 2; ++i) { int R, C; stage_rc(tid * 16 + i * 8192, R, C); voffB[i] = (unsigned)(R * K + C) * 2u; }
    const size_t kstep = (size_t)(BK * 2);
    const size_t hstep = (size_t)HALF * K * 2;
    const size_t tstep = 2 * hstep;
    const unsigned ldsw = (unsigned)wid * 1024u;
    const unsigned ldsb = (unsigned)(size_t)lds + ldsw;
    const int aoff = lds_byte(wr * 64 + fr, fq * 8), boff = lds_byte(wc * 32 + fr, fq * 8);
#define PG8_SA(b, h) (((b) * 2 + (h)) * HTB)
#define PG8_SB(b, h) ((4 + (b) * 2 + (h)) * HTB)
#define PG8_STAGE(bufoff, gbase, voff) do { _Pragma("unroll") for (int _i = 0; _i < 2; ++_i) glds16((gbase), (voff)[_i], ldsb + (unsigned)((bufoff) + _i * 8192)); } while (0)
#define PG8_LDA(dst, b, h) do { _Pragma("unroll") for (int m = 0; m < 4; ++m) _Pragma("unroll") for (int k = 0; k < 2; ++k) dst[m][k] = *(const PG8_LAS bf16x8*)(lds + PG8_SA(b, h) + aoff + m * 2048 + k * 1024); } while (0)
#define PG8_LDB(dst, b, h) do { _Pragma("unroll") for (int n = 0; n < 2; ++n) _Pragma("unroll") for (int k = 0; k < 2; ++k) dst[n][k] = *(const PG8_LAS bf16x8*)(lds + PG8_SB(b, h) + boff + n * 2048 + k * 1024); } while (0)
#define PG8_MMA(ai, bj, At, Bt) do { __builtin_amdgcn_s_setprio(1); _Pragma("unroll") for (int m = 0; m < 4; ++m) _Pragma("unroll") for (int n = 0; n < 2; ++n) { \
        if constexpr (F8) acc[ai][bj][m][n] = __builtin_amdgcn_mfma_scale_f32_16x16x128_f8f6f4(cat8(Bt[n][0], Bt[n][1]), cat8(At[m][0], At[m][1]), acc[ai][bj][m][n], 0, 0, 0, 0, 0, 0); \
        else { _Pragma("unroll") for (int k = 0; k < 2; ++k) acc[ai][bj][m][n] = __builtin_amdgcn_mfma_f32_16x16x32_bf16(Bt[n][k], At[m][k], acc[ai][bj][m][n], 0, 0, 0); } } __builtin_amdgcn_s_setprio(0); } while (0)
#define PG8_WAIT_V(n) asm volatile("s_waitcnt vmcnt(" #n ")" ::: "memory")
#define PG8_WAIT_L(n) asm volatile("s_waitcnt lgkmcnt(" #n ")" ::: "memory")
#define PG8_BAR __builtin_amdgcn_s_barrier()
#define PG8_SCHED __builtin_amdgcn_sched_barrier(0)
#define PG8_TLOAD(u, t0, t1) do { const int tl_ = wid * 64 + hw_lane(); _Pragma("unroll") for (int _i = 0; _i < 2; ++_i) { int R_, C_; stage_rc(tl_ * 16 + _i * 8192, R_, C_); \
        const int* p0_ = rowtok + (u).pm * BM + R_; const int* p1_ = p0_ + HALF; asm volatile("global_load_dword %0, %1, off" : "=v"(t0[_i]) : "v"(p0_) : "memory"); asm volatile("global_load_dword %0, %1, off" : "=v"(t1[_i]) : "v"(p1_) : "memory"); } } while (0)
#define PG8_TFIN(t0, t1) do { const int tl_ = wid * 64 + hw_lane(); _Pragma("unroll") for (int _i = 0; _i < 2; ++_i) { int R_, C_; stage_rc(tl_ * 16 + _i * 8192, R_, C_); asm volatile("" : "+v"(t0[_i]), "+v"(t1[_i])); \
        int a_ = (int)t0[_i], b_ = (int)t1[_i]; a_ = a_ < 0 ? 0 : a_; b_ = b_ < 0 ? 0 : b_; t0[_i] = (unsigned)a_ * (unsigned)(K * 2) + (unsigned)C_ * 2u; t1[_i] = (unsigned)b_ * (unsigned)(K * 2) + (unsigned)C_ * 2u; } } while (0)
#define PG8_GVOFF(u, v0, v1) do { const int tl_ = wid * 64 + hw_lane();   _Pragma("unroll") for (int _i = 0; _i < 2; ++_i) { int R_, C_; stage_rc(tl_ * 16 + _i * 8192, R_, C_); \
        int t0_ = rowtok[(u).pm * BM + R_], t1_ = rowtok[(u).pm * BM + HALF + R_]; t0_ = t0_ < 0 ? 0 : t0_; t1_ = t1_ < 0 ? 0 : t1_; \
        v0[_i] = (unsigned)t0_ * (unsigned)(K * 2) + (unsigned)C_ * 2u; v1[_i] = (unsigned)t1_ * (unsigned)(K * 2) + (unsigned)C_ * 2u; } } while (0)
    Unit cur, nxt; int ui = 0;
    if (!S.next(0, cur)) return;
    f32x4 acc[2][2][4][2];
#pragma unroll
    for (int a = 0; a < 2; ++a)
#pragma unroll
        for (int b = 0; b < 2; ++b)
#pragma unroll
            for (int m = 0; m < 4; ++m)
#pragma unroll
                for (int n = 0; n < 2; ++n) acc[a][b][m][n] = (f32x4){0.f, 0.f, 0.f, 0.f};
    bf16x8 At[4][2], B0[2][2], B1[2][2];
    const char* gA = (const char*)g.A; const char* cB = (const char*)g.Bt + (size_t)cur.pn * tstep;
    unsigned cv0[2], cv1[2], nv0[2], nv1[2];
    PG8_GVOFF(cur, cv0, cv1);
    if constexpr (EpiSide<Epi>::v) { cur.side = (unsigned)(size_t)lds + SIDE_OFF; E.side_issue(cur, wid); }
    S.a_ready(cur);
    PG8_STAGE(PG8_SB(0, 0), cB, voffB); PG8_STAGE(PG8_SB(0, 1), cB + hstep, voffB); PG8_STAGE(PG8_SA(0, 0), gA, cv0); PG8_STAGE(PG8_SA(0, 1), gA, cv1);
    if (wr == 1) PG8_BAR;
    PG8_WAIT_V(2); PG8_BAR;
    PG8_STAGE(PG8_SB(1, 0), cB + kstep, voffB); PG8_STAGE(PG8_SA(1, 0), gA + kstep, cv0); PG8_STAGE(PG8_SB(1, 1), cB + hstep + kstep, voffB);
    PG8_WAIT_V(6); PG8_BAR;
    for (;;) {
        const bool has_next = S.next(ui + 1, nxt);
        const char* nB = has_next ? (const char*)g.Bt + (size_t)nxt.pn * tstep : cB;
        if (has_next) { PG8_TLOAD(nxt, nv0, nv1); } else {
#pragma unroll
            for (int i = 0; i < 2; ++i) { nv0[i] = cv0[i]; nv1[i] = cv1[i]; } }
        for (int t = 0; t < nt; t += 2) {
            const bool last = (t == nt - 2);
            const char* a1 = gA + (size_t)((t + 1) & ktm_) * kstep;
            const char* a2 = last ? gA : gA + (size_t)((t + 2) & ktm_) * kstep; const char* b2 = last ? nB : cB + (size_t)((t + 2) & ktm_) * kstep;
            const char* a3 = a2 + kstep; const char* b3 = b2 + kstep;
            if (last && has_next) { S.a_ready(nxt); PG8_TFIN(nv0, nv1); }
            PG8_LDB(B0, 0, 0); PG8_LDB(B1, 0, 1); PG8_SCHED; PG8_LDA(At, 0, 0); PG8_STAGE(PG8_SA(1, 1), a1, cv1);
            PG8_WAIT_V(8); PG8_WAIT_L(0); PG8_BAR; PG8_MMA(0, 0, At, B0); PG8_MMA(0, 1, At, B1); PG8_BAR; PG8_SCHED;
            PG8_LDA(At, 0, 1); PG8_STAGE(PG8_SB(0, 0), b2, voffB); PG8_STAGE(PG8_SB(0, 1), b2 + hstep, voffB); if (last) { PG8_STAGE(PG8_SA(0, 0), a2, nv0); } else { PG8_STAGE(PG8_SA(0, 0), a2, cv0); }
            PG8_WAIT_V(8); PG8_WAIT_L(0); PG8_BAR; PG8_MMA(1, 0, At, B0); PG8_MMA(1, 1, At, B1); PG8_BAR; PG8_SCHED;
            PG8_LDB(B0, 1, 0); PG8_LDB(B1, 1, 1); PG8_SCHED; PG8_LDA(At, 1, 0); if (last) { PG8_STAGE(PG8_SA(0, 1), a2, nv1); } else { PG8_STAGE(PG8_SA(0, 1), a2, cv1); }
            PG8_WAIT_V(8); PG8_WAIT_L(0); PG8_BAR; PG8_MMA(0, 0, At, B0); PG8_MMA(0, 1, At, B1); PG8_BAR; PG8_SCHED;
            PG8_LDA(At, 1, 1); PG8_STAGE(PG8_SB(1, 0), b3, voffB); PG8_STAGE(PG8_SB(1, 1), b3 + hstep, voffB); if (last) { PG8_STAGE(PG8_SA(1, 0), a3, nv0); } else { PG8_STAGE(PG8_SA(1, 0), a3, cv0); }
            PG8_WAIT_V(8); PG8_WAIT_L(0); PG8_BAR; PG8_MMA(1, 0, At, B0); PG8_MMA(1, 1, At, B1); PG8_BAR; PG8_SCHED;
        }
        if (wr == 0) PG8_BAR;
        { const int l2 = hw_lane(); E(acc, cur, wr, wc, l2 & 15, l2 >> 4); } S.done(cur);
        if (!has_next) break;
#pragma unroll
        for (int a = 0; a < 2; ++a)
#pragma unroll
            for (int b = 0; b < 2; ++b)
#pragma unroll
                for (int m = 0; m < 4; ++m)
#pragma unroll
                    for (int n = 0; n < 2; ++n) acc[a][b][m][n] = (f32x4){0.f, 0.f, 0.f, 0.f};
        cur = nxt; cB = nB; ++ui;
        if constexpr (EpiSide<Epi>::v) { cur.side = (unsigned)(size_t)lds + SIDE_OFF + (ui & 1) * SIDE_BYTES; E.side_issue(cur, wid); }
#pragma unroll
        for (int i = 0; i < 2; ++i) { cv0[i] = nv0[i]; cv1[i] = nv1[i]; }
        if (wr == 1) PG8_BAR;
    }
    PG8_WAIT_V(0);
    PG8_BAR;
#undef PG8_SA
#undef PG8_SB
#undef PG8_STAGE
#undef PG8_LDA
#undef PG8_LDB
#undef PG8_MMA
#undef PG8_WAIT_V
#undef PG8_WAIT_L
#undef PG8_BAR
#undef PG8_SCHED
#undef PG8_GVOFF
#undef PG8_TLOAD
#undef PG8_TFIN
}
struct MoeOrder : StaticOrder {
    const PG8_LAS int* tile_e; int per_e;
    __device__ __forceinline__ bool next(int i, Unit& u) const { if (!StaticOrder::next(i, u)) return false; u.pn += __builtin_amdgcn_readfirstlane(tile_e[u.pm]) * per_e; return true; }
};
struct TailOrder {
    const int* tile_e; int rt0, ntail, per_e, nsl, kslice_bytes, c;
    __device__ __forceinline__ bool next(int i, Unit& u) const { if (i > 0 || c >= ntail * per_e * nsl) return false; const int sl = c % nsl, t = c / nsl, pnl = t % per_e, rt = rt0 + t / per_e;
        u.pm = rt; u.pn = __builtin_amdgcn_readfirstlane(tile_e[rt]) * per_e + pnl; u.koff = sl * kslice_bytes; return true; }
    __device__ __forceinline__ void a_ready(const Unit&) const {}
    __device__ __forceinline__ void done(const Unit&) const {}
};
}

__device__ __forceinline__ void f_route1(const Ctx& c, const float* __restrict__ x, const float* __restrict__ g, const float* __restrict__ rw, const float* __restrict__ rb,
                                         int* __restrict__ tope, float* __restrict__ topw, int* __restrict__ rank, int* __restrict__ cnt, int* __restrict__ rowtok, float* __restrict__ rrow) {
    for (int r = blockIdx.x * NTHREADS + c.tid; r < RCAP; r += c.G * NTHREADS) { rowtok[r] = -1; rrow[r] = 0.f; }
    LAS int* le = (LAS int*)c.lds;
    for (int ck = blockIdx.x; ck < T / 64; ck += c.G) {
        float gg[16];
#pragma unroll
        for (int q = 0; q < 16; ++q) gg[q] = g[c.lane + 64 * q];
        for (int j0 = 0; j0 < 8; j0 += 4) {
        float hh[4][16];
#pragma unroll
        for (int j = 0; j < 4; ++j) { const float* xr = x + (size_t)(ck * 64 + c.wave * 8 + j0 + j) * D;
#pragma unroll
            for (int q = 0; q < 16; ++q) hh[j][q] = xr[c.lane + 64 * q]; }
#pragma unroll
        for (int j = 0; j < 4; ++j) {
            const int tl = c.wave * 8 + j0 + j, t = ck * 64 + tl;
            float s = 0.f;
#pragma unroll
            for (int q = 0; q < 16; ++q) s += hh[j][q] * hh[j][q];
            const float r = rsqrtf(wave_sum(s, c.lane) * (1.f / D) + EPS);
            float lg[8];
#pragma unroll
            for (int e = 0; e < 8; ++e) lg[e] = 0.f;
#pragma unroll
            for (int q = 0; q < 16; ++q) { const int k = c.lane + 64 * q; const float hv = hh[j][q] * gg[q]; const f32x4 w0 = *(const f32x4*)(rw + k * 8), w1 = *(const f32x4*)(rw + k * 8 + 4);
                lg[0] += hv * w0[0]; lg[1] += hv * w0[1]; lg[2] += hv * w0[2]; lg[3] += hv * w0[3]; lg[4] += hv * w1[0]; lg[5] += hv * w1[1]; lg[6] += hv * w1[2]; lg[7] += hv * w1[3]; }
            {
                const bool h5 = (c.lane >> 5) & 1, h4 = (c.lane >> 4) & 1, h3 = (c.lane >> 3) & 1;
                float a4[4];
#pragma unroll
                for (int e = 0; e < 4; ++e) { const float keep = h5 ? lg[4 + e] : lg[e], send = h5 ? lg[e] : lg[4 + e]; a4[e] = keep + bperm(send, c.lane ^ 32); }
                float a2[2];
#pragma unroll
                for (int e = 0; e < 2; ++e) { const float keep = h4 ? a4[2 + e] : a4[e], send = h4 ? a4[e] : a4[2 + e]; a2[e] = keep + bperm(send, c.lane ^ 16); }
                float a1 = (h3 ? a2[1] : a2[0]) + bperm(h3 ? a2[0] : a2[1], c.lane ^ 8);
                a1 = xadd<4>(a1, c.lane); a1 = xadd<2>(a1, c.lane); a1 = xadd<1>(a1, c.lane);
#pragma unroll
                for (int e = 0; e < 8; ++e) lg[e] = __builtin_bit_cast(float, __builtin_amdgcn_readlane(__builtin_bit_cast(int, a1), 32 * (e >> 2) + 16 * ((e >> 1) & 1) + 8 * (e & 1))) * r + rb[e];
            }
            int e0 = 0; float v0 = lg[0];
#pragma unroll
            for (int e = 1; e < 8; ++e) if (lg[e] > v0) { v0 = lg[e]; e0 = e; }
            int e1 = -1; float v1 = -3.0e38f;
#pragma unroll
            for (int e = 0; e < 8; ++e) if (e != e0 && lg[e] > v1) { v1 = lg[e]; e1 = e; }
            if (c.lane == 0) { const float w1 = 1.f / (1.f + __expf(v0 - v1)); le[tl * 2] = e0; le[tl * 2 + 1] = e1; tope[t * 2] = e0; tope[t * 2 + 1] = e1; topw[t * 2] = (1.f - w1) * (1.f / MOE_WD_SCALE); topw[t * 2 + 1] = w1 * (1.f / MOE_WD_SCALE); }
        }
        }
        __syncthreads();
        if (c.wave == 0) {
            const int t = ck * 64 + c.lane; const int e0 = le[c.lane * 2], e1 = le[c.lane * 2 + 1];
            int r0 = 0, r1 = 0;
#pragma unroll
            for (int e = 0; e < 8; ++e) { const unsigned long long m = __ballot(e0 == e || e1 == e); const int pre = __popcll(m & ((1ull << c.lane) - 1ull));
                if (e0 == e) r0 = pre; if (e1 == e) r1 = pre; if (c.lane == e) cnt[ck * 8 + e] = __popcll(m); }
            rank[t * 2] = r0; rank[t * 2 + 1] = r1;
        }
        __syncthreads();
    }
}
__device__ __forceinline__ void f_route2(const Ctx& c, const int* __restrict__ tope, const int* __restrict__ rank, const int* __restrict__ cnt, int* __restrict__ pos, int* __restrict__ rowtok, int* __restrict__ tile_e, int* __restrict__ ntiles, const unsigned long long* __restrict__ xss, float* __restrict__ rrow) {
    LAS int* lbase = (LAS int*)c.lds;
    LAS int* ltot = lbase + 2048;
    {
        const int e = c.wave; int v[4]; int s = 0;
#pragma unroll
        for (int j = 0; j < 4; ++j) { v[j] = cnt[(4 * c.lane + j) * 8 + e]; s += v[j]; }
        int inc = s;
#pragma unroll
        for (int o = 1; o < 64; o <<= 1) { const int up = __builtin_amdgcn_ds_bpermute((c.lane - o) << 2, inc); if (c.lane >= o) inc += up; }
        int ex = inc - s;
#pragma unroll
        for (int j = 0; j < 4; ++j) { lbase[(4 * c.lane + j) * 8 + e] = ex; ex += v[j]; }
        if (c.lane == 63) ltot[e] = inc;
    }
    __syncthreads();
    int segoff[9]; segoff[0] = 0;
#pragma unroll
    for (int e = 0; e < 8; ++e) segoff[e + 1] = segoff[e] + ((ltot[e] + 255) & ~255);
    for (int ck = blockIdx.x; ck < T / 64; ck += c.G) {
        if (c.tid < 128) { const int tl = c.tid >> 1, k = c.tid & 1, t = ck * 64 + tl; const int e = tope[t * 2 + k];
            int so = 0;
#pragma unroll
            for (int q = 0; q < 8; ++q) so = (e == q) ? segoff[q] : so;
            const int p = so + lbase[ck * 8 + e] + rank[t * 2 + k]; pos[t * 2 + k] = p; rowtok[p] = t; rrow[p] = rsqrtf((float)xss[t] * (1.f / 65536.f) * (1.f / D) + EPS) * (1.f / MOE_WGU_SCALE) * (PROBE_K2 ? 0.5f : 1.f); }
    }
    if (blockIdx.x == 0) {
        for (int rt = c.tid; rt < RCAP / 256; rt += NTHREADS) { int e = -1;
#pragma unroll
            for (int q = 0; q < 8; ++q) if (rt * 256 >= segoff[q] && rt * 256 < segoff[q + 1]) e = q;
            tile_e[rt] = e; }
        if (c.tid == 0) ntiles[0] = segoff[8] / 256;
    }
}
__device__ __forceinline__ void f_combine(const Ctx& c, float* __restrict__ x, const bf16_t* __restrict__ Y, const int* __restrict__ pos, const float* __restrict__ topw) {
    const int stride = c.G * NTHREADS;
    for (int i0 = blockIdx.x * NTHREADS + c.tid; i0 < T * 128; i0 += 4 * stride) {
        int p0[4], p1[4]; float w0[4], w1[4]; bool ok[4];
#pragma unroll
        for (int k = 0; k < 4; ++k) { const int i = i0 + k * stride; ok[k] = i < T * 128; const int t = ok[k] ? (i >> 7) : 0; const int2 pp = *(const int2*)(pos + t * 2); const float2 ww = *(const float2*)(topw + t * 2); p0[k] = pp.x; p1[k] = pp.y; w0[k] = ww.x; w1[k] = ww.y; }
        u32x4 ya[4], yb[4]; f32x4 xa[4], xb[4];
#pragma unroll
        for (int k = 0; k < 4; ++k) { const int i = ok[k] ? i0 + k * stride : 0; const int t = i >> 7, cc = (i & 127) * 8;
            ya[k] = *(const u32x4*)(Y + (size_t)p0[k] * D + cc); yb[k] = *(const u32x4*)(Y + (size_t)p1[k] * D + cc);
            const f32x4* xp = (const f32x4*)(x + (size_t)t * D + cc); xa[k] = xp[0]; xb[k] = xp[1]; }
#pragma unroll
        for (int k = 0; k < 4; ++k) { if (!ok[k]) continue; const int i = i0 + k * stride; const int t = i >> 7, cc = (i & 127) * 8;
            f32x4 a0, a1, b0, b1; unpack8(ya[k], a0, a1); unpack8(yb[k], b0, b1);
            f32x4* xp = (f32x4*)(x + (size_t)t * D + cc);
            xp[0] = xa[k] + a0 * w0[k] + b0 * w1[k]; xp[1] = xb[k] + a1 * w0[k] + b1 * w1[k]; }
    }
}
namespace att {
using s16x4 = __attribute__((ext_vector_type(4))) short;
using f32x16 = __attribute__((ext_vector_type(16))) float;
constexpr int QBLK = 32, KVBLK = 64, SHM_K = 64 * 128  , SHM_V = 64 * 64  , OPITCH = 144  , SHM_ATTN = 8 * 32 * OPITCH;
constexpr float THR = 8.f;
constexpr int ATT_PITCH = 1024;
#define KSWZ(row, colB) ((row) * 256 + ((colB) ^ (((row) & 15) << 4)))
#define SBAR() __builtin_amdgcn_sched_barrier(0)
#define KSWZ8(row, colB) ((row) * 128 + ((colB) ^ ((((row) >> 1) & 7) << 4)))
__device__ __forceinline__ int crow(int r, int hi) { return (r & 3) + 8 * (r >> 2) + 4 * hi; }
__device__ __forceinline__ void cmask(f32x16& p0, f32x16& p1, int jb, int qrel, int hi) {
    const int kb = 64 * jb + 4 * hi;
#pragma unroll
    for (int r = 0; r < 16; ++r) { const int kv = kb + (r & 3) + 8 * (r >> 2); if (kv > qrel) p0[r] = -INFINITY; if (kv + 32 > qrel) p1[r] = -INFINITY; }
}
template <bool FAST>
__device__ __forceinline__ void partialSM(f32x16& p0, f32x16& p1, float& m_reg, float& alpha) {
    if (FAST) {
        alpha = 1.f;
#pragma unroll
        for (int r = 0; r < 16; ++r) p0[r] = __builtin_amdgcn_exp2f(p0[r]);
        return;
    }
    float pmax = p0[0];
#pragma unroll
    for (int r = 1; r < 16; ++r) pmax = fmaxf(pmax, p0[r]);
#pragma unroll
    for (int r = 0; r < 16; ++r) pmax = fmaxf(pmax, p1[r]);
    { auto rr = __builtin_amdgcn_permlane32_swap(__float_as_uint(pmax), __float_as_uint(pmax), false, false); pmax = fmaxf(__uint_as_float(rr[0]), __uint_as_float(rr[1])); }
    float mn;
    if (__builtin_expect(__all(pmax - m_reg <= THR), 1)) { mn = m_reg; alpha = 1.f; }
    else { mn = fmaxf(m_reg, pmax); alpha = __builtin_amdgcn_exp2f(m_reg - mn); m_reg = mn; }
#pragma unroll
    for (int r = 0; r < 16; ++r) { p0[r] = p0[r] - mn; p1[r] = p1[r] - mn; }
#pragma unroll
    for (int r = 0; r < 16; ++r) p0[r] = __builtin_amdgcn_exp2f(p0[r]);
}
__device__ __forceinline__ void partialSM_rel(f32x16& p0, f32x16& p1, float& m_reg, float& alpha) {
    float pmax = p0[0];
#pragma unroll
    for (int r = 1; r < 16; ++r) pmax = fmaxf(pmax, p0[r]);
#pragma unroll
    for (int r = 0; r < 16; ++r) pmax = fmaxf(pmax, p1[r]);
    { auto rr = __builtin_amdgcn_permlane32_swap(__float_as_uint(pmax), __float_as_uint(pmax), false, false); pmax = fmaxf(__uint_as_float(rr[0]), __uint_as_float(rr[1])); }
    if (__builtin_expect(__all(pmax <= THR), 1)) alpha = 1.f;
    else { const float dl = fmaxf(pmax, 0.f); m_reg += dl; alpha = __builtin_amdgcn_exp2f(-dl);
#pragma unroll
        for (int r = 0; r < 16; ++r) { p0[r] -= dl; p1[r] -= dl; } }
#pragma unroll
    for (int r = 0; r < 16; ++r) p0[r] = __builtin_amdgcn_exp2f(p0[r]);
}
__device__ __forceinline__ void finishSM(f32x16& p0, f32x16& p1, float alpha, float& l_reg, bf16x8& pa0, bf16x8& pa1, bf16x8& pa2, bf16x8& pa3) {
#pragma unroll
    for (int r = 0; r < 16; ++r) p1[r] = __builtin_amdgcn_exp2f(p1[r]);
    float ps = 0;
#pragma unroll
    for (int r = 0; r < 16; ++r) ps += p0[r];
#pragma unroll
    for (int r = 0; r < 16; ++r) ps += p1[r];
    { auto rr = __builtin_amdgcn_permlane32_swap(__float_as_uint(ps), __float_as_uint(ps), false, false); ps = __uint_as_float(rr[0]) + __uint_as_float(rr[1]); }
    l_reg = l_reg * alpha + ps;
#define PK4(P, BASE, OUT) do { unsigned a0 = cvt_pk_bf16(P[BASE + 0], P[BASE + 1]), a1 = cvt_pk_bf16(P[BASE + 2], P[BASE + 3]);   \
    unsigned b0 = cvt_pk_bf16(P[BASE + 4], P[BASE + 5]), b1 = cvt_pk_bf16(P[BASE + 6], P[BASE + 7]);                              \
    auto r0 = __builtin_amdgcn_permlane32_swap(a0, b0, false, false); auto r1 = __builtin_amdgcn_permlane32_swap(a1, b1, false, false); \
    u32x4 w = {r0[0], r1[0], r0[1], r1[1]}; OUT = *reinterpret_cast<bf16x8*>(&w); } while (0)
    PK4(p0, 0, pa0); PK4(p0, 8, pa1); PK4(p1, 0, pa2); PK4(p1, 8, pa3);
#undef PK4
}
__device__ __forceinline__ void qkt(f32x16& p0, f32x16& p1, const char* Ks, const bf16x8* qr, int r32, int hi) {
    p0 = f32x16{}; p1 = f32x16{};
#pragma unroll
    for (int d0 = 0; d0 < 6; ++d0) { const int cb = (d0 * 16 + hi * 8) * 2;
        const bf16x8 b0 = *reinterpret_cast<const bf16x8*>(Ks + KSWZ(r32, cb));
        const bf16x8 b1 = *reinterpret_cast<const bf16x8*>(Ks + KSWZ(32 + r32, cb));
        p0 = __builtin_amdgcn_mfma_f32_32x32x16_bf16(b0, qr[d0], p0, 0, 0, 0);
        p1 = __builtin_amdgcn_mfma_f32_32x32x16_bf16(b1, qr[d0], p1, 0, 0, 0); }
}
template <bool ZERO> __device__ __forceinline__ void qkt8(f32x16& p0, f32x16& p1, const char* Ks, const pg8::i32x8v* qf, int r32, int hi, float cinit = 0.f) {
    if constexpr (ZERO) { p0 = f32x16{}; p1 = f32x16{}; } else {
#pragma unroll
    for (int r = 0; r < 16; ++r) { p0[r] = cinit; p1[r] = cinit; } }
#pragma unroll
    for (int sx = 0; sx < 2; ++sx) { const int cb = (2 * sx + hi) * 32;
        const bf16x8 a0 = *reinterpret_cast<const bf16x8*>(Ks + KSWZ8(r32, cb)), a1 = *reinterpret_cast<const bf16x8*>(Ks + KSWZ8(r32, cb + 16));
        const bf16x8 b0 = *reinterpret_cast<const bf16x8*>(Ks + KSWZ8(32 + r32, cb)), b1 = *reinterpret_cast<const bf16x8*>(Ks + KSWZ8(32 + r32, cb + 16));
        p0 = __builtin_amdgcn_mfma_scale_f32_32x32x64_f8f6f4(pg8::cat8(a0, a1), qf[sx], p0, 0, 0, 0, 0, 0, 0);
        p1 = __builtin_amdgcn_mfma_scale_f32_32x32x64_f8f6f4(pg8::cat8(b0, b1), qf[sx], p1, 0, 0, 0, 0, 0, 0); }
}
__device__ __forceinline__ int v_st(int k, int c) { const int kk = (k & ~0xC) | ((k & 4) << 1) | ((k & 8) >> 1); return ((kk >> 3) * 2 + (c >> 5)) * 512 + ((kk & 7) * 32 + (c & 31)) * 2; }
__device__ __forceinline__ int v_rd_base(int lane) { return ((lane & 3) << 3) | (((lane >> 2) & 3) << 6) | (((lane >> 4) & 1) << 5) | (((lane >> 5) & 1) << 8); }
constexpr int v_rd_off(int d0, int ks, int half) { return d0 * 512 + ks * 2048 + half * 1024; }
template <int OFF> __device__ __forceinline__ s16x4 tr_read(int vb) { s16x4 r; asm volatile("ds_read_b64_tr_b16 %0, %1 offset:%2" : "=&v"(r) : "v"(vb), "i"(OFF) : "memory"); return r; }
template <int D0> __device__ __forceinline__ void pv_one(f32x16& od, int vb, bf16x8 pa0, bf16x8 pa1, bf16x8 pa2, bf16x8 pa3) {
    const s16x4 l0 = tr_read<v_rd_off(D0, 0, 0)>(vb), h0 = tr_read<v_rd_off(D0, 0, 1)>(vb), l1 = tr_read<v_rd_off(D0, 1, 0)>(vb), h1 = tr_read<v_rd_off(D0, 1, 1)>(vb);
    const s16x4 l2 = tr_read<v_rd_off(D0, 2, 0)>(vb), h2 = tr_read<v_rd_off(D0, 2, 1)>(vb), l3 = tr_read<v_rd_off(D0, 3, 0)>(vb), h3 = tr_read<v_rd_off(D0, 3, 1)>(vb);
    asm volatile("s_waitcnt lgkmcnt(0)" ::: "memory"); SBAR();
#define PK(L, H) (bf16x8){L[0], L[1], L[2], L[3], H[0], H[1], H[2], H[3]}
    od = __builtin_amdgcn_mfma_f32_32x32x16_bf16(pa0, PK(l0, h0), od, 0, 0, 0);
    od = __builtin_amdgcn_mfma_f32_32x32x16_bf16(pa1, PK(l1, h1), od, 0, 0, 0);
    od = __builtin_amdgcn_mfma_f32_32x32x16_bf16(pa2, PK(l2, h2), od, 0, 0, 0);
    od = __builtin_amdgcn_mfma_f32_32x32x16_bf16(pa3, PK(l3, h3), od, 0, 0, 0);
#undef PK
}
#define VSWZ(d, cB) ((d) * 64 + ((cB) ^ ((((d) >> 2) & 3) << 4)))
__device__ __forceinline__ unsigned pk4_bf8(float a, float b, float c, float d, int old) { const int w = __builtin_amdgcn_cvt_pk_bf8_f32(a, b, old, false); return (unsigned)__builtin_amdgcn_cvt_pk_bf8_f32(c, d, w, true); }
__device__ __forceinline__ void finishSM8(f32x16& p0, f32x16& p1, float alpha, float& l_reg, pg8::i32x8v& pb) {
#pragma unroll
    for (int r = 0; r < 16; ++r) p1[r] = __builtin_amdgcn_exp2f(p1[r]);
    (void)alpha; (void)l_reg;
#pragma unroll
    for (int g = 0; g < 4; ++g) { pb[g] = (int)pk4_bf8(p0[4 * g], p0[4 * g + 1], p0[4 * g + 2], p0[4 * g + 3], pb[g]); pb[4 + g] = (int)pk4_bf8(p1[4 * g], p1[4 * g + 1], p1[4 * g + 2], p1[4 * g + 3], pb[4 + g]); }
}
__device__ __forceinline__ void pv8(f32x16 (&o)[2], f32x16& ol, const char* Vs, const pg8::i32x8v pb, int r32, int hi, const pg8::i32x8v ones) {
    ol = __builtin_amdgcn_mfma_scale_f32_32x32x64_f8f6f4(ones, pb, ol, 0, 1, 0, 0, 0, 0);
#pragma unroll
    for (int dh = 0; dh < 2; ++dh) { const int d = 32 * dh + r32;
        const bf16x8 a0 = *reinterpret_cast<const bf16x8*>(Vs + VSWZ(d, 32 * hi)), a1 = *reinterpret_cast<const bf16x8*>(Vs + VSWZ(d, 32 * hi + 16));
        o[dh] = __builtin_amdgcn_mfma_scale_f32_32x32x64_f8f6f4(pg8::cat8(a0, a1), pb, o[dh], 0  , 1  , 0, 0, 0, 0); }
}
template <bool FAST>
__device__ __forceinline__ void attn_unit(const bf16_t* __restrict__ Qn, const bf16_t* __restrict__ Kn, const bf16_t* __restrict__ Vn, bf16_t* __restrict__ att, const float* __restrict__ gq, const float* __restrict__ rope, int bh, int qb, char* lds, int tid, float cshift) {
    const int wid = __builtin_amdgcn_readfirstlane(tid >> 6), lane = tid & 63, r32 = lane & 31, hi = lane >> 5;
    char* V_lds = lds; char* K_lds = lds + 6 * SHM_V;
    float m_reg = -1e30f, l_reg = 0; f32x16 o[2] = {}, ol = {}; pg8::i32x8v qf[2];
    const int q0 = qb * 256;
    {
        const int bq = bh >> 3, hq = bh & 7, sq = q0 + wid * QBLK + r32;
        const bf16_t* Qw = Qn + ((size_t)bq * SEQ + sq) * 768 + hq * 96 + hi * 8;
        float v[6][8]; float ss = 0.f;
#pragma unroll
        for (int d0 = 0; d0 < 6; ++d0) { f32x4 x0, x1; unpack8(*reinterpret_cast<const u32x4*>(Qw + d0 * 16), x0, x1);
#pragma unroll
            for (int j = 0; j < 4; ++j) { v[d0][j] = x0[j]; v[d0][4 + j] = x1[j]; ss += x0[j] * x0[j] + x1[j] * x1[j]; } }
        { auto rr = __builtin_amdgcn_permlane32_swap(__float_as_uint(ss), __float_as_uint(ss), false, false); ss = __uint_as_float(rr[0]) + __uint_as_float(rr[1]); }
        const float rq = rsqrtf(ss * (1.f / 96.f) + EPS) * ATT_KSC;
#pragma unroll
        for (int d0 = 0; d0 < 6; ++d0) { const f32x4 g0 = *(const f32x4*)(gq + d0 * 16 + hi * 8), g1 = *(const f32x4*)(gq + d0 * 16 + hi * 8 + 4);
#pragma unroll
            for (int j = 0; j < 4; ++j) { v[d0][j] *= rq * g0[j]; v[d0][4 + j] *= rq * g1[j]; } }
        const f32x4* rp = (const f32x4*)(rope + ((size_t)sq * 16 + 8 * hi) * 2);
#pragma unroll
        for (int jj = 0; jj < 4; ++jj) { const f32x4 cs = rp[jj];
#pragma unroll
            for (int k = 0; k < 2; ++k) { const int j = 2 * jj + k; const float c_ = cs[2 * k], s_ = cs[2 * k + 1], x1 = v[4][j], x2 = v[5][j]; v[4][j] = x1 * c_ - x2 * s_; v[5][j] = x2 * c_ + x1 * s_; } }
#pragma unroll
        for (int d0 = 0; d0 < 6; ++d0) { qf[d0 >> 2][2 * (d0 & 3)] = (int)pk4_f8(v[d0][0], v[d0][1], v[d0][2], v[d0][3]); qf[d0 >> 2][2 * (d0 & 3) + 1] = (int)pk4_f8(v[d0][4], v[d0][5], v[d0][6], v[d0][7]); }
        qf[1][4] = (FAST && hi == 0) ? (int)(pk4_f8(-cshift, 0.f, 0.f, 0.f) & 0xffu) : 0; qf[1][5] = 0; qf[1][6] = 0; qf[1][7] = 0;
    }
    const char* Kh = (const char*)Kn + (size_t)bh * SEQ * 128; const char* Vh = (const char*)Vn + (size_t)bh * SEQ * 64;
    const int kst0 = KSWZ8(tid >> 3, (tid & 7) * 16);
    const int vst0 = VSWZ(tid >> 3, (8 * (tid & 7)) & 48) + ((8 * (tid & 7)) & 15);
    struct { uint2 v; bf16x8 k0; } sr_[2];
#define SLOAD(i, t) do { sr_[i].v = *reinterpret_cast<const uint2*>(Vh + (size_t)(t) * (KVBLK * 64) + tid * 8); sr_[i].k0 = *reinterpret_cast<const bf16x8*>(Kh + (size_t)(t) * (KVBLK * 128) + tid * 16); } while (0)
#define SWRITE(b, i) do { *(uint2*)(V_lds + (b) * SHM_V + vst0) = sr_[i].v; \
    *(bf16x8*)(K_lds + (b) * SHM_K + kst0) = sr_[i].k0; } while (0)
#define SWAIT() asm volatile("s_waitcnt vmcnt(2)" ::: "memory")
#define RESC(a) do { if (!FAST && __any((a) < 1.f)) { _Pragma("unroll") for (int d = 0; d < 2; ++d) _Pragma("unroll") for (int r = 0; r < 16; ++r) o[d][r] *= (a); ol[0] *= (a); } } while (0)
#define CMASK(P0, P1, t) do { const int jb_ = (t) - (NT - 4); if (jb_ >= 0) cmask(P0, P1, jb_, qrel, hi); } while (0)
    f32x16 pA0, pA1, pB0, pB1; float alA, alB; pg8::i32x8v pb = {};
    pg8::i32x8v ones; { int o4 = 0x38383838; asm volatile("" : "+v"(o4)); ones = (pg8::i32x8v){o4, o4, o4, o4, o4, o4, o4, o4}; asm volatile("" : "+v"(ones)); }
    const int NT = (q0 + 256) / KVBLK; const int qrel = wid * QBLK + r32;
    SLOAD(0, 0); asm volatile("s_waitcnt vmcnt(0)" ::: "memory"); SWRITE(1, 0); __syncthreads();
    qkt8<true>(pA0, pA1, K_lds + SHM_K, qf, r32, hi); CMASK(pA0, pA1, 0); partialSM<FAST>(pA0, pA1, m_reg, alA);
    SLOAD(0, 1); if (2 < NT) SLOAD(1, 2);
    asm volatile("s_waitcnt vmcnt(0)" ::: "memory"); SWRITE(2, 0); SWRITE(3, 1);
    if (3 < NT) SLOAD(0, 3); if (4 < NT) SLOAD(1, 4);
    __syncthreads();
#define ILV4() do { __builtin_amdgcn_sched_group_barrier(0x100, 4, 0); __builtin_amdgcn_sched_group_barrier(0x008, 1, 0); __builtin_amdgcn_sched_group_barrier(0x400, 4, 0); __builtin_amdgcn_sched_group_barrier(0x100, 2, 0); __builtin_amdgcn_sched_group_barrier(0x008, 1, 0); __builtin_amdgcn_sched_group_barrier(0x400, 4, 0); __builtin_amdgcn_sched_group_barrier(0x100, 2, 0); __builtin_amdgcn_sched_group_barrier(0x008, 1, 0); __builtin_amdgcn_sched_group_barrier(0x400, 4, 0); __builtin_amdgcn_sched_group_barrier(0x008, 1, 0); __builtin_amdgcn_sched_group_barrier(0x400, 4, 0); } while (0)
#define ILV3() do { __builtin_amdgcn_sched_group_barrier(0x008, 1, 0); __builtin_amdgcn_sched_group_barrier(0x100, 4, 0); __builtin_amdgcn_sched_group_barrier(0x400, 4, 0); __builtin_amdgcn_sched_group_barrier(0x008, 1, 0); __builtin_amdgcn_sched_group_barrier(0x400, 6, 0); __builtin_amdgcn_sched_group_barrier(0x008, 1, 0); __builtin_amdgcn_sched_group_barrier(0x400, 6, 0); } while (0)
    int z0 = 0, z1 = 1, z2 = 2;
    for (int j = 1; j + 1 < NT; j += 2) {
        SBAR(); qkt8<FAST>(pB0, pB1, K_lds + (2 * z1) * SHM_K, qf, r32, hi, -m_reg);
        finishSM8(pA0, pA1, alA, l_reg, pb); ILV4(); SBAR(); CMASK(pB0, pB1, j); SBAR();
        pv8(o, ol, V_lds + (2 * z0 + 1) * SHM_V, pb, r32, hi, ones); if constexpr (FAST) { partialSM<true>(pB0, pB1, m_reg, alB); ILV3(); } else partialSM_rel(pB0, pB1, m_reg, alB);
        RESC(alB);
        asm volatile("s_waitcnt vmcnt(0)" ::: "memory"); SWRITE(2 * z2, 0); SWRITE(2 * z2 + 1, 1);
        if (j + 4 < NT) SLOAD(0, j + 4); if (j + 5 < NT) SLOAD(1, j + 5);
        SBAR(); qkt8<FAST>(pA0, pA1, K_lds + (2 * z1 + 1) * SHM_K, qf, r32, hi, -m_reg);
        finishSM8(pB0, pB1, alB, l_reg, pb); ILV4(); SBAR(); CMASK(pA0, pA1, j + 1); SBAR();
        pv8(o, ol, V_lds + (2 * z1) * SHM_V, pb, r32, hi, ones); if constexpr (FAST) { partialSM<true>(pA0, pA1, m_reg, alA); ILV3(); } else partialSM_rel(pA0, pA1, m_reg, alA);
        RESC(alA); __syncthreads();
        { const int t0_ = z0; z0 = z1; z1 = z2; z2 = t0_; }
    }
    SBAR(); qkt8<FAST>(pB0, pB1, K_lds + (2 * z1) * SHM_K, qf, r32, hi, -m_reg); CMASK(pB0, pB1, NT - 1);
    finishSM8(pA0, pA1, alA, l_reg, pb); SBAR();
    pv8(o, ol, V_lds + (2 * z0 + 1) * SHM_V, pb, r32, hi, ones); if constexpr (FAST) partialSM<true>(pB0, pB1, m_reg, alB); else partialSM_rel(pB0, pB1, m_reg, alB);
    RESC(alB);
    finishSM8(pB0, pB1, alB, l_reg, pb); SBAR();
    pv8(o, ol, V_lds + (2 * z1) * SHM_V, pb, r32, hi, ones);
    __syncthreads();
    { const float rl = __builtin_amdgcn_rcpf(ol[0]); char* img = lds + wid * (32 * OPITCH);
#pragma unroll
      for (int dh = 0; dh < 2; ++dh)
#pragma unroll
        for (int g = 0; g < 4; ++g) *(uint2*)(img + r32 * OPITCH + (32 * dh + 8 * g + 4 * hi) * 2) = make_uint2(cvt_pk_bf16(o[dh][4 * g] * rl, o[dh][4 * g + 1] * rl), cvt_pk_bf16(o[dh][4 * g + 2] * rl, o[dh][4 * g + 3] * rl));
      asm volatile("s_waitcnt lgkmcnt(0)" ::: "memory");
      const int b = bh >> 3, h = bh & 7;
      bf16_t* Ow = att + ((size_t)b * SEQ + q0 + wid * QBLK) * ATT_PITCH + h * 64;
#pragma unroll
      for (int p = 0; p < 4; ++p) { const int qr_ = 8 * p + (lane >> 3), cch = lane & 7; *(u32x4*)(Ow + (size_t)qr_ * ATT_PITCH + 8 * cch) = *(const u32x4*)(img + qr_ * OPITCH + 16 * cch); } }
    __syncthreads();
#undef SLOAD
#undef SWRITE
#undef SWAIT
#undef RESC
#undef CMASK
}
#undef KSWZ
#undef KSWZ8
#undef VSWZ
#undef SBAR
}
__device__ __forceinline__ void f_attn_part(const Ctx& c, const bf16_t* Qn, const bf16_t* Kn, const bf16_t* Vn, bf16_t* att_out, const float* gq, const float* rope, int part, bool fast, float cshift) {
    const int bx = blockIdx.x, G = c.G;
    const int vcu = (G % 8 == 0) ? (bx % 8) * (G / 8) + bx / 8 : bx;
    for (int p = vcu; p < 256; p += G) {
        const int bh = p >> 4, j = p & 15;
        int tid_ = c.tid; asm volatile("" : "+v"(tid_));
        if (fast) att::attn_unit<true>(Qn, Kn, Vn, att_out, gq, rope, bh, part ? j : 31 - j, (char*)c.lds, tid_, cshift);
        else att::attn_unit<false>(Qn, Kn, Vn, att_out, gq, rope, bh, part ? j : 31 - j, (char*)c.lds, tid_, 0.f);
    }
}
__device__ __forceinline__ float attn_score_bound(const Ctx& c, const float* __restrict__ gq, const float* __restrict__ gk) {
    float mq = 0.f, mk = 0.f;
    for (int i = c.lane; i < QKD; i += 64) { mq = fmaxf(mq, fabsf(gq[i])); mk = fmaxf(mk, fabsf(gk[i])); }
#pragma unroll
    for (int o = 1; o < 64; o <<= 1) { mq = fmaxf(mq, bperm(mq, c.lane ^ o)); mk = fmaxf(mk, bperm(mk, c.lane ^ o)); }
    return __builtin_bit_cast(float, __builtin_amdgcn_readfirstlane(__builtin_bit_cast(int, 14.1358f * mq * mk)));
}
typedef float f32x2_ __attribute__((ext_vector_type(2)));
constexpr int S5_MT_ELEMS = 256 * 384, S5_W_ELEMS = 128 * 256, S5_APITCH = 784;
__device__ __forceinline__ void s5_tables(const Ctx& c, int g, const float* __restrict__ lam_re, const float* __restrict__ lam_im, const float* __restrict__ log_step, const float* __restrict__ b_re, const float* __restrict__ b_im,
                                          const float* __restrict__ c_re, const float* __restrict__ c_im, bf16_t* __restrict__ MT, bf16_t* __restrict__ W, float* __restrict__ LB16) {
    LAS f32x2_* pw = (LAS f32x2_*)c.lds;
    LAS f32x2_* Bb = pw + 17 * 64;
    LAS f32x2_* Cm = Bb + 64 * 16;
    LAS float* Kt = (LAS float*)(Cm + 16 * 64);
    const int tid = c.tid;
    if (tid < 64) {
        const int p = tid;
        const float lre = lam_re[g * 64 + p], lim = lam_im[g * 64 + p], st = __expf(log_step[g]);
        const float mag = __expf(lre * st);
        float sn, cs; sincos_rev((double)lim * (double)st * 0.15915494309189535, sn, cs);
        const float lbr = mag * cs, lbi = mag * sn;
        const float nr = lbr - 1.f, ni = lbi, den = 1.f / (lre * lre + lim * lim);
        const float cr = (nr * lre + ni * lim) * den, ci = (ni * lre - nr * lim) * den;
        float pr = 1.f, pi = 0.f;
        for (int tau = 0; tau <= 16; ++tau) { pw[tau * 64 + p] = (f32x2_){pr, pi}; const float nr2 = pr * lbr - pi * lbi, ni2 = pr * lbi + pi * lbr; pr = nr2; pi = ni2; }
        const f32x2_ l16 = pw[16 * 64 + p]; LB16[(g * 64 + p) * 2] = l16.x; LB16[(g * 64 + p) * 2 + 1] = l16.y;
        for (int k = 0; k < 16; ++k) { const float br = b_re[(g * 64 + p) * 16 + k], bi = b_im[(g * 64 + p) * 16 + k]; Bb[p * 16 + k] = (f32x2_){cr * br - ci * bi, cr * bi + ci * br};
            Cm[k * 64 + p] = (f32x2_){c_re[(g * 16 + k) * 64 + p], c_im[(g * 16 + k) * 64 + p]}; }
    }
    __syncthreads();
    {
        const int tau = tid >> 5, cc = (tid >> 1) & 15, hf = tid & 1;
        float s8[8];
#pragma unroll
        for (int j = 0; j < 8; ++j) s8[j] = 0.f;
        for (int p = 0; p < 64; ++p) { const f32x2_ cm = Cm[cc * 64 + p], w = pw[tau * 64 + p]; const float ar = cm.x * w.x - cm.y * w.y, ai = cm.x * w.y + cm.y * w.x;
            const LAS f32x4* bp = (const LAS f32x4*)(Bb + p * 16 + 8 * hf);
#pragma unroll
            for (int j2 = 0; j2 < 4; ++j2) { const f32x4 b = bp[j2]; s8[2 * j2] += ar * b[0] - ai * b[1]; s8[2 * j2 + 1] += ar * b[2] - ai * b[3]; } }
#pragma unroll
        for (int j = 0; j < 8; ++j) Kt[(tau << 8) + (cc << 4) + 8 * hf + j] = s8[j];
    }
    __syncthreads();
    {
        const int lane = c.lane, w8 = c.wave;
        for (int n = w8; n < 256; n += 8) { const int j = n >> 4, cc = n & 15; bf16_t* row = MT + (size_t)n * 384;
#pragma unroll
            for (int q = 0; q < 2; ++q) { const int k = 2 * (lane + 64 * q), sx = k >> 4, c2 = k & 15;
                f32x2_ v = (f32x2_){0.f, 0.f}; if (sx <= j) v = *(const LAS f32x2_*)(Kt + ((j - sx) << 8) + (cc << 4) + c2);
                *(unsigned*)(row + k) = f2bf(v.x) | (f2bf(v.y) << 16); }
            { const int kk = 2 * lane, ri = kk >> 6, p = kk & 63; const LAS f32x4* cp = (const LAS f32x4*)(Cm + cc * 64 + p); const LAS f32x4* wp = (const LAS f32x4*)(pw + (j + 1) * 64 + p); const f32x4 cm = cp[0], w = wp[0];
              const float v0 = ri ? -(cm[0] * w[1] + cm[1] * w[0]) : (cm[0] * w[0] - cm[1] * w[1]), v1 = ri ? -(cm[2] * w[3] + cm[3] * w[2]) : (cm[2] * w[2] - cm[3] * w[3]);
              *(unsigned*)(row + 256 + kk) = f2bf(v0) | (f2bf(v1) << 16); } }
        for (int n = w8; n < 128; n += 8) { const int ri = n >> 6, p = n & 63; bf16_t* row = W + (size_t)n * 256;
#pragma unroll
            for (int q = 0; q < 2; ++q) { const int k = 2 * (lane + 64 * q), sx = k >> 4, c2 = k & 15; const f32x2_ w = pw[(15 - sx) * 64 + p]; const f32x4 b = *(const LAS f32x4*)(Bb + p * 16 + c2);
                const float v0 = ri ? (w.x * b[1] + w.y * b[0]) : (w.x * b[0] - w.y * b[1]), v1 = ri ? (w.x * b[3] + w.y * b[2]) : (w.x * b[2] - w.y * b[3]);
                *(unsigned*)(row + k) = f2bf(v0) | (f2bf(v1) << 16); } }
    }
    __syncthreads();
}
__device__ __forceinline__ void s5_stage(const Ctx& c, const bf16_t* __restrict__ U, const bf16_t* __restrict__ xin, int b, int blk, int g, int loff = 0) {
#pragma unroll
    for (int i = 0; i < 4; ++i) { const int q = c.tid + NTHREADS * i, m = q >> 5, w = q & 31;
        const u32x4 v = *(const u32x4*)(U + ((size_t)b * SEQ + (blk * 64 + m) * 16 + (w >> 1)) * 512 + 16 * g + 8 * (w & 1));
        *(LAS u32x4*)(c.lds + loff + m * S5_APITCH + w * 16) = v; }
    if (xin) {
#pragma unroll
        for (int i = 0; i < 2; ++i) { const int q = c.tid + NTHREADS * i, m = q >> 4, w = q & 15;
            const u32x4 v = *(const u32x4*)(xin + (((size_t)b * 512 + blk * 64 + m) * 32 + g) * 128 + 8 * w);
            *(LAS u32x4*)(c.lds + loff + m * S5_APITCH + 512 + w * 16) = v; }
    }
}
__device__ __forceinline__ void f_s5_e(const Ctx& c, const bf16_t* __restrict__ U, const bf16_t* __restrict__ Wt, float* __restrict__ E) {
    const int lane = c.lane, r16 = lane & 15, q = lane >> 4, w = c.wave;
    if (c.G == 256) {
        const int it = blockIdx.x, g = it & 31, blk = (it >> 5) & 7; constexpr int T2 = 64 * S5_APITCH;
        s5_stage(c, U, nullptr, 0, blk, g, 0); s5_stage(c, U, nullptr, 1, blk, g, T2);
        const bf16_t* wp = Wt + (size_t)g * S5_W_ELEMS + (16 * w + r16) * 256 + 8 * q;
        bf16x8 bfr8[8];
#pragma unroll
        for (int ks = 0; ks < 8; ++ks) bfr8[ks] = *(const bf16x8*)(wp + 32 * ks);
        __syncthreads();
#pragma unroll
        for (int bb = 0; bb < 2; ++bb) { f32x4 acc[4];
#pragma unroll
            for (int mt = 0; mt < 4; ++mt) acc[mt] = (f32x4){0.f, 0.f, 0.f, 0.f};
#pragma unroll
            for (int ks = 0; ks < 8; ++ks)
#pragma unroll
                for (int mt = 0; mt < 4; ++mt) { const bf16x8 a = *(const LAS bf16x8*)(c.lds + bb * T2 + (16 * mt + r16) * S5_APITCH + (32 * ks + 8 * q) * 2); acc[mt] = __builtin_amdgcn_mfma_f32_16x16x32_bf16(a, bfr8[ks], acc[mt], 0, 0, 0); }
#pragma unroll
            for (int mt = 0; mt < 4; ++mt)
#pragma unroll
                for (int r = 0; r < 4; ++r) E[(((size_t)bb * 512 + blk * 64 + 16 * mt + 4 * q + r) * 32 + g) * 128 + 16 * w + r16] = acc[mt][r]; }
        __syncthreads();
        return;
    }
    for (int it = blockIdx.x; it < 512; it += c.G) {
        const int g = it & 31, blk = (it >> 5) & 7, b = it >> 8;
        s5_stage(c, U, nullptr, b, blk, g);
        __syncthreads();
        f32x4 acc[4];
#pragma unroll
        for (int mt = 0; mt < 4; ++mt) acc[mt] = (f32x4){0.f, 0.f, 0.f, 0.f};
        const bf16_t* wp = Wt + (size_t)g * S5_W_ELEMS + (16 * w + r16) * 256 + 8 * q;
#pragma unroll
        for (int ks = 0; ks < 8; ++ks) {
            const bf16x8 bfr = *(const bf16x8*)(wp + 32 * ks);
#pragma unroll
            for (int mt = 0; mt < 4; ++mt) { const bf16x8 a = *(const LAS bf16x8*)(c.lds + (16 * mt + r16) * S5_APITCH + (32 * ks + 8 * q) * 2); acc[mt] = __builtin_amdgcn_mfma_f32_16x16x32_bf16(a, bfr, acc[mt], 0, 0, 0); }
        }
#pragma unroll
        for (int mt = 0; mt < 4; ++mt)
#pragma unroll
            for (int r = 0; r < 4; ++r) E[(((size_t)b * 512 + blk * 64 + 16 * mt + 4 * q + r) * 32 + g) * 128 + 16 * w + r16] = acc[mt][r];
        __syncthreads();
    }
}
__device__ __forceinline__ void f_s5_scan(const Ctx& c, const float* __restrict__ E, const float* __restrict__ LB16, bf16_t* __restrict__ xin) {
    LAS f32x2_* Ssh = (LAS f32x2_*)c.lds;
    for (int bg = blockIdx.x; bg < BATCH * S5G; bg += c.G) {
        const int b = bg / S5G, g = bg % S5G, p = c.lane, seg = c.wave;
        const float lr = LB16[(g * 64 + p) * 2], li = LB16[(g * 64 + p) * 2 + 1];
        const float* ep = E + (((size_t)b * 512 + seg * 64) * 32 + g) * 128 + p; bf16_t* xp = xin + (((size_t)b * 512 + seg * 64) * 32 + g) * 128 + p;
        float er[64], ei[64];
#pragma unroll
        for (int i = 0; i < 64; ++i) { er[i] = ep[(size_t)i * 4096]; ei[i] = ep[(size_t)i * 4096 + 64]; }
        float xr = 0.f, xi = 0.f;
#pragma unroll
        for (int i = 0; i < 64; ++i) { const float nr = lr * xr - li * xi + er[i], ni = lr * xi + li * xr + ei[i]; er[i] = xr; ei[i] = xi; xr = nr; xi = ni; }
        Ssh[seg * 64 + p] = (f32x2_){xr, xi};
        float qr = lr, qi = li;
#pragma unroll
        for (int k = 0; k < 6; ++k) { const float nr = qr * qr - qi * qi, ni = 2.f * qr * qi; qr = nr; qi = ni; }
        __syncthreads();
        float cr = 0.f, ci = 0.f;
        for (int s2 = 0; s2 < seg; ++s2) { const f32x2_ sv = Ssh[s2 * 64 + p]; const float nr = qr * cr - qi * ci + sv.x, ni = qr * ci + qi * cr + sv.y; cr = nr; ci = ni; }
        float fr = 1.f, fi = 0.f;
#pragma unroll
        for (int i = 0; i < 64; ++i) { const float vr = er[i] + fr * cr - fi * ci, vi = ei[i] + fr * ci + fi * cr;
            xp[(size_t)i * 4096] = (bf16_t)f2bf(vr); xp[(size_t)i * 4096 + 64] = (bf16_t)f2bf(vi);
            const float nr = fr * lr - fi * li, ni = fr * li + fi * lr; fr = nr; fi = ni; }
        __syncthreads();
    }
}
__device__ __forceinline__ void f_s5_y(const Ctx& c, const bf16_t* __restrict__ U, const bf16_t* __restrict__ xin, const bf16_t* __restrict__ MTt, const float* __restrict__ dsk, bf16_t* __restrict__ YG) {
    const int lane = c.lane, r16 = lane & 15, q = lane >> 4, w = c.wave;
    if (c.G == 256) {
        const int it = blockIdx.x, g = it & 31, blk = (it >> 5) & 7; constexpr int T2 = 64 * S5_APITCH;
        s5_stage(c, U, xin, 0, blk, g, 0); s5_stage(c, U, xin, 1, blk, g, T2);
        const bf16_t* mp = MTt + (size_t)g * S5_MT_ELEMS + (32 * w + r16) * 384 + 8 * q;
        bf16x8 b0[12], b1[12];
#pragma unroll
        for (int ks = 0; ks < 12; ++ks) { b0[ks] = (bf16x8){0, 0, 0, 0, 0, 0, 0, 0}; b1[ks] = b0[ks]; if (ks <= w || ks >= 8) { b0[ks] = *(const bf16x8*)(mp + 32 * ks); b1[ks] = *(const bf16x8*)(mp + 16 * 384 + 32 * ks); } }
        const float dk = dsk[16 * g + r16];
        __syncthreads();
#pragma unroll
        for (int bb = 0; bb < 2; ++bb) { f32x4 acc[4][2];
#pragma unroll
            for (int mt = 0; mt < 4; ++mt) { acc[mt][0] = (f32x4){0.f, 0.f, 0.f, 0.f}; acc[mt][1] = (f32x4){0.f, 0.f, 0.f, 0.f}; }
#pragma unroll
            for (int ks = 0; ks < 12; ++ks) {
                if (ks <= w || ks >= 8) {
#pragma unroll
                    for (int mt = 0; mt < 4; ++mt) { const bf16x8 a = *(const LAS bf16x8*)(c.lds + bb * T2 + (16 * mt + r16) * S5_APITCH + (32 * ks + 8 * q) * 2);
                        acc[mt][0] = __builtin_amdgcn_mfma_f32_16x16x32_bf16(a, b0[ks], acc[mt][0], 0, 0, 0); acc[mt][1] = __builtin_amdgcn_mfma_f32_16x16x32_bf16(a, b1[ks], acc[mt][1], 0, 0, 0); }
                }
            }
#pragma unroll
            for (int mt = 0; mt < 4; ++mt)
#pragma unroll
                for (int jj = 0; jj < 2; ++jj)
#pragma unroll
                    for (int r = 0; r < 4; ++r) { const int m = 16 * mt + 4 * q + r, j = 2 * w + jj;
                        const float uv = bf2f(*(const LAS bf16_t*)(c.lds + bb * T2 + m * S5_APITCH + (16 * j + r16) * 2));
                        YG[((size_t)bb * SEQ + (blk * 64 + m) * 16 + j) * 512 + 16 * g + r16] = (bf16_t)f2bf(gelu_tanh(acc[mt][jj][r] + dk * uv)); } }
        __syncthreads();
        return;
    }
    for (int it = blockIdx.x; it < 512; it += c.G) {
        const int g = it & 31, blk = (it >> 5) & 7, b = it >> 8;
        s5_stage(c, U, xin, b, blk, g);
        f32x4 acc[4][2];
#pragma unroll
        for (int mt = 0; mt < 4; ++mt) { acc[mt][0] = (f32x4){0.f, 0.f, 0.f, 0.f}; acc[mt][1] = (f32x4){0.f, 0.f, 0.f, 0.f}; }
        const bf16_t* mp = MTt + (size_t)g * S5_MT_ELEMS + (32 * w + r16) * 384 + 8 * q;
        bf16x8 b0[12], b1[12];
#pragma unroll
        for (int ks = 0; ks < 12; ++ks) { b0[ks] = (bf16x8){0, 0, 0, 0, 0, 0, 0, 0}; b1[ks] = b0[ks]; if (ks <= w || ks >= 8) { b0[ks] = *(const bf16x8*)(mp + 32 * ks); b1[ks] = *(const bf16x8*)(mp + 16 * 384 + 32 * ks); } }
        __syncthreads();
#pragma unroll
        for (int ks = 0; ks < 12; ++ks) {
            if (ks <= w || ks >= 8) {
#pragma unroll
                for (int mt = 0; mt < 4; ++mt) { const bf16x8 a = *(const LAS bf16x8*)(c.lds + (16 * mt + r16) * S5_APITCH + (32 * ks + 8 * q) * 2);
                    acc[mt][0] = __builtin_amdgcn_mfma_f32_16x16x32_bf16(a, b0[ks], acc[mt][0], 0, 0, 0); acc[mt][1] = __builtin_amdgcn_mfma_f32_16x16x32_bf16(a, b1[ks], acc[mt][1], 0, 0, 0); }
            }
        }
        const float dk = dsk[16 * g + r16];
#pragma unroll
        for (int mt = 0; mt < 4; ++mt)
#pragma unroll
            for (int jj = 0; jj < 2; ++jj)
#pragma unroll
                for (int r = 0; r < 4; ++r) { const int m = 16 * mt + 4 * q + r, j = 2 * w + jj;
                    const float uv = bf2f(*(const LAS bf16_t*)(c.lds + m * S5_APITCH + (16 * j + r16) * 2));
                    YG[((size_t)b * SEQ + (blk * 64 + m) * 16 + j) * 512 + 16 * g + r16] = (bf16_t)f2bf(gelu_tanh(acc[mt][jj][r] + dk * uv)); }
        __syncthreads();
    }
}
#ifndef REP_PRO
#define REP_PRO 1
#endif
#ifndef REP_P2
#define REP_P2 1
#endif
#ifndef REP_HEADS
#define REP_HEADS 1
#endif
#ifndef REP_ATTN
#define REP_ATTN 1
#endif
#ifndef REP_S5Y
#define REP_S5Y 1
#endif
#ifndef REP_GLU
#define REP_GLU 1
#endif
#ifndef REP_MIXB
#define REP_MIXB 1
#endif
#ifndef REP_FFN1
#define REP_FFN1 1
#endif
#ifndef REP_ROUTE1
#define REP_ROUTE1 1
#endif
#ifndef REP_ROUTE2
#define REP_ROUTE2 1
#endif
#ifndef REP_GEMM1
#define REP_GEMM1 1
#endif
#ifndef REP_GEMM2
#define REP_GEMM2 1
#endif
#ifndef PROBE_ONLINE
#define PROBE_ONLINE 0
#endif
#ifndef PROBE_MASK
#define PROBE_MASK 0ull
#endif
#ifndef PROBE_BAR
#define PROBE_BAR 0
#endif
struct Args { const float* in[32]; float* out; unsigned char* ws; int ph_lo, ph_hi; };
constexpr size_t WS_CTL = 0, CTL_ZERO_BYTES = 2 * MiB;
constexpr int CW_BAR = 4096;
constexpr size_t WS_XSSM = 64 * 1024, WS_XSSF = WS_XSSM + 2 * 131072, WS_QSS = WS_XSSF + 2 * 131072, WS_KVSS = WS_QSS + 2 * 131072, WS_KRSS = WS_KVSS + 2 * 131072, WS_TICKETS = WS_KRSS + 65536;
constexpr size_t WS_SCANCNT = 48 * 1024;
constexpr size_t WS_XB = 2 * MiB;
constexpr size_t WS_WGLU = 34 * MiB, WS_WPA = 35 * MiB, WS_WPS = 37 * MiB, WS_WOUT = 39 * MiB, WS_S5MT = 43 * MiB, WS_S5LB = 55 * MiB, WS_BIASL = 56 * MiB, WS_GA = 57 * MiB, WS_GB = 89 * MiB, WS_QRAW = 121 * MiB  , WS_K = 145 * MiB,
    WS_U = 169 * MiB, WS_V = 185 * MiB, WS_ATT = 201 * MiB  , WS_S5X = 233 * MiB;
constexpr size_t WS_MIX = 153 * MiB, WS_HD = 57 * MiB;
constexpr size_t WS_WIN = 241 * MiB, WS_WUQ = 253 * MiB, WS_WUKV = 254 * MiB, WS_WFGU = 255 * MiB, WS_WFD = 266 * MiB, WS_S5W = 272 * MiB, WS_QLAT = 276 * MiB, WS_KVLAT = 284 * MiB, WS_YG = 276 * MiB  , WS_ROPE = 292 * MiB, WS_KVRAW = 316 * MiB, WS_S5E = 365 * MiB  ;
constexpr size_t WS_WMGU = 309 * MiB, WS_WMD = 421 * MiB, WS_H1 = 34 * MiB, WS_YB = 309 * MiB, WS_MT = 303 * MiB, WS_TOPE = WS_MT, WS_TOPW = WS_MT + 256 * 1024, WS_RANK = WS_MT + 512 * 1024, WS_CNT = WS_MT + 768 * 1024,
    WS_TILEE = WS_MT + 800 * 1024, WS_NTILES = WS_MT + 804 * 1024, WS_POS = 304 * MiB, WS_ROWTOK = 305 * MiB, WS_RROW = 306 * MiB, WS_SLAB = 185 * MiB  , WS_WIN8 = 381 * MiB  , WS_XB8 = 185 * MiB  , WS_END = 477 * MiB;

constexpr int MOE_TILES = NE * (D / 64) * (FFE / 64) * 3, MOE_S0 = 2048, MOE_S1 = MOE_S0 + 4096, MOE_S2 = MOE_S1 + 2048;
#define MOE_SLICE(lo_, hi_) do { if (c.G == 256 && bid >= 128) { __syncthreads(); Ctx cj_ = c; cj_.lane = hw_lane(); cj_.tid = cj_.wave * 64 + cj_.lane; { const Ctx& c = cj_; ConvDist cd_{c.gw - 128 * NWAVES, 128 * NWAVES, 0, (lo_), (hi_)}; JOB_MOE(); } __syncthreads(); } } while (0)
constexpr int TAIL_NSL7 = 7;
constexpr int TAIL_NSL = 2;
#define CONV_SCR(c) ((LAS float*)((c).lds + (c).wave * CONV_SCR_BYTES))
#define JOB_MIXER(l) do { \
    conv_proj(c, cd_, CONV_SCR(c), IN(2) + (size_t)(l) * D * INC, WSP(bf16_t, WS_WIN) + (size_t)(l) * 3072 * D, IN(1) + (l) * D); \
    conv_plain<true>(c, cd_, CONV_SCR(c), IN(2) + (size_t)(l) * D * INC + 928, D, 2048, WSP(bf16_t, WS_WIN8) + (size_t)(l) * 2048 * (D / 2), D, IN(1) + (l) * D, 64.f, INC); \
    conv_plain(c, cd_, CONV_SCR(c), IN(5) + (size_t)(l) * QLR * 768, QLR, 768, WSP(bf16_t, WS_WUQ) + (size_t)(l) * 768 * 256, 256, IN(4) + (l) * QLR); \
    conv_kv(c, cd_, CONV_SCR(c), IN(7) + (size_t)(l) * KVLR * 1024, WSP(bf16_t, WS_WUKV) + (size_t)(l) * 1024 * 256, IN(6) + (l) * KVLR); \
    conv_plain(c, cd_, CONV_SCR(c), IN(18) + (size_t)(l) * 512 * 512, 512, 512, WSP(bf16_t, WS_WGLU) + (size_t)(l) * 512 * 512, 512, nullptr); \
    conv_plain_at(c, cd_, CONV_SCR(c), IN(20) + (size_t)(l) * 512 * 1024, 512, 1024, WSP(bf16_t, WS_WPA) + (size_t)(l) * 1024 * 1024, 1024, 0); \
    conv_plain_at(c, cd_, CONV_SCR(c), IN(21) + (size_t)(l) * 512 * 1024, 512, 1024, WSP(bf16_t, WS_WPA) + (size_t)(l) * 1024 * 1024, 1024, 512); \
    conv_plain(c, cd_, CONV_SCR(c), IN(22) + (size_t)(l) * D * D, D, D, WSP(bf16_t, WS_WOUT) + (size_t)(l) * D * D, D, nullptr); \
    for (int i_ = blockIdx.x * NTHREADS + c.tid; i_ < 3072; i_ += c.G * NTHREADS) { const int s_ = proj_src(i_); WSP(float, WS_BIASL)[(l) * 3072 + i_] = s_ >= 0 ? IN(3)[(l) * INC + s_] : 0.f; } } while (0)
#define JOB_FFN() do { conv_gateup(c, cd_, CONV_SCR(c), IN(24), IN(25), FFD, WSP(bf16_t, WS_WFGU), IN(23), 1); conv_plain(c, cd_, CONV_SCR(c), IN(26), FFD, D, WSP(bf16_t, WS_WFD), FFD, nullptr); } while (0)
#define JOB_MOE() do { conv_gateup<true>(c, cd_, CONV_SCR(c), IN(29), IN(30), FFE, WSP(bf16_t, WS_WMGU), IN(23) + D, NE, MOE_WGU_SCALE); conv_plain_n<true>(c, cd_, CONV_SCR(c), IN(31), FFE, D, WSP(bf16_t, WS_WMD), NE, MOE_WD_SCALE); } while (0)

__global__ void __launch_bounds__(NTHREADS, 2) mk_fwd(Args a) {
    extern __shared__ __attribute__((aligned(16))) unsigned char lds_raw[];
    Ctx c0; c0.lds = (LAS unsigned char*)lds_raw;
    c0.tid = threadIdx.x; c0.lane = c0.tid & 63; c0.wave = __builtin_amdgcn_readfirstlane(c0.tid >> 6); c0.G = gridDim.x; c0.gw = blockIdx.x * NWAVES + c0.wave; c0.NGW = c0.G * NWAVES;
    volatile LAS unsigned* MISC = (volatile LAS unsigned*)(c0.lds + LDSCTL_OFF);
    for (int u = c0.tid; u < (LDS_BYTES - LDSCTL_OFF) / 4; u += NTHREADS) ((LAS unsigned*)(c0.lds + LDSCTL_OFF))[u] = 0u;
    __syncthreads();
    unsigned char* ws0 = a.ws;
    XcdBarrier bar = xcd_barrier_post((unsigned*)(ws0 + WS_CTL) + CW_BAR, MISC + 8); bar.w = (unsigned)c0.wave;
    const int lo = a.ph_lo, hi = a.ph_hi; int ph = 0;
    volatile LAS unsigned long long* PRB = (volatile LAS unsigned long long*)(c0.lds + LDSCTL_OFF + 128);
#define PH_BEGIN if (ph >= lo && ph < hi) { if (PROBE_MASK != 0ull && ((PROBE_MASK >> ph) & 1ull)) PRB[1] = __builtin_amdgcn_s_memrealtime(); Ctx c = c0; c.lane = hw_lane(); asm volatile("" : "+s"(c.wave), "+s"(c.gw), "+s"(c.G), "+s"(c.NGW)); c.tid = c.wave * 64 + c.lane; unsigned char* ws = ws0; asm volatile("" : "+s"(ws)); float* X = a.out; asm volatile("" : "+s"(X)); const int bid = __builtin_amdgcn_readfirstlane(blockIdx.x);
#define PH_END if (PROBE_MASK != 0ull && ((PROBE_MASK >> ph) & 1ull)) { __syncthreads(); if ((c0.wave == 0 && hw_lane() == 0)) PRB[0] = PRB[0] + (__builtin_amdgcn_s_memrealtime() - PRB[1]); } if (PROBE_BAR && (c0.wave == 0 && hw_lane() == 0)) PRB[1] = __builtin_amdgcn_s_memrealtime(); if (ph + 1 < hi) xcd_barrier(bar); if (PROBE_BAR && (c0.wave == 0 && hw_lane() == 0)) PRB[0] = PRB[0] + (__builtin_amdgcn_s_memrealtime() - PRB[1]); } ++ph;
#define IN(k) ({ const float* p_ = a.in[k]; asm volatile("" : "+s"(p_)); p_; })
#define WSP(type, off) ((type*)(ws + (off)))
#define COMMA ,
#define GEMM(EpiT, Aptr, Bptr, N_, K_, ...) do { pg8::Gemm g_{(const pg8::bf16_t*)(Aptr), (const pg8::bf16_t*)(Bptr), T, (N_), (K_), (K_)}; pg8::StaticOrder S_; S_.init(T, (N_), c.G, bid); EpiT E_{__VA_ARGS__}; \
        int tid_ = c.tid; asm volatile("" : "+v"(tid_)); pg8::gemm_phase<EpiT, pg8::StaticOrder, true, true>(c.lds, g_, S_, E_, tid_); } while (0)
#define GEMM8(EpiT, Aptr, Bptr, N_, K_, ...) do { pg8::Gemm g_{(const pg8::bf16_t*)(Aptr), (const pg8::bf16_t*)(Bptr), T, (N_), (K_), (K_)}; pg8::StaticOrder S_; S_.init(T, (N_), c.G, bid); EpiT E_{__VA_ARGS__}; \
        int tid_ = c.tid; asm volatile("" : "+v"(tid_)); pg8::gemm_phase<EpiT, pg8::StaticOrder, true, true, true>(c.lds, g_, S_, E_, tid_); } while (0)

#ifndef STAG_P1
#define STAG_P1 0
#endif
#ifndef STAG_FFN1
#define STAG_FFN1 0
#endif
#ifndef STAG_GEMM1
#define STAG_GEMM1 0
#endif
#define STAGGER(ticks) do { if ((ticks) > 0 && ((bid >> 3) & 1)) { const unsigned long long t0_ = __builtin_amdgcn_s_memrealtime(); while (__builtin_amdgcn_s_memrealtime() - t0_ < (unsigned long long)(ticks)) __builtin_amdgcn_s_sleep(4); } } while (0)
    PH_BEGIN for (int rep_ = 0; rep_ < REP_PRO; ++rep_) {
        for (int wgi = bid; wgi < DEPTH * S5G; wgi += c.G) { const int l = wgi >> 5, g = wgi & 31;
            s5_tables(c, g, IN(10) + l * 2048, IN(11) + l * 2048, IN(12) + l * 32, IN(13) + (size_t)l * 32768, IN(14) + (size_t)l * 32768, IN(15) + (size_t)l * 32768, IN(16) + (size_t)l * 32768,
                      WSP(bf16_t, WS_S5MT) + (size_t)wgi * S5_MT_ELEMS, WSP(bf16_t, WS_S5W) + (size_t)wgi * S5_W_ELEMS, WSP(float, WS_S5LB) + l * 4096); }
        { ConvDist cd_{c.G >= 128 ? (bid >= DEPTH * S5G ? c.gw - DEPTH * S5G * NWAVES : -1) : c.gw, c.G >= 128 ? c.NGW - DEPTH * S5G * NWAVES : c.NGW, 0};
          JOB_MIXER(0); }
        f_rope_table(c, WSP(float, WS_ROPE));
        f_xbss(c, IN(0), WSP(bf16_t, WS_XB), WSP(unsigned char, WS_XB8), WSP(u64, WS_XSSM), c.G >= 128 ? DEPTH * S5G : 0);
    } PH_END

    { constexpr int l = 0;
        PH_BEGIN STAGGER(STAG_P1); GEMM(EpiProjF, WSP(bf16_t, WS_XB), WSP(bf16_t, WS_WIN) + (size_t)l * 3072 * D, 1024, D, WSP(u64, WS_XSSM) + l * T, WSP(float, WS_BIASL) + l * 3072, WSP(bf16_t, WS_QLAT), WSP(bf16_t, WS_KVLAT),
                      WSP(bf16_t, WS_U), WSP(bf16_t, WS_GA), WSP(bf16_t, WS_GB), WSP(u64, WS_QSS) + l * T, WSP(u64, WS_KVSS) + l * T, WSP(float, WS_KRSS), 0, 1.f);
                 __syncthreads();
                 GEMM8(EpiProjF, WSP(bf16_t, WS_XB8), WSP(bf16_t, WS_WIN8) + (size_t)l * 2048 * (D / 2), 2048, D / 2, WSP(u64, WS_XSSM) + l * T, WSP(float, WS_BIASL) + l * 3072, WSP(bf16_t, WS_QLAT), WSP(bf16_t, WS_KVLAT),
                      WSP(bf16_t, WS_U), WSP(bf16_t, WS_GA), WSP(bf16_t, WS_GB), WSP(u64, WS_QSS) + l * T, WSP(u64, WS_KVSS) + l * T, WSP(float, WS_KRSS), 4, 1.f / 64.f); PH_END
        PH_BEGIN for (int rep_ = 0; rep_ < REP_P2; ++rep_) { GEMM(EpiRowScale, WSP(bf16_t, WS_QLAT), WSP(bf16_t, WS_WUQ) + (size_t)l * 768 * 256, 768, 256, WSP(bf16_t, WS_QRAW), WSP(u64, WS_QSS) + l * T, 768, 1.f / 256.f);
                 __syncthreads();
                 if (c.G == 256) { GEMM(EpiKV, WSP(bf16_t, WS_KVLAT), WSP(bf16_t, WS_WUKV) + (size_t)l * 1024 * 256, 1024, 256, WSP(u64, WS_KVSS) + l * T, WSP(float, WS_KRSS), WSP(bf16_t, WS_KVLAT), IN(9) + l * QKD, WSP(float, WS_ROPE), WSP(bf16_t, WS_K), WSP(bf16_t, WS_V)); }
                 else { GEMM(EpiKVslow, WSP(bf16_t, WS_KVLAT), WSP(bf16_t, WS_WUKV) + (size_t)l * 1024 * 256, 1024, 256, WSP(u64, WS_KVSS) + l * T, WSP(float, WS_KRSS), WSP(bf16_t, WS_KVLAT), IN(9) + l * QKD, WSP(float, WS_ROPE), WSP(bf16_t, WS_K), WSP(bf16_t, WS_V)); }
                 __syncthreads();
                 f_s5_e(c, WSP(bf16_t, WS_U), WSP(bf16_t, WS_S5W) + (size_t)l * 32 * S5_W_ELEMS, WSP(float, WS_S5E));
 __syncthreads(); }
                 PH_END
        PH_BEGIN { unsigned* scnt_ = WSP(unsigned, WS_SCANCNT) + 64 * l; const int nscan_ = bid < BATCH * S5G ? (BATCH * S5G - bid + c.G - 1) / c.G : 0;
                 if (nscan_ > 0) { f_s5_scan(c, WSP(float, WS_S5E), WSP(float, WS_S5LB) + l * 4096, WSP(bf16_t, WS_S5X)); asm volatile("s_waitcnt vmcnt(0)" ::: "memory"); __syncthreads();
                     if (c.tid == 0) { __builtin_amdgcn_fence(__ATOMIC_RELEASE, "agent"); asm volatile("s_waitcnt vmcnt(0)" ::: "memory"); (void)__hip_atomic_fetch_add(scnt_, (unsigned)nscan_, __ATOMIC_RELAXED, __HIP_MEMORY_SCOPE_AGENT); } }
                 { const float sb_ = attn_score_bound(c, IN(8) + l * QKD, IN(9) + l * QKD); const float sbe_ = sb_ * 1.02f;     const bool fast_ = sbe_ <= 17.0f && !PROBE_ONLINE; const float csh_ = ceilf(fmaxf(sbe_ - 15.7f, 0.f) * 8.f) * 0.125f;         const int slot_ = (c.G % 8 == 0 ? (bid % 8) * (c.G / 8) + bid / 8 : bid) % 3;
                 for (int part_ = 0; part_ < 3; ++part_) {
                     if (part_ == slot_) { __syncthreads(); { Ctx cj_ = c; cj_.lane = hw_lane(); cj_.tid = cj_.wave * 64 + cj_.lane; const Ctx& c = cj_;     const int nsw_ = (c.G >= 128 ? BATCH * S5G : 0) * NWAVES;     ConvDist cd_{l == 0 ? (c.gw >= nsw_ ? c.gw - nsw_ : -1) : (c.gw >= nsw_ ? c.gw - nsw_ : c.gw + c.NGW - nsw_), l == 0 ? c.NGW - nsw_ : c.NGW, 0, (l == 1 && c.G == 256) ? MOE_S2 : 0, 0x7fffffff}; if (l == 0) { JOB_MIXER(1); JOB_FFN(); } else { JOB_MOE(); } } __syncthreads(); }
                     if (part_ < 2) f_attn_part(c, WSP(bf16_t, WS_QRAW), WSP(bf16_t, WS_K), WSP(bf16_t, WS_V), WSP(bf16_t, WS_ATT), IN(8) + l * QKD, WSP(float, WS_ROPE), part_, fast_, csh_); } }
                 __syncthreads();
                 if (c.tid == 0) { unsigned sp_ = 0u; while (__hip_atomic_load(scnt_, __ATOMIC_RELAXED, __HIP_MEMORY_SCOPE_AGENT) < (unsigned)(BATCH * S5G)) { __builtin_amdgcn_s_sleep(4); if (++sp_ > (1u << 22)) break; }
                     __builtin_amdgcn_fence(__ATOMIC_ACQUIRE, "agent"); asm volatile("s_waitcnt vmcnt(0)" ::: "memory"); }
                 __syncthreads();
                 for (int rep_ = 0; rep_ < REP_S5Y; ++rep_) { f_s5_y(c, WSP(bf16_t, WS_U), WSP(bf16_t, WS_S5X), WSP(bf16_t, WS_S5MT) + (size_t)l * 32 * S5_MT_ELEMS, IN(17) + l * 512, WSP(bf16_t, WS_YG)); } } PH_END
        PH_BEGIN GEMM(EpiGluF, WSP(bf16_t, WS_YG), WSP(bf16_t, WS_WGLU) + (size_t)l * 512 * 512, 512, 512, WSP(bf16_t, WS_YG), IN(19) + l * 512, WSP(bf16_t, WS_ATT) + 512, 1024, 0);
                 if (l == 0) MOE_SLICE(0, MOE_S0); else MOE_SLICE(MOE_S1, MOE_S2); PH_END
        PH_BEGIN GEMM(EpiMixFused, WSP(bf16_t, WS_ATT), WSP(bf16_t, WS_WPA) + (size_t)l * 1024 * 1024, 1024, 1024, WSP(bf16_t, WS_GA), WSP(bf16_t, WS_GB), WSP(bf16_t, WS_MIX)); PH_END
        PH_BEGIN if (l == 0) { GEMM(EpiResidF<false COMMA false>, WSP(bf16_t, WS_MIX), WSP(bf16_t, WS_WOUT), D, D, IN(0), nullptr, WSP(bf16_t, WS_XB), WSP(u64, WS_XSSF), nullptr); }
                 else { GEMM(EpiResidF<true COMMA true>, WSP(bf16_t, WS_MIX), WSP(bf16_t, WS_WOUT) + (size_t)D * D, D, D, nullptr, X, WSP(bf16_t, WS_XB), WSP(u64, WS_XSSF) + T, WSP(unsigned char, WS_XB8)); } PH_END
        if (l == 0) {
            PH_BEGIN STAGGER(STAG_FFN1); for (int rep_ = 0; rep_ < REP_FFN1; ++rep_) { GEMM(EpiSwigluF, WSP(bf16_t, WS_XB), WSP(bf16_t, WS_WFGU), 2 * FFD, D, WSP(bf16_t, WS_HD), WSP(u64, WS_XSSF), nullptr, FFD, 22, 1.f); } MOE_SLICE(MOE_S0, MOE_S1); PH_END
            PH_BEGIN GEMM(EpiResidF<true COMMA false COMMA true COMMA true>, WSP(bf16_t, WS_HD), WSP(bf16_t, WS_WFD), D, FFD, nullptr, nullptr, WSP(bf16_t, WS_XB), WSP(u64, WS_XSSM) + T, WSP(unsigned char, WS_XB8)); PH_END
        } else {
            PH_BEGIN for (int rep_ = 0; rep_ < REP_ROUTE1; ++rep_) { __syncthreads(); f_route1(c, X, IN(23) + l * D, IN(27), IN(28), WSP(int, WS_TOPE), WSP(float, WS_TOPW), WSP(int, WS_RANK), WSP(int, WS_CNT), WSP(int, WS_ROWTOK), WSP(float, WS_RROW));
 } PH_END
            PH_BEGIN for (int rep_ = 0; rep_ < REP_ROUTE2; ++rep_) { f_route2(c, WSP(int, WS_TOPE), WSP(int, WS_RANK), WSP(int, WS_CNT), WSP(int, WS_POS), WSP(int, WS_ROWTOK), WSP(int, WS_TILEE), WSP(int, WS_NTILES), WSP(u64, WS_XSSF) + T, WSP(float, WS_RROW)); } PH_END
            PH_BEGIN { const int ntl = __builtin_amdgcn_readfirstlane(WSP(int, WS_NTILES)[0]);
                pg8::Gemm g_{(const pg8::bf16_t*)WSP(bf16_t, WS_XB8), (const pg8::bf16_t*)WSP(bf16_t, WS_WMGU), ntl * 256, 2 * FFE, D / 2, D / 2};     LAS int* lte_ = (LAS int*)(c.lds + pg8::STAGE_BYTES); for (int i_ = c.tid; i_ < RCAP / 256; i_ += NTHREADS) lte_[i_] = WSP(int, WS_TILEE)[i_]; __syncthreads();
                pg8::MoeOrder S_; S_.init(ntl * 256, 2 * FFE, c.G, bid); S_.tile_e = lte_; S_.per_e = 2 * FFE / 256;
                EpiSwigluF8 E_{WSP(bf16_t, WS_H1), nullptr, WSP(float, WS_RROW), FFE, 2 * FFE / 256, 1.f};
                STAGGER(STAG_GEMM1); int tid_ = c.tid; asm volatile("" : "+v"(tid_)); for (int rep_ = 0; rep_ < REP_GEMM1; ++rep_) pg8::gemm_phase_gather<EpiSwigluF8, pg8::MoeOrder, true>(c.lds, g_, WSP(int, WS_ROWTOK), S_, E_, tid_); } PH_END
            PH_BEGIN { const int ntl = __builtin_amdgcn_readfirstlane(WSP(int, WS_NTILES)[0]); const int nfull = ntl < 128 ? ntl : 128;
                { pg8::Gemm g_{(const pg8::bf16_t*)WSP(bf16_t, WS_H1), (const pg8::bf16_t*)WSP(bf16_t, WS_WMD), nfull * 256, D, FFE / 2, FFE / 2}; LAS int* lte_ = (LAS int*)(c.lds + pg8::STAGE_BYTES); for (int i_ = c.tid; i_ < RCAP / 256; i_ += NTHREADS) lte_[i_] = WSP(int, WS_TILEE)[i_]; __syncthreads();
                  pg8::MoeOrder S_; S_.init(nfull * 256, D, c.G, bid); S_.tile_e = lte_; S_.per_e = D / 256;
                  EpiStoreBf16 E_{WSP(bf16_t, WS_YB), D, D / 256};
                  int tid_ = c.tid; asm volatile("" : "+v"(tid_)); for (int rep_ = 0; rep_ < REP_GEMM2; ++rep_) pg8::gemm_phase<EpiStoreBf16, pg8::MoeOrder, true, true, true>(c.lds, g_, S_, E_, tid_); }
                __syncthreads();
                if (ntl > nfull) {
                    if ((ntl - nfull) * (D / 256) * TAIL_NSL7 <= c.G) {
                        pg8::Gemm g_{(const pg8::bf16_t*)WSP(bf16_t, WS_H1), (const pg8::bf16_t*)WSP(bf16_t, WS_WMD), ntl * 256, D, FFE / 2 / TAIL_NSL7, FFE / 2};
                        EpiSplitKAll E_{WSP(bf16_t, WS_YB), WSP(float, WS_SLAB), WSP(unsigned, WS_TICKETS), D, D / 256, nfull, TAIL_NSL7, FFE / TAIL_NSL7};
                        pg8::TailOrder S_{WSP(int, WS_TILEE), nfull, ntl - nfull, D / 256, TAIL_NSL7, FFE / TAIL_NSL7, bid};
                        int tid_ = c.tid; asm volatile("" : "+v"(tid_)); pg8::gemm_phase<EpiSplitKAll, pg8::TailOrder, false, true, true>(c.lds, g_, S_, E_, tid_); __syncthreads();
                    } else {
                    pg8::Gemm g_{(const pg8::bf16_t*)WSP(bf16_t, WS_H1), (const pg8::bf16_t*)WSP(bf16_t, WS_WMD), ntl * 256, D, FFE / 2 / TAIL_NSL, FFE / 2};
                    EpiSplitK E_{WSP(bf16_t, WS_YB), WSP(float, WS_XB), WSP(unsigned, WS_TICKETS), D, D / 256, nfull, TAIL_NSL, FFE / TAIL_NSL};
                    for (int base_ = 0; base_ < (ntl - nfull) * (D / 256) * TAIL_NSL; base_ += c.G) {
                        pg8::TailOrder S_{WSP(int, WS_TILEE), nfull, ntl - nfull, D / 256, TAIL_NSL, FFE / TAIL_NSL, bid + base_};
                        int tid_ = c.wave * 64 + hw_lane(); asm volatile("" : "+v"(tid_)); pg8::gemm_phase<EpiSplitK, pg8::TailOrder, false, true, true>(c.lds, g_, S_, E_, tid_); __syncthreads(); } } } } PH_END
            PH_BEGIN f_combine(c, X, WSP(bf16_t, WS_YB), WSP(int, WS_POS), WSP(float, WS_TOPW)); PH_END
        }

    }
    { constexpr int l = 1;
        PH_BEGIN STAGGER(STAG_P1); GEMM(EpiProjF, WSP(bf16_t, WS_XB), WSP(bf16_t, WS_WIN) + (size_t)l * 3072 * D, 1024, D, WSP(u64, WS_XSSM) + l * T, WSP(float, WS_BIASL) + l * 3072, WSP(bf16_t, WS_QLAT), WSP(bf16_t, WS_KVLAT),
                      WSP(bf16_t, WS_U), WSP(bf16_t, WS_GA), WSP(bf16_t, WS_GB), WSP(u64, WS_QSS) + l * T, WSP(u64, WS_KVSS) + l * T, WSP(float, WS_KRSS), 0, 1.f);
                 __syncthreads();
                 GEMM8(EpiProjF, WSP(bf16_t, WS_XB8), WSP(bf16_t, WS_WIN8) + (size_t)l * 2048 * (D / 2), 2048, D / 2, WSP(u64, WS_XSSM) + l * T, WSP(float, WS_BIASL) + l * 3072, WSP(bf16_t, WS_QLAT), WSP(bf16_t, WS_KVLAT),
                      WSP(bf16_t, WS_U), WSP(bf16_t, WS_GA), WSP(bf16_t, WS_GB), WSP(u64, WS_QSS) + l * T, WSP(u64, WS_KVSS) + l * T, WSP(float, WS_KRSS), 4, 1.f / 64.f); PH_END
        PH_BEGIN for (int rep_ = 0; rep_ < REP_P2; ++rep_) { GEMM(EpiRowScale, WSP(bf16_t, WS_QLAT), WSP(bf16_t, WS_WUQ) + (size_t)l * 768 * 256, 768, 256, WSP(bf16_t, WS_QRAW), WSP(u64, WS_QSS) + l * T, 768, 1.f / 256.f);
                 __syncthreads();
                 if (c.G == 256) { GEMM(EpiKV, WSP(bf16_t, WS_KVLAT), WSP(bf16_t, WS_WUKV) + (size_t)l * 1024 * 256, 1024, 256, WSP(u64, WS_KVSS) + l * T, WSP(float, WS_KRSS), WSP(bf16_t, WS_KVLAT), IN(9) + l * QKD, WSP(float, WS_ROPE), WSP(bf16_t, WS_K), WSP(bf16_t, WS_V)); }
                 else { GEMM(EpiKVslow, WSP(bf16_t, WS_KVLAT), WSP(bf16_t, WS_WUKV) + (size_t)l * 1024 * 256, 1024, 256, WSP(u64, WS_KVSS) + l * T, WSP(float, WS_KRSS), WSP(bf16_t, WS_KVLAT), IN(9) + l * QKD, WSP(float, WS_ROPE), WSP(bf16_t, WS_K), WSP(bf16_t, WS_V)); }
                 __syncthreads();
                 f_s5_e(c, WSP(bf16_t, WS_U), WSP(bf16_t, WS_S5W) + (size_t)l * 32 * S5_W_ELEMS, WSP(float, WS_S5E));
 __syncthreads(); }
                 PH_END
        PH_BEGIN { unsigned* scnt_ = WSP(unsigned, WS_SCANCNT) + 64 * l; const int nscan_ = bid < BATCH * S5G ? (BATCH * S5G - bid + c.G - 1) / c.G : 0;
                 if (nscan_ > 0) { f_s5_scan(c, WSP(float, WS_S5E), WSP(float, WS_S5LB) + l * 4096, WSP(bf16_t, WS_S5X)); asm volatile("s_waitcnt vmcnt(0)" ::: "memory"); __syncthreads();
                     if (c.tid == 0) { __builtin_amdgcn_fence(__ATOMIC_RELEASE, "agent"); asm volatile("s_waitcnt vmcnt(0)" ::: "memory"); (void)__hip_atomic_fetch_add(scnt_, (unsigned)nscan_, __ATOMIC_RELAXED, __HIP_MEMORY_SCOPE_AGENT); } }
                 { const float sb_ = attn_score_bound(c, IN(8) + l * QKD, IN(9) + l * QKD); const float sbe_ = sb_ * 1.02f;     const bool fast_ = sbe_ <= 17.0f && !PROBE_ONLINE; const float csh_ = ceilf(fmaxf(sbe_ - 15.7f, 0.f) * 8.f) * 0.125f;         const int slot_ = (c.G % 8 == 0 ? (bid % 8) * (c.G / 8) + bid / 8 : bid) % 3;
                 for (int part_ = 0; part_ < 3; ++part_) {
                     if (part_ == slot_) { __syncthreads(); { Ctx cj_ = c; cj_.lane = hw_lane(); cj_.tid = cj_.wave * 64 + cj_.lane; const Ctx& c = cj_;     const int nsw_ = (c.G >= 128 ? BATCH * S5G : 0) * NWAVES;     ConvDist cd_{l == 0 ? (c.gw >= nsw_ ? c.gw - nsw_ : -1) : (c.gw >= nsw_ ? c.gw - nsw_ : c.gw + c.NGW - nsw_), l == 0 ? c.NGW - nsw_ : c.NGW, 0, (l == 1 && c.G == 256) ? MOE_S2 : 0, 0x7fffffff}; if (l == 0) { JOB_MIXER(1); JOB_FFN(); } else { JOB_MOE(); } } __syncthreads(); }
                     if (part_ < 2) f_attn_part(c, WSP(bf16_t, WS_QRAW), WSP(bf16_t, WS_K), WSP(bf16_t, WS_V), WSP(bf16_t, WS_ATT), IN(8) + l * QKD, WSP(float, WS_ROPE), part_, fast_, csh_); } }
                 __syncthreads();
                 if (c.tid == 0) { unsigned sp_ = 0u; while (__hip_atomic_load(scnt_, __ATOMIC_RELAXED, __HIP_MEMORY_SCOPE_AGENT) < (unsigned)(BATCH * S5G)) { __builtin_amdgcn_s_sleep(4); if (++sp_ > (1u << 22)) break; }
                     __builtin_amdgcn_fence(__ATOMIC_ACQUIRE, "agent"); asm volatile("s_waitcnt vmcnt(0)" ::: "memory"); }
                 __syncthreads();
                 for (int rep_ = 0; rep_ < REP_S5Y; ++rep_) { f_s5_y(c, WSP(bf16_t, WS_U), WSP(bf16_t, WS_S5X), WSP(bf16_t, WS_S5MT) + (size_t)l * 32 * S5_MT_ELEMS, IN(17) + l * 512, WSP(bf16_t, WS_YG)); } } PH_END
        PH_BEGIN GEMM(EpiGluF, WSP(bf16_t, WS_YG), WSP(bf16_t, WS_WGLU) + (size_t)l * 512 * 512, 512, 512, WSP(bf16_t, WS_YG), IN(19) + l * 512, WSP(bf16_t, WS_ATT) + 512, 1024, 0);
                 if (l == 0) MOE_SLICE(0, MOE_S0); else MOE_SLICE(MOE_S1, MOE_S2); PH_END
        PH_BEGIN GEMM(EpiMixFused, WSP(bf16_t, WS_ATT), WSP(bf16_t, WS_WPA) + (size_t)l * 1024 * 1024, 1024, 1024, WSP(bf16_t, WS_GA), WSP(bf16_t, WS_GB), WSP(bf16_t, WS_MIX)); PH_END
        PH_BEGIN if (l == 0) { GEMM(EpiResidF<false COMMA false>, WSP(bf16_t, WS_MIX), WSP(bf16_t, WS_WOUT), D, D, IN(0), nullptr, WSP(bf16_t, WS_XB), WSP(u64, WS_XSSF), nullptr); }
                 else { GEMM(EpiResidF<true COMMA true>, WSP(bf16_t, WS_MIX), WSP(bf16_t, WS_WOUT) + (size_t)D * D, D, D, nullptr, X, WSP(bf16_t, WS_XB), WSP(u64, WS_XSSF) + T, WSP(unsigned char, WS_XB8)); } PH_END
        if (l == 0) {
            PH_BEGIN STAGGER(STAG_FFN1); for (int rep_ = 0; rep_ < REP_FFN1; ++rep_) { GEMM(EpiSwigluF, WSP(bf16_t, WS_XB), WSP(bf16_t, WS_WFGU), 2 * FFD, D, WSP(bf16_t, WS_HD), WSP(u64, WS_XSSF), nullptr, FFD, 22, 1.f); } MOE_SLICE(MOE_S0, MOE_S1); PH_END
            PH_BEGIN GEMM(EpiResidF<true COMMA false COMMA true COMMA true>, WSP(bf16_t, WS_HD), WSP(bf16_t, WS_WFD), D, FFD, nullptr, nullptr, WSP(bf16_t, WS_XB), WSP(u64, WS_XSSM) + T, WSP(unsigned char, WS_XB8)); PH_END
        } else {
            PH_BEGIN for (int rep_ = 0; rep_ < REP_ROUTE1; ++rep_) { __syncthreads(); f_route1(c, X, IN(23) + l * D, IN(27), IN(28), WSP(int, WS_TOPE), WSP(float, WS_TOPW), WSP(int, WS_RANK), WSP(int, WS_CNT), WSP(int, WS_ROWTOK), WSP(float, WS_RROW));
 } PH_END
            PH_BEGIN for (int rep_ = 0; rep_ < REP_ROUTE2; ++rep_) { f_route2(c, WSP(int, WS_TOPE), WSP(int, WS_RANK), WSP(int, WS_CNT), WSP(int, WS_POS), WSP(int, WS_ROWTOK), WSP(int, WS_TILEE), WSP(int, WS_NTILES), WSP(u64, WS_XSSF) + T, WSP(float, WS_RROW)); } PH_END
            PH_BEGIN { const int ntl = __builtin_amdgcn_readfirstlane(WSP(int, WS_NTILES)[0]);
                pg8::Gemm g_{(const pg8::bf16_t*)WSP(bf16_t, WS_XB8), (const pg8::bf16_t*)WSP(bf16_t, WS_WMGU), ntl * 256, 2 * FFE, D / 2, D / 2};     LAS int* lte_ = (LAS int*)(c.lds + pg8::STAGE_BYTES); for (int i_ = c.tid; i_ < RCAP / 256; i_ += NTHREADS) lte_[i_] = WSP(int, WS_TILEE)[i_]; __syncthreads();
                pg8::MoeOrder S_; S_.init(ntl * 256, 2 * FFE, c.G, bid); S_.tile_e = lte_; S_.per_e = 2 * FFE / 256;
                EpiSwigluF8 E_{WSP(bf16_t, WS_H1), nullptr, WSP(float, WS_RROW), FFE, 2 * FFE / 256, 1.f};
                STAGGER(STAG_GEMM1); int tid_ = c.tid; asm volatile("" : "+v"(tid_)); for (int rep_ = 0; rep_ < REP_GEMM1; ++rep_) pg8::gemm_phase_gather<EpiSwigluF8, pg8::MoeOrder, true>(c.lds, g_, WSP(int, WS_ROWTOK), S_, E_, tid_); } PH_END
            PH_BEGIN { const int ntl = __builtin_amdgcn_readfirstlane(WSP(int, WS_NTILES)[0]); const int nfull = ntl < 128 ? ntl : 128;
                { pg8::Gemm g_{(const pg8::bf16_t*)WSP(bf16_t, WS_H1), (const pg8::bf16_t*)WSP(bf16_t, WS_WMD), nfull * 256, D, FFE / 2, FFE / 2}; LAS int* lte_ = (LAS int*)(c.lds + pg8::STAGE_BYTES); for (int i_ = c.tid; i_ < RCAP / 256; i_ += NTHREADS) lte_[i_] = WSP(int, WS_TILEE)[i_]; __syncthreads();
                  pg8::MoeOrder S_; S_.init(nfull * 256, D, c.G, bid); S_.tile_e = lte_; S_.per_e = D / 256;
                  EpiStoreBf16 E_{WSP(bf16_t, WS_YB), D, D / 256};
                  int tid_ = c.tid; asm volatile("" : "+v"(tid_)); for (int rep_ = 0; rep_ < REP_GEMM2; ++rep_) pg8::gemm_phase<EpiStoreBf16, pg8::MoeOrder, true, true, true>(c.lds, g_, S_, E_, tid_); }
                __syncthreads();
                if (ntl > nfull) {
                    if ((ntl - nfull) * (D / 256) * TAIL_NSL7 <= c.G) {
                        pg8::Gemm g_{(const pg8::bf16_t*)WSP(bf16_t, WS_H1), (const pg8::bf16_t*)WSP(bf16_t, WS_WMD), ntl * 256, D, FFE / 2 / TAIL_NSL7, FFE / 2};
                        EpiSplitKAll E_{WSP(bf16_t, WS_YB), WSP(float, WS_SLAB), WSP(unsigned, WS_TICKETS), D, D / 256, nfull, TAIL_NSL7, FFE / TAIL_NSL7};
                        pg8::TailOrder S_{WSP(int, WS_TILEE), nfull, ntl - nfull, D / 256, TAIL_NSL7, FFE / TAIL_NSL7, bid};
                        int tid_ = c.tid; asm volatile("" : "+v"(tid_)); pg8::gemm_phase<EpiSplitKAll, pg8::TailOrder, false, true, true>(c.lds, g_, S_, E_, tid_); __syncthreads();
                    } else {
                    pg8::Gemm g_{(const pg8::bf16_t*)WSP(bf16_t, WS_H1), (const pg8::bf16_t*)WSP(bf16_t, WS_WMD), ntl * 256, D, FFE / 2 / TAIL_NSL, FFE / 2};
                    EpiSplitK E_{WSP(bf16_t, WS_YB), WSP(float, WS_XB), WSP(unsigned, WS_TICKETS), D, D / 256, nfull, TAIL_NSL, FFE / TAIL_NSL};
                    for (int base_ = 0; base_ < (ntl - nfull) * (D / 256) * TAIL_NSL; base_ += c.G) {
                        pg8::TailOrder S_{WSP(int, WS_TILEE), nfull, ntl - nfull, D / 256, TAIL_NSL, FFE / TAIL_NSL, bid + base_};
                        int tid_ = c.wave * 64 + hw_lane(); asm volatile("" : "+v"(tid_)); pg8::gemm_phase<EpiSplitK, pg8::TailOrder, false, true, true>(c.lds, g_, S_, E_, tid_); __syncthreads(); } } } } PH_END
            PH_BEGIN f_combine(c, X, WSP(bf16_t, WS_YB), WSP(int, WS_POS), WSP(float, WS_TOPW)); PH_END
        }

    }
    if ((PROBE_MASK != 0ull || PROBE_BAR) && blockIdx.x == 0 && (c0.wave == 0 && hw_lane() == 0)) { const unsigned long long t0_ = __builtin_amdgcn_s_memrealtime(); const unsigned long long acc_ = PRB[0]; while (__builtin_amdgcn_s_memrealtime() - t0_ < acc_) __builtin_amdgcn_s_sleep(8); }
}

extern "C" void kernel_launch(void* const* d_in, const int* in_sizes, int n_in, void* d_out, int out_size, void* d_ws, size_t ws_size, hipStream_t stream) {
    static int grid = 0;
    if (grid == 0) {
        if (n_in != 32 || out_size != T * D || ws_size < WS_END) { fprintf(stderr, "kernel_launch: unexpected shapes (n_in %d out %d ws %zu)\n", n_in, out_size, ws_size); grid = -1; return; }
        int dev = 0, cus = 0, per_cu = 0;
        if (hipGetDevice(&dev) != hipSuccess || hipDeviceGetAttribute(&cus, hipDeviceAttributeMultiprocessorCount, dev) != hipSuccess) { grid = -1; return; }
        if (hipFuncSetAttribute((const void*)mk_fwd, hipFuncAttributeMaxDynamicSharedMemorySize, LDS_BYTES) != hipSuccess) { fprintf(stderr, "kernel_launch: hipFuncSetAttribute failed\n"); grid = -1; return; }
        if (hipOccupancyMaxActiveBlocksPerMultiprocessor(&per_cu, (const void*)mk_fwd, NTHREADS, LDS_BYTES) != hipSuccess || per_cu < 1) { fprintf(stderr, "kernel_launch: occupancy query says %d\n", per_cu); }
        (void)hipGetLastError();
        grid = cus;
    }
    if (grid < 0) return;
    (void)hipMemsetAsync((char*)d_ws + WS_CTL, 0, CTL_ZERO_BYTES, stream);
    Args a{};
    for (int i = 0; i < 32; ++i) a.in[i] = (const float*)d_in[i];
    a.out = (float*)d_out; a.ws = (unsigned char*)d_ws; a.ph_lo = 0; a.ph_hi = 1000;
    hipLaunchKernelGGL(mk_fwd, dim3(grid), dim3(NTHREADS), LDS_BYTES, stream, a);
}
```

```cpp
#include <hip/hip_runtime.h>
#ifndef PROBE_K2
#define PROBE_K2 0
#endif
#include <cstdio>
#include <cstdint>

typedef unsigned short bf16_t;
typedef short bf16x8 __attribute__((ext_vector_type(8)));
typedef float f32x4 __attribute__((ext_vector_type(4)));
typedef unsigned u32x4 __attribute__((ext_vector_type(4)));
#define LAS __attribute__((address_space(3)))
#define GAS __attribute__((address_space(1)))

constexpr int D = 1024, BATCH = 2, SEQ = 8192, T = BATCH * SEQ, DEPTH = 2;
constexpr int NH = 8, QKD = 96, QLR = 256, KVLR = 128;
constexpr int S5G = 32;
constexpr int FFD = 2816, NE = 8, FFE = 3584, INC = 2976;
constexpr int RCAP = 34816;
constexpr float EPS = 1e-6f;
constexpr float QSCALE = 0.14724444602590306f;
constexpr int NWAVES = 8, NTHREADS = 512;
constexpr int LDS_BYTES = 147456;
constexpr int LDSCTL_OFF = 143360;
constexpr size_t MiB = 1u << 20;

__device__ __forceinline__ unsigned f2bf(float f) { unsigned u = __builtin_bit_cast(unsigned, f); return (u + 0x7fffu + ((u >> 16) & 1u)) >> 16; }
__device__ __forceinline__ float bf2f(unsigned h) { return __builtin_bit_cast(float, h << 16); }
__device__ __forceinline__ float bflo(unsigned w) { return __builtin_bit_cast(float, w << 16); }
__device__ __forceinline__ float bfhi(unsigned w) { return __builtin_bit_cast(float, w & 0xffff0000u); }
__device__ __forceinline__ int hw_lane() { int l; asm volatile("v_mbcnt_lo_u32_b32 %0, -1, 0\n\tv_mbcnt_hi_u32_b32 %0, -1, %0" : "=v"(l)); return l; }
__device__ __forceinline__ float bperm(float v, int lane_src) { return __builtin_bit_cast(float, __builtin_amdgcn_ds_bpermute(lane_src << 2, __builtin_bit_cast(int, v))); }
template <int M> __device__ __forceinline__ float xadd(float v, int lane) { return v + bperm(v, lane ^ M); }
__device__ __forceinline__ float wave_sum(float v, int lane) { v = xadd<1>(v, lane); v = xadd<2>(v, lane); v = xadd<4>(v, lane); v = xadd<8>(v, lane); v = xadd<16>(v, lane); return xadd<32>(v, lane); }
__device__ __forceinline__ float sigmoidf_(float v) { return __builtin_amdgcn_rcpf(1.f + __expf(-v)); }
__device__ __forceinline__ float sigmoid_fast(float v) { return __builtin_amdgcn_rcpf(1.f + __expf(-v)); }
__device__ __forceinline__ float siluf_(float v) { return v * __builtin_amdgcn_rcpf(1.f + __expf(-v)); }
__device__ __forceinline__ float gelu_tanh(float v) {
    const float z = 0.7978845608028654f * (v + 0.044715f * v * v * v);
    const float e = __expf(2.f * z);
    const float th = 1.f - 2.f * __builtin_amdgcn_rcpf(e + 1.f);
    return 0.5f * v * (1.f + th);
}
__device__ __forceinline__ void sincos_rev(double rev, float& s, float& c) {
    const double fr = rev - floor(rev);
    const float f = (float)fr;
    s = __builtin_amdgcn_sinf(f); c = __builtin_amdgcn_cosf(f);
}
__constant__ double c_invrev[16] = {0.15915494309189535, 0.08949940160889101, 0.050329212104487035, 0.0283021958306234, 0.015915494309189534, 0.008949940160889102,
    0.005032921210448704, 0.00283021958306234, 0.0015915494309189536, 0.0008949940160889102, 0.0005032921210448703, 0.00028302195830623395, 0.00015915494309189535,
    8.949940160889102e-05, 5.0329212104487035e-05, 2.8302195830623396e-05};

#define XB_TMO      128
#define XB_XCNT(j)  (256  + 64 * (j))
#define XB_XSUB(j)  (1280 + 64 * (j))
#define XB_XGEN(j)  (2304 + 64 * (j))
#define XB_TOP      3328
#define XB_TOPGEN   3392
#define XCD_BAR_WORDS 3456
#define XB_SPIN_CAP (1u << 18)

__device__ __forceinline__ unsigned xb_ld(unsigned* p)              { return __hip_atomic_load(p, __ATOMIC_RELAXED, __HIP_MEMORY_SCOPE_AGENT); }
__device__ __forceinline__ unsigned xb_add(unsigned* p, unsigned v) { return __hip_atomic_fetch_add(p, v, __ATOMIC_RELAXED, __HIP_MEMORY_SCOPE_AGENT); }
__device__ __forceinline__ unsigned xb_xcc_id() { return (unsigned)__builtin_amdgcn_s_getreg((3 << 11) | 20) & 0xFu; }
#define XB_SPIN(cond, bar) do { unsigned _sp = 0; while (cond) { __builtin_amdgcn_s_sleep(1); \
    if ((++_sp & 255u) == 0u) { if (xb_ld(&(bar)[XB_TMO])) break; if (_sp > XB_SPIN_CAP) { atomicAdd(&(bar)[XB_TMO], 1u); break; } } } } while (0)

struct XcdBarrier {
    unsigned* bar; unsigned x; unsigned w;
    volatile LAS unsigned* st;
};

__device__ __forceinline__ XcdBarrier xcd_barrier_post(unsigned* bar, volatile LAS unsigned* st) {
    XcdBarrier b; b.bar = bar; b.x = xb_xcc_id(); b.st = st;
    if (threadIdx.x == 0) (void)xb_add(&bar[XB_XCNT(b.x)], 1u);
    return b;
}
__device__ __forceinline__ void xcd_barrier_complete(unsigned* bar, unsigned x, unsigned& nloc, unsigned& nx) {
    const unsigned G = gridDim.x * gridDim.y * gridDim.z;
    unsigned sum, cnt, mine, sp = 0u;
    for (;;) {
        sum = 0u; cnt = 0u; mine = 0u;
#pragma unroll
        for (unsigned j = 0; j < 16; ++j) { const unsigned c = xb_ld(&bar[XB_XCNT(j)]); sum += c; cnt += (c > 0u) ? 1u : 0u; mine = (j == x) ? c : mine; }
        if (sum == G) break;
        __builtin_amdgcn_s_sleep(1);
        if ((++sp & 255u) == 0u) { if (xb_ld(&bar[XB_TMO])) break; if (sp > XB_SPIN_CAP) { atomicAdd(&bar[XB_TMO], 1u); break; } }
    }
    nloc = mine > 0u ? mine : 1u; nx = cnt > 0u ? cnt : 1u;
}

__device__ __forceinline__ void xcd_barrier(const XcdBarrier& b) {
    asm volatile("s_waitcnt vmcnt(0)" ::: "memory");
    __syncthreads();
    if (b.w == 0u && hw_lane() == 0) {
        unsigned* bar = b.bar; asm volatile("" : "+s"(bar));
        __builtin_amdgcn_s_waitcnt(0);
        unsigned nloc = b.st[0], nx = b.st[1];
        if (nloc == 0u) { xcd_barrier_complete(bar, b.x, nloc, nx); b.st[0] = nloc; b.st[1] = nx; }
        const unsigned old = xb_add(&bar[XB_XSUB(b.x)], 1u);
        const unsigned gen = old / nloc;
        if (old + 1u == (gen + 1u) * nloc) {
            __builtin_amdgcn_fence(__ATOMIC_RELEASE, "agent");
            asm volatile("s_waitcnt vmcnt(0)" ::: "memory");
            const unsigned og = xb_add(&bar[XB_TOP], 1u);
            const unsigned tg = og / nx;
            if (og + 1u == (tg + 1u) * nx) xb_add(&bar[XB_TOPGEN], 1u);
            else XB_SPIN(xb_ld(&bar[XB_TOPGEN]) == tg, bar);
            __builtin_amdgcn_fence(__ATOMIC_ACQUIRE, "agent");
            xb_add(&bar[XB_XGEN(b.x)], 1u);
            asm volatile("s_waitcnt vmcnt(0)" ::: "memory");
        } else {
            XB_SPIN(xb_ld(&bar[XB_XGEN(b.x)]) == gen, bar);
            __builtin_amdgcn_fence(__ATOMIC_ACQUIRE, "agent");
            asm volatile("s_waitcnt vmcnt(0)" ::: "memory");
        }
    }
    __syncthreads();
}
struct Ctx { int tid, lane, wave, G, gw, NGW; LAS unsigned char* lds; };
namespace pg8 {
#define PG8_LAS __attribute__((address_space(3)))
typedef unsigned short bf16_t;
typedef short bf16x8 __attribute__((ext_vector_type(8)));
typedef float f32x4 __attribute__((ext_vector_type(4)));
typedef unsigned u32x4 __attribute__((ext_vector_type(4)));
typedef int i32x4v __attribute__((ext_vector_type(4)));
typedef int i32x8v __attribute__((ext_vector_type(8)));
__device__ __forceinline__ i32x8v cat8(const bf16x8 a, const bf16x8 b) { return __builtin_shufflevector(__builtin_bit_cast(i32x4v, a), __builtin_bit_cast(i32x4v, b), 0, 1, 2, 3, 4, 5, 6, 7); }
constexpr int BM = 256, BK = 64, HALF = 128, HTB = HALF * BK * 2  , STAGE_BYTES = 8 * HTB, NXCD = 8, WGM = 8;

__host__ __device__ __forceinline__ int lds_byte(int r, int c) { const int st = (r >> 4) * 2 + (c >> 5), rr = r & 15, cc = c & 31, ob = rr * 64 + cc * 2; return st * 1024 + (ob ^ (((ob >> 9) & 1) << 5)); }
__host__ __device__ __forceinline__ void stage_rc(int b, int& R, int& C) { const int st = b / 1024, sb = b % 1024, swz = sb ^ (((sb >> 9) & 1) << 5); R = (st >> 1) * 16 + swz / 64; C = (st & 1) * 32 + (swz % 64) / 2; }
__host__ __device__ __forceinline__ int perm32(int rho) { const int n = rho >> 4, i = rho & 15; return 8 * (i >> 2) + 4 * n + (i & 3); }

struct Unit { int pm, pn; int koff = 0; unsigned side = 0; };
struct Gemm { const bf16_t* A; const bf16_t* Bt; int M, N, K, Kp; };

struct StaticOrder {
    int nM, nN, nwg, G, c;
    __host__ __device__ void init(int M, int N, int G_, int c_) { nM = M / BM; nN = N / BM; nwg = nM * nN; G = G_; c = c_; }
    __host__ __device__ bool next(int i, Unit& u) const {
        const long L = (long)i * G + c; if (L >= nwg) return false;
        int wgid = (int)L; { const int q = nwg / NXCD, r = nwg % NXCD, xcd = wgid % NXCD, off = wgid / NXCD; wgid = (xcd < r ? xcd * (q + 1) : r * (q + 1) + (xcd - r) * q) + off; }
        const int nig = WGM * nN, gid = wgid / nig, fm = gid * WGM, gsz = (nM - fm) < WGM ? (nM - fm) : WGM;
        u.pm = fm + ((wgid % nig) % gsz); u.pn = (wgid % nig) / gsz; return true;
    }
    __device__ __forceinline__ void a_ready(const Unit&) const {}
    __device__ __forceinline__ void done(const Unit&) const {}
};
typedef float f32x2 __attribute__((ext_vector_type(2)));
typedef __bf16 bf16x2_t __attribute__((ext_vector_type(2)));
__device__ __forceinline__ unsigned cvt_pk_bf16(float lo, float hi) { const f32x2 v = {lo, hi}; return __builtin_bit_cast(unsigned, __builtin_convertvector(v, bf16x2_t)); }
__device__ __forceinline__ void glds16(const void* base, unsigned voff, unsigned lds_addr) {
    asm volatile("s_mov_b32 m0, %2\n\ts_nop 0\n\tglobal_load_lds_dwordx4 %0, %1" :: "v"(voff), "s"(base), "s"(lds_addr) : "memory", "m0");
}
template <class E, class = void> struct EpiSide { static constexpr bool v = false; };
template <class E> struct EpiSide<E, decltype((void)E::SIDE)> { static constexpr bool v = E::SIDE; };
constexpr int SIDE_OFF = 8 * 128 * 64 * 2 + 1024, SIDE_BYTES = 4096;
template <class Epi, class Sched, bool ALIGN_EPI = false, bool SP2 = false, bool F8 = false>
__device__ __forceinline__ void gemm_phase(PG8_LAS unsigned char* lds, const Gemm g, const Sched& S, const Epi& E, const int tid) {
    const int wid = __builtin_amdgcn_readfirstlane(tid >> 6), lane = tid & 63, wr = wid >> 2, wc = wid & 3, fr = lane & 15, fq = lane >> 4;
    const int K = g.Kp; int nt = g.K / BK; if constexpr (F8) asm volatile("" : "+s"(nt));
    unsigned voffA[2], voffB[2];
#pragma unroll
    for (int i = 0; i < 2; ++i) { int R, C; stage_rc(tid * 16 + i * 8192, R, C); const int Rb = Epi::PERM ? ((R & ~31) + perm32(R & 31)) : R;
        voffA[i] = (unsigned)(R * K + C) * 2u; voffB[i] = (unsigned)(Rb * K + C) * 2u; }
    const size_t kstep = (size_t)(BK * 2);
    const size_t hstep = (size_t)HALF * K * 2;
    const size_t tstep = 2 * hstep;
    const unsigned ldsw = (unsigned)wid * 1024u;
    const unsigned ldsb = (unsigned)(size_t)lds + ldsw;
    const int aoff = lds_byte(wr * 64 + fr, fq * 8), boff = lds_byte(wc * 32 + fr, fq * 8);
#define PG8_SA(b, h) (((b) * 2 + (h)) * HTB)
#define PG8_SB(b, h) ((4 + (b) * 2 + (h)) * HTB)
#define PG8_STAGE(bufoff, gbase, voff) do { _Pragma("unroll") for (int _i = 0; _i < 2; ++_i) glds16((gbase), (voff)[_i], ldsb + (unsigned)((bufoff) + _i * 8192)); } while (0)
#define PG8_LDA(dst, b, h) do { _Pragma("unroll") for (int m = 0; m < 4; ++m) _Pragma("unroll") for (int k = 0; k < 2; ++k) dst[m][k] = *(const PG8_LAS bf16x8*)(lds + PG8_SA(b, h) + aoff + m * 2048 + k * 1024); } while (0)
#define PG8_LDB(dst, b, h) do { _Pragma("unroll") for (int n = 0; n < 2; ++n) _Pragma("unroll") for (int k = 0; k < 2; ++k) dst[n][k] = *(const PG8_LAS bf16x8*)(lds + PG8_SB(b, h) + boff + n * 2048 + k * 1024); } while (0)
#define PG8_MMA(ai, bj, At, Bt) do { __builtin_amdgcn_s_setprio(1); _Pragma("unroll") for (int m = 0; m < 4; ++m) _Pragma("unroll") for (int n = 0; n < 2; ++n) { \
        if constexpr (F8) acc[ai][bj][m][n] = __builtin_amdgcn_mfma_scale_f32_16x16x128_f8f6f4(cat8(Bt[n][0], Bt[n][1]), cat8(At[m][0], At[m][1]), acc[ai][bj][m][n], 0, 0, 0, 0, 0, 0); \
        else { _Pragma("unroll") for (int k = 0; k < 2; ++k) acc[ai][bj][m][n] = __builtin_amdgcn_mfma_f32_16x16x32_bf16(Bt[n][k], At[m][k], acc[ai][bj][m][n], 0, 0, 0); } } __builtin_amdgcn_s_setprio(0); } while (0)
#define PG8_WAIT_V(n) asm volatile("s_waitcnt vmcnt(" #n ")" ::: "memory")
#define PG8_WAIT_L(n) asm volatile("s_waitcnt lgkmcnt(" #n ")" ::: "memory")
#define PG8_BAR __builtin_amdgcn_s_barrier()
#define PG8_SCHED __builtin_amdgcn_sched_barrier(0)
    Unit cur, nxt; int ui = 0;
    if (!S.next(0, cur)) return;
    f32x4 acc[2][2][4][2];
#pragma unroll
    for (int a = 0; a < 2; ++a)
#pragma unroll
        for (int b = 0; b < 2; ++b)
#pragma unroll
            for (int m = 0; m < 4; ++m)
#pragma unroll
                for (int n = 0; n < 2; ++n) acc[a][b][m][n] = (f32x4){0.f, 0.f, 0.f, 0.f};
    bf16x8 At[4][2], B0[2][2], B1[2][2];
    const char* cA = (const char*)g.A + (size_t)cur.pm * tstep + cur.koff; const char* cB = (const char*)g.Bt + (size_t)cur.pn * tstep + cur.koff;
    if constexpr (EpiSide<Epi>::v) { cur.side = (unsigned)(size_t)lds + SIDE_OFF; E.side_issue(cur, wid); }
    S.a_ready(cur);
    if constexpr (SP2) {
        PG8_STAGE(PG8_SB(0, 0), cB, voffB); PG8_STAGE(PG8_SB(0, 1), cB + hstep, voffB); PG8_STAGE(PG8_SA(0, 0), cA, voffA); PG8_STAGE(PG8_SA(0, 1), cA + hstep, voffA);
        if (wr == 1) PG8_BAR;
        PG8_WAIT_V(2); PG8_BAR;
        PG8_STAGE(PG8_SB(1, 0), cB + kstep, voffB); PG8_STAGE(PG8_SA(1, 0), cA + kstep, voffA); PG8_STAGE(PG8_SB(1, 1), cB + hstep + kstep, voffB);
        PG8_WAIT_V(6); PG8_BAR;
    } else {
        PG8_STAGE(PG8_SB(0, 0), cB, voffB); PG8_STAGE(PG8_SA(0, 0), cA, voffA); PG8_STAGE(PG8_SB(0, 1), cB + hstep, voffB); PG8_STAGE(PG8_SA(0, 1), cA + hstep, voffA);
        if (wr == 1) PG8_BAR;
        PG8_WAIT_V(4); PG8_BAR;
        PG8_STAGE(PG8_SB(1, 0), cB + kstep, voffB); PG8_STAGE(PG8_SA(1, 0), cA + kstep, voffA); PG8_STAGE(PG8_SB(1, 1), cB + hstep + kstep, voffB);
        PG8_WAIT_V(6); PG8_BAR;
    }
    for (;;) {
        const bool has_next = S.next(ui + 1, nxt);
        const char* nA = has_next ? (const char*)g.A + (size_t)nxt.pm * tstep + nxt.koff : cA; const char* nB = has_next ? (const char*)g.Bt + (size_t)nxt.pn * tstep + nxt.koff : cB;
        for (int t = 0; t < nt; t += 2) {
            if constexpr (Epi::MID) { if (2 * t == nt) E.mid(acc, cur, wr, wc, fr, fq); }
            const bool last = (t == nt - 2);
            const char* a1 = cA + (size_t)(t + 1) * kstep;
            const char* a2 = last ? nA : cA + (size_t)(t + 2) * kstep; const char* b2 = last ? nB : cB + (size_t)(t + 2) * kstep;
            const char* a3 = a2 + kstep; const char* b3 = b2 + kstep;
            if (last && has_next) S.a_ready(nxt);
            if constexpr (SP2) {
            PG8_LDB(B0, 0, 0); PG8_LDB(B1, 0, 1); PG8_SCHED; PG8_LDA(At, 0, 0); PG8_STAGE(PG8_SA(1, 1), a1 + hstep, voffA);
            PG8_WAIT_V(8); PG8_WAIT_L(0); PG8_BAR; PG8_MMA(0, 0, At, B0); PG8_MMA(0, 1, At, B1); PG8_BAR; PG8_SCHED;
            PG8_LDA(At, 0, 1); PG8_STAGE(PG8_SB(0, 0), b2, voffB); PG8_STAGE(PG8_SB(0, 1), b2 + hstep, voffB); PG8_STAGE(PG8_SA(0, 0), a2, voffA);
            PG8_WAIT_V(8); PG8_WAIT_L(0); PG8_BAR; PG8_MMA(1, 0, At, B0); PG8_MMA(1, 1, At, B1); PG8_BAR; PG8_SCHED;
            PG8_LDB(B0, 1, 0); PG8_LDB(B1, 1, 1); PG8_SCHED; PG8_LDA(At, 1, 0); PG8_STAGE(PG8_SA(0, 1), a2 + hstep, voffA);
            PG8_WAIT_V(8); PG8_WAIT_L(0); PG8_BAR; PG8_MMA(0, 0, At, B0); PG8_MMA(0, 1, At, B1); PG8_BAR; PG8_SCHED;
            PG8_LDA(At, 1, 1); PG8_STAGE(PG8_SB(1, 0), b3, voffB); PG8_STAGE(PG8_SB(1, 1), b3 + hstep, voffB); PG8_STAGE(PG8_SA(1, 0), a3, voffA);
            PG8_WAIT_V(8); PG8_WAIT_L(0); PG8_BAR; PG8_MMA(1, 0, At, B0); PG8_MMA(1, 1, At, B1); PG8_BAR; PG8_SCHED;
            } else {
            PG8_LDB(B0, 0, 0); PG8_SCHED; PG8_LDA(At, 0, 0); PG8_STAGE(PG8_SA(1, 1), a1 + hstep, voffA);
            PG8_WAIT_L(8); PG8_BAR; PG8_WAIT_L(0); PG8_MMA(0, 0, At, B0); PG8_BAR; PG8_SCHED;
            PG8_LDB(B1, 0, 1); PG8_STAGE(PG8_SB(0, 0), b2, voffB);
            PG8_BAR; PG8_WAIT_L(0); PG8_MMA(0, 1, At, B1); PG8_BAR;
            PG8_LDA(At, 0, 1); PG8_STAGE(PG8_SA(0, 0), a2, voffA);
            PG8_BAR; PG8_WAIT_L(0); PG8_MMA(1, 0, At, B0); PG8_BAR; PG8_SCHED;
            PG8_STAGE(PG8_SB(0, 1), b2 + hstep, voffB);
            PG8_WAIT_V(6); PG8_BAR; PG8_MMA(1, 1, At, B1); PG8_BAR;
            PG8_LDB(B0, 1, 0); PG8_SCHED; PG8_LDA(At, 1, 0); PG8_STAGE(PG8_SA(0, 1), a2 + hstep, voffA);
            PG8_WAIT_L(8); PG8_BAR; PG8_WAIT_L(0); PG8_MMA(0, 0, At, B0); PG8_BAR; PG8_SCHED;
            PG8_LDB(B1, 1, 1); PG8_STAGE(PG8_SB(1, 0), b3, voffB);
            PG8_BAR; PG8_WAIT_L(0); PG8_MMA(0, 1, At, B1); PG8_BAR;
            PG8_LDA(At, 1, 1); PG8_STAGE(PG8_SA(1, 0), a3, voffA);
            PG8_BAR; PG8_WAIT_L(0); PG8_MMA(1, 0, At, B0); PG8_BAR; PG8_SCHED;
            PG8_STAGE(PG8_SB(1, 1), b3 + hstep, voffB);
            PG8_WAIT_V(6); PG8_BAR; PG8_MMA(1, 1, At, B1); PG8_BAR;
            }
        }
        if constexpr (ALIGN_EPI) { if (wr == 0) PG8_BAR; }
        if constexpr (!Epi::AFTER_DRAIN) { E(acc, cur, wr, wc, fr, fq); S.done(cur); }
        if (!has_next) break;
#pragma unroll
        for (int a = 0; a < 2; ++a)
#pragma unroll
            for (int b = 0; b < 2; ++b)
#pragma unroll
                for (int m = 0; m < 4; ++m)
#pragma unroll
                    for (int n = 0; n < 2; ++n) acc[a][b][m][n] = (f32x4){0.f, 0.f, 0.f, 0.f};
        cur = nxt; cA = nA; cB = nB; ++ui;
        if constexpr (EpiSide<Epi>::v) { cur.side = (unsigned)(size_t)lds + SIDE_OFF + (ui & 1) * SIDE_BYTES; E.side_issue(cur, wid); }
        if constexpr (ALIGN_EPI) { if (wr == 1) PG8_BAR; }
    }
    PG8_WAIT_V(0);
    if constexpr (!ALIGN_EPI) { if (wr == 0) PG8_BAR; }
    PG8_BAR;
    if constexpr (Epi::AFTER_DRAIN) { E.fused(acc, cur, wr, wc, fr, fq, lds, wid, lane); S.done(cur); }
#undef PG8_SA
#undef PG8_SB
#undef PG8_STAGE
#undef PG8_LDA
#undef PG8_LDB
#undef PG8_MMA
#undef PG8_WAIT_V
#undef PG8_WAIT_L
#undef PG8_BAR
#undef PG8_SCHED
}
}
using pg8::cvt_pk_bf16;
__device__ __forceinline__ u32x4 pack8(const f32x4 a, const f32x4 b) { u32x4 w; w.x = cvt_pk_bf16(a[0], a[1]); w.y = cvt_pk_bf16(a[2], a[3]); w.z = cvt_pk_bf16(b[0], b[1]); w.w = cvt_pk_bf16(b[2], b[3]); return w; }
__device__ __forceinline__ void unpack8(const u32x4 w, f32x4& a, f32x4& b) { a = (f32x4){bflo(w.x), bfhi(w.x), bflo(w.y), bfhi(w.y)}; b = (f32x4){bflo(w.z), bfhi(w.z), bflo(w.w), bfhi(w.w)}; }
constexpr float MOE_WGU_SCALE = 64.f, MOE_WD_SCALE = 128.f;
__device__ __forceinline__ unsigned pk4_f8(float a, float b, float c, float d) { const int w = __builtin_amdgcn_cvt_pk_fp8_f32(a, b, 0, false); return (unsigned)__builtin_amdgcn_cvt_pk_fp8_f32(c, d, w, true); }
__device__ __forceinline__ uint2 pack8_f8(const f32x4 a, const f32x4 b) { return make_uint2(pk4_f8(a[0], a[1], a[2], a[3]), pk4_f8(b[0], b[1], b[2], b[3])); }
__device__ __forceinline__ f32x4 clamp_f8(const f32x4 v) { return (f32x4){__builtin_amdgcn_fmed3f(v[0], -448.f, 448.f), __builtin_amdgcn_fmed3f(v[1], -448.f, 448.f), __builtin_amdgcn_fmed3f(v[2], -448.f, 448.f), __builtin_amdgcn_fmed3f(v[3], -448.f, 448.f)}; }
__device__ __forceinline__ float sum4sq(const f32x4 v) { return (v[0] * v[0] + v[1] * v[1]) + (v[2] * v[2] + v[3] * v[3]); }
__device__ __forceinline__ f32x4 sig4(const f32x4 v) { return (f32x4){sigmoidf_(v[0]), sigmoidf_(v[1]), sigmoidf_(v[2]), sigmoidf_(v[3])}; }
__device__ __forceinline__ f32x4 sig4f(const f32x4 v) { return (f32x4){sigmoid_fast(v[0]), sigmoid_fast(v[1]), sigmoid_fast(v[2]), sigmoid_fast(v[3])}; }

constexpr int CONV_SCR_BYTES = 64 * 65 * 4;
__device__ __forceinline__ int inv32(int lam) { return 16 * ((lam >> 2) & 1) + 4 * (lam >> 3) + (lam & 3); }
__device__ __forceinline__ void conv_load(const float* __restrict__ W, int ldw, int Ksrc, int Nsrc, int k0, int n0, int lane, f32x4 (&v)[16]) {
    const int r4 = lane >> 4, c4 = lane & 15;
    const bool colok = (n0 + 4 * c4) < Nsrc;
#pragma unroll
    for (int i = 0; i < 16; ++i) { const int k = k0 + 4 * i + r4; v[i] = (f32x4){0.f, 0.f, 0.f, 0.f}; if (colok && k < Ksrc) v[i] = *(const f32x4*)(W + (size_t)k * ldw + n0 + 4 * c4); }
}
template <class DstRow, bool F8 = false>
__device__ __forceinline__ void conv_emit(const f32x4 (&v)[16], int Ksrc, int Nsrc, bf16_t* __restrict__ WT, int Kdst, const float* __restrict__ gain, LAS float* scr, int k0, int n0, int lane, const DstRow& dstrow, float scale = 1.f) {
    const int r4 = lane >> 4, c4 = lane & 15;
#pragma unroll
    for (int i = 0; i < 16; ++i)
#pragma unroll
        for (int j = 0; j < 4; ++j) scr[(4 * i + r4) * 65 + 4 * c4 + j] = v[i][j];
    asm volatile("s_waitcnt lgkmcnt(0)" ::: "memory");
    const int kc = lane & 7;
    f32x4 g0 = (f32x4){1.f, 1.f, 1.f, 1.f}, g1 = g0;
    if (gain && k0 < Ksrc) { g0 = *(const f32x4*)(gain + k0 + 8 * kc); g1 = *(const f32x4*)(gain + k0 + 8 * kc + 4); }
    if constexpr (F8) { g0 = g0 * scale; g1 = g1 * scale; }
#pragma unroll
    for (int it = 0; it < 8; ++it) { const int nn = (lane >> 3) + 8 * it; const LAS float* s = scr + (8 * kc) * 65 + nn;
        const int dr = (n0 + nn) < Nsrc ? dstrow(n0 + nn) : -1;
        if constexpr (F8) { if (dr >= 0) *(uint2*)((unsigned char*)WT + (size_t)dr * Kdst + k0 + 8 * kc) = make_uint2(pk4_f8(s[0 * 65] * g0[0], s[1 * 65] * g0[1], s[2 * 65] * g0[2], s[3 * 65] * g0[3]), pk4_f8(s[4 * 65] * g1[0], s[5 * 65] * g1[1], s[6 * 65] * g1[2], s[7 * 65] * g1[3])); }
        else { u32x4 o; o.x = cvt_pk_bf16(s[0 * 65] * g0[0], s[1 * 65] * g0[1]); o.y = cvt_pk_bf16(s[2 * 65] * g0[2], s[3 * 65] * g0[3]); o.z = cvt_pk_bf16(s[4 * 65] * g1[0], s[5 * 65] * g1[1]); o.w = cvt_pk_bf16(s[6 * 65] * g1[2], s[7 * 65] * g1[3]);
            if (dr >= 0) *(u32x4*)(WT + (size_t)dr * Kdst + k0 + 8 * kc) = o; } }
    asm volatile("s_waitcnt lgkmcnt(0)" ::: "memory");
}
template <class DstRow, bool F8 = false>
__device__ __forceinline__ void conv_tile(const float* __restrict__ W, int ldw, int Ksrc, int Nsrc, bf16_t* __restrict__ WT, int Kdst, const float* __restrict__ gain, LAS float* scr, int k0, int n0, int lane, const DstRow& dstrow, float scale = 1.f) {
    f32x4 v[16]; conv_load(W, ldw, Ksrc, Nsrc, k0, n0, lane, v); conv_emit<DstRow, F8>(v, Ksrc, Nsrc, WT, Kdst, gain, scr, k0, n0, lane, dstrow, scale);
}
struct ConvDist { int w, nw, off, lo = 0, hi = 0x7fffffff;
    __device__ __forceinline__ int first(int items) { const int f = w < 0 ? items : (w - off % nw + nw) % nw; off += items; return f; }
    __device__ __forceinline__ void range(int items, int& first, int& end) {
        const int a = lo - off > 0 ? lo - off : 0; end = hi - off < items ? (hi - off > 0 ? hi - off : 0) : items;
        if (w < 0 || a >= end) first = end; else first = a + (w - (off + a - lo) % nw + nw) % nw;
        off += items; } };
template <class Job>
__device__ __forceinline__ void conv_run(const Job& J, int items, int first, int stride, int lane, LAS float* scr) {
    int it = first; if (it >= items) return;
    f32x4 va[16], vb[16];
    J.load(it, lane, va);
    for (;;) {
        const int it2 = it + stride;
        if (it2 < items) J.load(it2, lane, vb);
        J.emit(it, lane, scr, va);
        if (it2 >= items) break;
        const int it3 = it2 + stride;
        if (it3 < items) J.load(it3, lane, va);
        J.emit(it2, lane, scr, vb);
        if (it3 >= items) break;
        it = it3;
    }
}
__device__ __forceinline__ int lcol(int rho) { return (rho & ~31) + pg8::perm32(rho & 31); }
struct DstPlain { __device__ __forceinline__ int operator()(int n) const { return (n & ~31) + inv32(n & 31); } };
struct DstGateUp { int half; __device__ __forceinline__ int operator()(int n) const { return 256 * (n >> 7) + 128 * half + (n & 96) + inv32(n & 31); } };
struct DstProj { __device__ __forceinline__ int operator()(int n) const { const int L = n < 416 ? n : n + 96; return (L & ~31) + inv32(L & 31); } };
template <bool F8> struct JobPlain { const float* W; int Ksrc, Nsrc; bf16_t* WT; int Kdst; const float* gain; float scale; int nN; int ldw;
    __device__ __forceinline__ void load(int it, int lane, f32x4 (&v)[16]) const { conv_load(W, ldw, Ksrc, Nsrc, 64 * (it / nN), 64 * (it % nN), lane, v); }
    __device__ __forceinline__ void emit(int it, int lane, LAS float* scr, const f32x4 (&v)[16]) const { conv_emit<DstPlain, F8>(v, Ksrc, Nsrc, WT, Kdst, gain, scr, 64 * (it / nN), 64 * (it % nN), lane, DstPlain{}, scale); } };
template <bool F8 = false>
__device__ __forceinline__ void conv_plain(const Ctx& c, ConvDist& cd, LAS float* scr, const float* W, int Ksrc, int Nsrc, bf16_t* WT, int Kdst, const float* gain, float scale = 1.f, int ldw = 0  ) {
    const int nK = Kdst / 64, nN = (Nsrc + 63) / 64; JobPlain<F8> J{W, Ksrc, Nsrc, WT, Kdst, gain, scale, nN, ldw ? ldw : Nsrc}; conv_run(J, nK * nN, cd.first(nK * nN), cd.nw, c.lane, scr);
}
template <bool F8> struct JobGateUp { const float* Wg; size_t dWu  ; int FF; bf16_t* WT; const float* gain; float scale; int nN, per;
    __device__ __forceinline__ void load(int it, int lane, f32x4 (&v)[16]) const { const int e = it / per, r = it % per, half = r & 1, kb = (r >> 1) / nN, nb = (r >> 1) % nN; conv_load((const float*)((const char*)Wg + (size_t)half * dWu) + (size_t)e * D * FF, FF, D, FF, 64 * kb, 64 * nb, lane, v); }
    __device__ __forceinline__ void emit(int it, int lane, LAS float* scr, const f32x4 (&v)[16]) const { const int e = it / per, r = it % per, half = r & 1, kb = (r >> 1) / nN, nb = (r >> 1) % nN;
        conv_emit<DstGateUp, F8>(v, D, FF, (bf16_t*)((unsigned char*)WT + (size_t)e * 2 * FF * D * (F8 ? 1 : 2)), D, gain, scr, 64 * kb, 64 * nb, lane, DstGateUp{half}, scale); } };
template <bool F8 = false>
__device__ __forceinline__ void conv_gateup(const Ctx& c, ConvDist& cd, LAS float* scr, const float* Wg, const float* Wu, int FF, bf16_t* WT, const float* gain, int ne, float scale = 1.f) {
    const int nK = D / 64, nN = FF / 64, per = nK * nN * 2; JobGateUp<F8> J{Wg, (size_t)((const char*)Wu - (const char*)Wg), FF, WT, gain, scale, nN, per}; int f_, e_; cd.range(per * ne, f_, e_); conv_run(J, e_, f_, cd.nw, c.lane, scr);
}
struct DstKV { __device__ __forceinline__ int operator()(int n) const { const int head = n >> 7, part = (n >> 6) & 1, d = n & 63; return 256 * (head >> 1) + 128 * (d >> 5) + 32 * (2 * (head & 1) + part) + inv32(d & 31); } };
__device__ __forceinline__ void conv_kv(const Ctx& c, ConvDist& cd, LAS float* scr, const float* W, bf16_t* WT, const float* gain) {
    const int nK = 256 / 64, nN = 1024 / 64, items = nK * nN;
    for (int it = cd.first(items); it < items; it += cd.nw) { const int kb = it / nN, nb = it % nN; conv_tile(W, 1024, KVLR, 1024, WT, 256, gain, scr, 64 * kb, 64 * nb, c.lane, DstKV{}); }
}
__device__ __forceinline__ void conv_plain_at(const Ctx& c, ConvDist& cd, LAS float* scr, const float* W, int Ksrc, int Nsrc, bf16_t* WT, int Kdst, int k_at) {
    const int nK = Ksrc / 64, nN = Nsrc / 64, items = nK * nN;
    for (int it = cd.first(items); it < items; it += cd.nw) { const int kb = it / nN, nb = it % nN; conv_tile(W, Nsrc, Ksrc, Nsrc, WT + k_at, Kdst, nullptr, scr, 64 * kb, 64 * nb, c.lane, DstPlain{}); }
}
template <bool F8> struct JobPlainN { const float* W; int Ksrc, Nsrc; bf16_t* WT; float scale; int nN, per;
    __device__ __forceinline__ void load(int it, int lane, f32x4 (&v)[16]) const { const int e = it / per, r = it % per; conv_load(W + (size_t)e * Ksrc * Nsrc, Nsrc, Ksrc, Nsrc, 64 * (r / nN), 64 * (r % nN), lane, v); }
    __device__ __forceinline__ void emit(int it, int lane, LAS float* scr, const f32x4 (&v)[16]) const { const int e = it / per, r = it % per;
        conv_emit<DstPlain, F8>(v, Ksrc, Nsrc, (bf16_t*)((unsigned char*)WT + (size_t)e * Nsrc * Ksrc * (F8 ? 1 : 2)), Ksrc, nullptr, scr, 64 * (r / nN), 64 * (r % nN), lane, DstPlain{}, scale); } };
template <bool F8 = false>
__device__ __forceinline__ void conv_plain_n(const Ctx& c, ConvDist& cd, LAS float* scr, const float* W, int Ksrc, int Nsrc, bf16_t* WT, int ne, float scale = 1.f) {
    const int nK = Ksrc / 64, nN = Nsrc / 64, per = nK * nN; JobPlainN<F8> J{W, Ksrc, Nsrc, WT, scale, nN, per}; int f_, e_; cd.range(per * ne, f_, e_); conv_run(J, e_, f_, cd.nw, c.lane, scr);
}
__device__ __forceinline__ int proj_src(int L) { return L < 416 ? L : (L < 512 ? -1 : L - 96); }
__device__ __forceinline__ void conv_proj(const Ctx& c, ConvDist& cd, LAS float* scr, const float* W, bf16_t* WT, const float* gain) {
    { bf16_t* zp = WT + (size_t)416 * D; asm volatile("" : "+s"(zp));
      for (int i = blockIdx.x * NTHREADS + c.tid; i < 96 * D / 8; i += c.G * NTHREADS) *(u32x4*)(zp + (size_t)i * 8) = (u32x4){0u, 0u, 0u, 0u}; }
    const int nK = D / 64, nN = (928 + 63) / 64  , items = nK * nN;
    for (int it = cd.first(items); it < items; it += cd.nw) { const int kb = it / nN, nb = it % nN; conv_tile(W, INC, D, INC, WT, D, gain, scr, 64 * kb, 64 * nb, c.lane, DstProj{}); }
}
__device__ __forceinline__ void f_xbss(const Ctx& c, const float* __restrict__ x, bf16_t* __restrict__ xb, unsigned char* __restrict__ xb8, unsigned long long* __restrict__ xss, int first_wg) {
    if ((int)blockIdx.x < first_wg) return;
    const int gw = ((int)blockIdx.x - first_wg) * NWAVES + c.wave, ngw = (c.G - first_wg) * NWAVES;
    for (int row0 = gw; row0 < T; row0 += 4 * ngw) {
        f32x4 a[4][2], b[4][2];
#pragma unroll
        for (int k = 0; k < 4; ++k) { const int row = row0 + k * ngw < T ? row0 + k * ngw : row0; const f32x4* xr = (const f32x4*)(x + (size_t)row * D) + 2 * c.lane;
#pragma unroll
            for (int j = 0; j < 2; ++j) { a[k][j] = xr[128 * j]; b[k][j] = xr[128 * j + 1]; } }
#pragma unroll
        for (int k = 0; k < 4; ++k) { const int row = row0 + k * ngw; if (row >= T) break;
            float s = 0.f;
#pragma unroll
            for (int j = 0; j < 2; ++j) { s += sum4sq(a[k][j]) + sum4sq(b[k][j]); *((u32x4*)(xb + (size_t)row * D) + c.lane + 64 * j) = pack8(a[k][j], b[k][j]); *((uint2*)(xb8 + (size_t)row * D) + c.lane + 64 * j) = pack8_f8(a[k][j], b[k][j]); }
            s = wave_sum(s, c.lane);
            if (c.lane == 0) xss[row] = (unsigned long long)(s * 65536.f + 0.5f); }
    }
}

typedef unsigned long long u64;
__device__ __forceinline__ u64 ss_fix(float s) { return (u64)(s * 65536.f + 0.5f); }
__device__ __forceinline__ float ss_val(u64 v) { return (float)v * (1.f / 65536.f); }
#define EPI_ROW(un, ai, m) ((un).pm * 256 + (ai) * 128 + wr * 64 + (m) * 16 + fr)
struct EpiProjF {
    static constexpr bool PERM = false, AFTER_DRAIN = false, MID = false, SIDE = true;
    __device__ __forceinline__ void side_issue(const pg8::Unit& un, int wid) const {
        if (wid < 2) pg8::glds16(xss + (size_t)un.pm * 256, (unsigned)wid * 1024u + (unsigned)hw_lane() * 16u, un.side + (unsigned)wid * 1024u);
        else if (wid == 2) pg8::glds16(bias + (size_t)(un.pn + pn0) * 256, (unsigned)hw_lane() * 16u, un.side + 2048u); }
    const u64* xss; const float* bias; bf16_t* qlat; bf16_t* kvlat; bf16_t* u; bf16_t* ga; bf16_t* gb; u64* qss; u64* kvss; float* krss; int pn0  ; float asc  ;
    __device__ __forceinline__ void operator()(const f32x4 (&acc)[2][2][4][2], const pg8::Unit& un, int wr, int wc, int fr, int fq) const { auto xss_ = xss; asm volatile("" : "+s"(xss_)); auto bias_ = bias; asm volatile("" : "+s"(bias_)); auto qlat_ = qlat; asm volatile("" : "+s"(qlat_)); auto kvlat_ = kvlat; asm volatile("" : "+s"(kvlat_)); auto u_ = u; asm volatile("" : "+s"(u_)); auto ga_ = ga; asm volatile("" : "+s"(ga_)); auto gb_ = gb; asm volatile("" : "+s"(gb_)); auto qss_ = qss; asm volatile("" : "+s"(qss_)); auto kvss_ = kvss; asm volatile("" : "+s"(kvss_)); auto krss_ = krss; asm volatile("" : "+s"(krss_));
        { const int l_ = hw_lane(); fr = l_ & 15; fq = l_ >> 4; }
        const int pn = un.pn + pn0, cl = wc * 32 + 8 * fq;
        f32x4 bv[2][2];
#pragma unroll
        for (int bj = 0; bj < 2; ++bj)
#pragma unroll
            for (int n = 0; n < 2; ++n) bv[bj][n] = *(const LAS f32x4*)((const LAS float*)(size_t)(un.side + 2048u) + bj * 128 + cl + 4 * n);
#pragma unroll
        for (int ai = 0; ai < 2; ++ai)
#pragma unroll
            for (int m = 0; m < 4; ++m) {
                const int row = EPI_ROW(un, ai, m);
                const float r = rsqrtf(ss_val(((const LAS u64*)(size_t)un.side)[ai * 128 + wr * 64 + m * 16 + fr]) * (1.f / D) + EPS) * asc;
                f32x4 v[2][2];
#pragma unroll
                for (int bj = 0; bj < 2; ++bj)
#pragma unroll
                    for (int n = 0; n < 2; ++n) v[bj][n] = acc[ai][bj][m][n] * r + bv[bj][n];
                if (pn == 0) {
                    *(u32x4*)(qlat_ + (size_t)row * 256 + cl) = pack8(v[0][0], v[0][1]); *(u32x4*)(qlat_ + (size_t)row * 256 + 128 + cl) = pack8(v[1][0], v[1][1]);
                    float s = (sum4sq(v[0][0]) + sum4sq(v[0][1])) + (sum4sq(v[1][0]) + sum4sq(v[1][1]));
                    s = xadd<32>(xadd<16>(s, fq * 16 + fr), fq * 16 + fr);
                    if (fq == 0) atomicAdd(qss_ + row, ss_fix(s));
                } else if (pn == 1) {
                    *(u32x4*)(kvlat_ + (size_t)row * 256 + cl) = pack8(v[0][0], v[0][1]); *(u32x4*)(kvlat_ + (size_t)row * 256 + 128 + cl) = pack8(v[1][0], v[1][1]);
                    float s = sum4sq(v[0][0]) + sum4sq(v[0][1]);
                    s = xadd<32>(xadd<16>(s, fq * 16 + fr), fq * 16 + fr);
                    if (fq == 0) atomicAdd(kvss_ + row, ss_fix(s));
                    if (wc == 0) { float s2 = sum4sq(v[1][0]) + sum4sq(v[1][1]); s2 = xadd<32>(xadd<16>(s2, fq * 16 + fr), fq * 16 + fr); if (fq == 0) krss_[row] = s2; }
                } else if (pn < 4) {
                    bf16_t* p = u_ + (size_t)row * 512 + (pn - 2) * 256 + cl;
                    *(u32x4*)p = pack8(v[0][0], v[0][1]); *(u32x4*)(p + 128) = pack8(v[1][0], v[1][1]);
                } else {
                    bf16_t* p = (pn < 8 ? ga_ + (size_t)row * 1024 + (pn - 4) * 256 : gb_ + (size_t)row * 1024 + (pn - 8) * 256) + cl;
                    *(u32x4*)p = pack8(sig4(v[0][0]), sig4(v[0][1])); *(u32x4*)(p + 128) = pack8(sig4(v[1][0]), sig4(v[1][1]));
                }
            }
    }
};
struct EpiRowScale {
    static constexpr bool PERM = false, AFTER_DRAIN = false, MID = false;
    bf16_t* O; const u64* ss; int ldc; float invn;
    __device__ __forceinline__ void operator()(const f32x4 (&acc)[2][2][4][2], const pg8::Unit& un, int wr, int wc, int fr, int fq) const { auto O_ = O; asm volatile("" : "+s"(O_)); auto ss_ = ss; asm volatile("" : "+s"(ss_));
        const int c0 = un.pn * 256 + wc * 32 + 8 * fq;
#pragma unroll
        for (int ai = 0; ai < 2; ++ai)
#pragma unroll
            for (int m = 0; m < 4; ++m) { const int row = EPI_ROW(un, ai, m); const float r = rsqrtf(ss_val(ss_[row]) * invn + EPS);
#pragma unroll
                for (int bj = 0; bj < 2; ++bj) *(u32x4*)(O_ + (size_t)row * ldc + c0 + bj * 128) = pack8(acc[ai][bj][m][0] * r, acc[ai][bj][m][1] * r); }
    }
};
constexpr float ATT_KSC = 0.38372444022488722f;
__device__ __forceinline__ int vt_pos(int kk) { const int u = kk >> 5, c = kk & 31, h = (c >> 2) & 1, jl = (c & 3) + 4 * (c >> 3); return 32 * h + jl + 16 * u; }
constexpr int VT_IMG_PITCH = 68;
template <bool LDSPATH> struct EpiKVT {
    static constexpr bool PERM = false, AFTER_DRAIN = LDSPATH, MID = false;
    const u64* kvss; const float* krss; const bf16_t* kvlat; const float* gk; const float* rope; bf16_t* Kn; bf16_t* Vn;
    __device__ __forceinline__ void operator()(const f32x4 (&acc)[2][2][4][2], const pg8::Unit& un, int wr, int wc, int fr, int fq) const { body(acc, un, wr, wc, fr, fq, nullptr, 0); }
    __device__ __forceinline__ void fused(const f32x4 (&acc)[2][2][4][2], const pg8::Unit& un, int wr, int wc, int fr, int fq, LAS unsigned char* lds, int wid, int lane) const { body(acc, un, wr, wc, fr, fq, lds, wid * 64 + lane); }
    __device__ __forceinline__ void body(const f32x4 (&acc)[2][2][4][2], const pg8::Unit& un, int wr, int wc, int fr, int fq, LAS unsigned char* img, int tid) const {
        asm volatile("" : "+v"(fr), "+v"(fq));
        auto kvss_ = kvss; asm volatile("" : "+s"(kvss_)); auto krss_ = krss; asm volatile("" : "+s"(krss_)); auto kvlat_ = kvlat; asm volatile("" : "+s"(kvlat_)); auto gk_ = gk; asm volatile("" : "+s"(gk_));
        auto rope_ = rope; asm volatile("" : "+s"(rope_)); auto Kn_ = Kn; asm volatile("" : "+s"(Kn_)); auto Vn_ = Vn; asm volatile("" : "+s"(Vn_));
        const int head = 2 * un.pn + (wc >> 1), lane = fq * 16 + fr;
        if ((wc & 1) == 0) {
            f32x4 g[2][2], gr1, gr2;
#pragma unroll
            for (int bj = 0; bj < 2; ++bj)
#pragma unroll
                for (int n = 0; n < 2; ++n) g[bj][n] = *(const f32x4*)(gk_ + 32 * bj + 8 * fq + 4 * n);
            gr1 = *(const f32x4*)(gk_ + 64 + 4 * fq); gr2 = *(const f32x4*)(gk_ + 80 + 4 * fq);
#pragma unroll
            for (int ai = 0; ai < 2; ++ai)
#pragma unroll
                for (int m = 0; m < 4; ++m) { const int row = EPI_ROW(un, ai, m); const float rkv = rsqrtf(ss_val(kvss_[row]) * (1.f / 128.f) + EPS);
                    f32x4 v[2][2]; float s = 0.f;
#pragma unroll
                    for (int bj = 0; bj < 2; ++bj)
#pragma unroll
                        for (int n = 0; n < 2; ++n) { v[bj][n] = acc[ai][bj][m][n] * rkv; s += sum4sq(v[bj][n]); }
                    s = xadd<32>(xadd<16>(s, lane), lane);
                    const float rk = rsqrtf((s + krss_[row]) * (1.f / 96.f) + EPS);
                    const float rks = rk * ATT_KSC; const int b = row / SEQ, sp = row % SEQ; unsigned char* kp = (unsigned char*)Kn_ + ((size_t)(b * NH + head) * SEQ + sp) * 128;
#pragma unroll
                    for (int bj = 0; bj < 2; ++bj) *(uint2*)(kp + 32 * (fq & 1) + 8 * (2 * bj + (fq >> 1))) = pack8_f8(v[bj][0] * g[bj][0] * rks, v[bj][1] * g[bj][1] * rks);
                    const uint2 w1 = *(const uint2*)(kvlat_ + (size_t)row * 256 + 128 + 4 * fq), w2 = *(const uint2*)(kvlat_ + (size_t)row * 256 + 144 + 4 * fq);
                    const f32x4 x1 = (f32x4){bflo(w1.x), bfhi(w1.x), bflo(w1.y), bfhi(w1.y)} * gr1 * rks, x2 = (f32x4){bflo(w2.x), bfhi(w2.x), bflo(w2.y), bfhi(w2.y)} * gr2 * rks;
                    const f32x4* rp = (const f32x4*)(rope_ + ((size_t)sp * 16 + 4 * fq) * 2); const f32x4 c01 = rp[0], c23 = rp[1];
                    const f32x4 cs = (f32x4){c01[0], c01[2], c23[0], c23[2]}, sn = (f32x4){c01[1], c01[3], c23[1], c23[3]};
                    const f32x4 o1 = x1 * cs - x2 * sn, o2 = x2 * cs + x1 * sn;
                    unsigned char* kr = kp + 64 + 32 * (fq >> 1) + 4 * (fq & 1);
                    *(unsigned*)kr = pk4_f8(o1[0], o1[1], o1[2], o1[3]); *(unsigned*)(kr + 8) = pk4_f8(o2[0], o2[1], o2[2], o2[3]);
                    *(uint2*)(kp + 80 + 32 * (fq >> 1) + 8 * (fq & 1)) = make_uint2(fq == 0 ? 0x38u : 0u, 0u); }
        } else {
#pragma unroll
            for (int ai = 0; ai < 2; ++ai)
#pragma unroll
                for (int m = 0; m < 4; ++m) { const int row = EPI_ROW(un, ai, m); const float rkv = rsqrtf(ss_val(kvss_[row]) * (1.f / 128.f) + EPS);
                    const int key = ai * 128 + wr * 64 + m * 16 + fr, pos = vt_pos(key & 63);
#pragma unroll
                    for (int bj = 0; bj < 2; ++bj) { const uint2 w = pack8_f8(acc[ai][bj][m][0] * rkv, acc[ai][bj][m][1] * rkv);
                        if constexpr (LDSPATH) { LAS unsigned char* p = img + ((((wc >> 1) * 4 + (key >> 6)) * 64 + 32 * bj + 8 * fq) * VT_IMG_PITCH) + pos;
#pragma unroll
                            for (int i = 0; i < 4; ++i) { p[i * VT_IMG_PITCH] = (unsigned char)(w.x >> (8 * i)); p[(4 + i) * VT_IMG_PITCH] = (unsigned char)(w.y >> (8 * i)); } }
                        else { const int b = row / SEQ, sp = row % SEQ; unsigned char* p = (unsigned char*)Vn_ + (((size_t)(b * NH + head) * (SEQ / 64) + (sp >> 6)) * 64 + 32 * bj + 8 * fq) * 64 + pos;
#pragma unroll
                            for (int i = 0; i < 4; ++i) { p[i * 64] = (unsigned char)(w.x >> (8 * i)); p[(4 + i) * 64] = (unsigned char)(w.y >> (8 * i)); } } } }
        }
        if constexpr (LDSPATH) {
            __syncthreads();
            const int hl = tid >> 8, tl = (tid >> 6) & 3, d = tid & 63; const int row0 = un.pm * 256, b = row0 / SEQ, sp0 = row0 % SEQ;
            const LAS unsigned* src = (const LAS unsigned*)(img + tid * VT_IMG_PITCH);
            u32x4* dst = (u32x4*)((unsigned char*)Vn_ + (((size_t)(b * NH + 2 * un.pn + hl) * (SEQ / 64) + (sp0 >> 6) + tl) * 64 + d) * 64);
#pragma unroll
            for (int q4 = 0; q4 < 4; ++q4) dst[q4] = (u32x4){src[4 * q4], src[4 * q4 + 1], src[4 * q4 + 2], src[4 * q4 + 3]};
        }
    }
};
typedef EpiKVT<true> EpiKV;
typedef EpiKVT<false> EpiKVslow;
struct EpiGluF {
    static constexpr bool PERM = false, AFTER_DRAIN = false, MID = false;
    const bf16_t* yg; const float* b; bf16_t* out; int ldo, pad_;
    __device__ __forceinline__ void operator()(const f32x4 (&acc)[2][2][4][2], const pg8::Unit& un, int wr, int wc, int fr, int fq) const { auto yg_ = yg; asm volatile("" : "+s"(yg_)); auto b_ = b; asm volatile("" : "+s"(b_)); auto out_ = out; asm volatile("" : "+s"(out_));
        const int c0 = un.pn * 256 + wc * 32 + 8 * fq;
        f32x4 bv[2][2];
#pragma unroll
        for (int bj = 0; bj < 2; ++bj)
#pragma unroll
            for (int n = 0; n < 2; ++n) bv[bj][n] = *(const f32x4*)(b_ + c0 + bj * 128 + 4 * n);
#pragma unroll
        for (int ai = 0; ai < 2; ++ai)
#pragma unroll
            for (int m = 0; m < 4; ++m) { const int row = EPI_ROW(un, ai, m);
#pragma unroll
                for (int bj = 0; bj < 2; ++bj) { const size_t o = (size_t)row * 512 + c0 + bj * 128; f32x4 y0, y1; unpack8(*(const u32x4*)(yg_ + o), y0, y1);
                    *(u32x4*)(out_ + (size_t)row * ldo + c0 + bj * 128) = pack8(y0 * sig4f(acc[ai][bj][m][0] + bv[bj][0]), y1 * sig4f(acc[ai][bj][m][1] + bv[bj][1])); } }
    }
};
struct EpiMixFused {
    static constexpr bool PERM = false, AFTER_DRAIN = false, MID = true;
    const bf16_t* ga; const bf16_t* gb; bf16_t* out;
    __device__ __forceinline__ void mid(f32x4 (&acc)[2][2][4][2], const pg8::Unit& un, int wr, int wc, int fr, int fq) const { auto ga_ = ga; asm volatile("" : "+s"(ga_)); auto gb_ = gb; asm volatile("" : "+s"(gb_));
        const int c0 = un.pn * 256 + wc * 32 + 8 * fq;
#pragma unroll
        for (int ai = 0; ai < 2; ++ai)
#pragma unroll
            for (int m = 0; m < 4; ++m) { const int row = EPI_ROW(un, ai, m);
#pragma unroll
                for (int bj = 0; bj < 2; ++bj) { const size_t o = (size_t)row * 1024 + c0 + bj * 128; f32x4 a0, a1, b0, b1; unpack8(*(const u32x4*)(ga_ + o), a0, a1); unpack8(*(const u32x4*)(gb_ + o), b0, b1);
#pragma unroll
                    for (int j = 0; j < 4; ++j) { acc[ai][bj][m][0][j] *= a0[j] * __builtin_amdgcn_rcpf(fmaxf(b0[j], 8.6736174e-19f)); acc[ai][bj][m][1][j] *= a1[j] * __builtin_amdgcn_rcpf(fmaxf(b1[j], 8.6736174e-19f)); } } }
    }
    __device__ __forceinline__ void operator()(const f32x4 (&acc)[2][2][4][2], const pg8::Unit& un, int wr, int wc, int fr, int fq) const { auto gb_ = gb; asm volatile("" : "+s"(gb_)); auto out_ = out; asm volatile("" : "+s"(out_));
        const int c0 = un.pn * 256 + wc * 32 + 8 * fq;
#pragma unroll
        for (int ai = 0; ai < 2; ++ai)
#pragma unroll
            for (int m = 0; m < 4; ++m) { const int row = EPI_ROW(un, ai, m);
#pragma unroll
                for (int bj = 0; bj < 2; ++bj) { const size_t o = (size_t)row * 1024 + c0 + bj * 128; f32x4 b0, b1; unpack8(*(const u32x4*)(gb_ + o), b0, b1);
#pragma unroll
                    for (int j = 0; j < 4; ++j) { b0[j] = fmaxf(b0[j], 8.6736174e-19f); b1[j] = fmaxf(b1[j], 8.6736174e-19f); }
                    *(u32x4*)(out_ + o) = pack8(acc[ai][bj][m][0] * b0, acc[ai][bj][m][1] * b1); } }
    }
};
template <bool IN_BF16, bool OUT_F32, bool OUT_BF16 = !OUT_F32, bool OUT_F8 = OUT_F32, int ACC_SHIFT = 0> struct EpiResidF {
    static constexpr bool PERM = false, AFTER_DRAIN = false, MID = false;
    const float* xin; float* xout; bf16_t* xb; u64* xssn; unsigned char* xb8;
    __device__ __forceinline__ void operator()(const f32x4 (&acc)[2][2][4][2], const pg8::Unit& un, int wr, int wc, int fr, int fq) const { auto xin_ = xin; asm volatile("" : "+s"(xin_)); auto xout_ = xout; asm volatile("" : "+s"(xout_)); auto xb_ = xb; asm volatile("" : "+s"(xb_)); auto xssn_ = xssn; asm volatile("" : "+s"(xssn_)); auto xb8_ = xb8; asm volatile("" : "+s"(xb8_));
        const int c0 = un.pn * 256 + wc * 32 + 8 * fq;
#pragma unroll
        for (int ai = 0; ai < 2; ++ai)
#pragma unroll
            for (int m = 0; m < 4; ++m) { const int row = EPI_ROW(un, ai, m); float s = 0.f;
#pragma unroll
                for (int bj = 0; bj < 2; ++bj) { const size_t o = (size_t)row * 1024 + c0 + bj * 128;
                    f32x4 x0, x1; if (IN_BF16) unpack8(*(const u32x4*)(xb_ + o), x0, x1); else { x0 = *(const f32x4*)(xin_ + o); x1 = *(const f32x4*)(xin_ + o + 4); }
                    constexpr float asc = 1.f / (float)(1 << ACC_SHIFT);
                    const f32x4 y0 = x0 + acc[ai][bj][m][0] * asc, y1 = x1 + acc[ai][bj][m][1] * asc;
                    if (OUT_F32) { *(f32x4*)(xout_ + o) = y0; *(f32x4*)(xout_ + o + 4) = y1; }
                    if (OUT_F8) *(uint2*)(xb8_ + o) = pack8_f8(y0, y1);
                    if (OUT_BF16) *(u32x4*)(xb_ + o) = pack8(y0, y1);
                    s += sum4sq(y0) + sum4sq(y1); }
                s = xadd<32>(xadd<16>(s, fq * 16 + fr), fq * 16 + fr);
                if (fq == 0) atomicAdd(xssn_ + row, ss_fix(s)); }
    }
};
typedef unsigned u32x2g __attribute__((ext_vector_type(2)));
template <bool OUT_F8> struct EpiSwigluT {
    static constexpr bool PERM = false, AFTER_DRAIN = false, MID = false, SIDE = true;
    __device__ __forceinline__ void side_issue(const pg8::Unit& un, int wid) const {
        if (rrow) { if (wid == 0) pg8::glds16(rrow + (size_t)un.pm * 256, (unsigned)hw_lane() * 16u, un.side); }
        else if (wid < 2) pg8::glds16(xss + (size_t)un.pm * 256, (unsigned)wid * 1024u + (unsigned)hw_lane() * 16u, un.side + (unsigned)wid * 1024u); }
    bf16_t* h; const u64* xss; const float* rrow; int ldh; int tiles_per_group; float oscale  ;
    __device__ __forceinline__ void operator()(const f32x4 (&acc)[2][2][4][2], const pg8::Unit& un, int wr, int wc, int fr, int fq) const { auto h_ = h; asm volatile("" : "+s"(h_)); auto xss_ = xss; asm volatile("" : "+s"(xss_)); auto rrow_ = rrow; asm volatile("" : "+s"(rrow_));
        asm volatile("" : "+v"(fr), "+v"(fq));
        const int c0 = (un.pn % tiles_per_group) * 128 + wc * 32 + 8 * fq;
#pragma unroll
        for (int ai = 0; ai < 2; ++ai)
#pragma unroll
            for (int m = 0; m < 4; ++m) { const int row = EPI_ROW(un, ai, m), rl = ai * 128 + wr * 64 + m * 16 + fr;
                const float r = rrow_ ? ((const LAS float*)(size_t)un.side)[rl] : rsqrtf(ss_val(((const LAS u64*)(size_t)un.side)[rl]) * (1.f / D) + EPS) * oscale;
                f32x4 o[2];
#pragma unroll
                for (int n = 0; n < 2; ++n) { const f32x4 g = acc[ai][0][m][n] * r, uu = acc[ai][1][m][n] * r; o[n] = (f32x4){siluf_(g[0]) * uu[0], siluf_(g[1]) * uu[1], siluf_(g[2]) * uu[2], siluf_(g[3]) * uu[3]}; }
                if constexpr (OUT_F8) { const uint2 pk_ = pack8_f8(clamp_f8(o[0]), clamp_f8(o[1])); *(GAS u32x2g*)((GAS unsigned char*)h_ + (size_t)row * ldh + c0) = (u32x2g){pk_.x, pk_.y}; }
                else *(GAS u32x4*)((GAS bf16_t*)h_ + (size_t)row * ldh + c0) = pack8(o[0], o[1]); }
    }
};
typedef EpiSwigluT<false> EpiSwigluF;
typedef EpiSwigluT<true> EpiSwigluF8;
struct EpiStoreBf16 {
    static constexpr bool PERM = false, AFTER_DRAIN = false, MID = false;
    bf16_t* O; int ldc; int tiles_per_group;
    __device__ __forceinline__ void operator()(const f32x4 (&acc)[2][2][4][2], const pg8::Unit& un, int wr, int wc, int fr, int fq) const { auto O_ = O; asm volatile("" : "+s"(O_));
        const int c0 = (un.pn % tiles_per_group) * 256 + wc * 32 + 8 * fq;
#pragma unroll
        for (int ai = 0; ai < 2; ++ai)
#pragma unroll
            for (int m = 0; m < 4; ++m) { const int row = EPI_ROW(un, ai, m);
#pragma unroll
                for (int bj = 0; bj < 2; ++bj) *(u32x4*)(O_ + (size_t)row * ldc + c0 + bj * 128) = pack8(acc[ai][bj][m][0], acc[ai][bj][m][1]); }
    }
};

__device__ __forceinline__ void f_rope_table(const Ctx& c, float* __restrict__ rope) {
    for (int i = blockIdx.x * NTHREADS + c.tid; i < SEQ * 16; i += c.G * NTHREADS) { float sn, cs; sincos_rev((double)(i >> 4) * c_invrev[i & 15], sn, cs); rope[2 * i] = cs; rope[2 * i + 1] = sn; }
}
template <bool ALLRED> struct EpiSplitKT {
    static constexpr bool PERM = false, AFTER_DRAIN = true, MID = false;
    bf16_t* O; float* slabs; unsigned* tickets; int ldc, per_e, rt0, nsl, kslice_bytes;
    __device__ __forceinline__ void fused(f32x4 (&acc)[2][2][4][2], const pg8::Unit& un, int wr, int wc, int fr, int fq, LAS unsigned char* lds, int wid, int lane) const {
        const int pnl = un.pn % per_e, tu = (un.pm - rt0) * per_e + pnl, sl = un.koff / kslice_bytes;
        float* my = slabs + ((size_t)tu * nsl + sl) * 65536;
#pragma unroll
        for (int ai = 0; ai < 2; ++ai)
#pragma unroll
            for (int m = 0; m < 4; ++m) { const int rl = ai * 128 + wr * 64 + m * 16 + fr;
#pragma unroll
                for (int bj = 0; bj < 2; ++bj)
#pragma unroll
                    for (int n = 0; n < 2; ++n) *(f32x4*)(my + rl * 256 + bj * 128 + wc * 32 + 8 * fq + 4 * n) = acc[ai][bj][m][n]; }
        asm volatile("s_waitcnt vmcnt(0)" ::: "memory");
        __syncthreads();
        LAS unsigned* flag = (LAS unsigned*)lds;
        if (wid == 0 && lane == 0) {
            __builtin_amdgcn_fence(__ATOMIC_RELEASE, "agent"); asm volatile("s_waitcnt vmcnt(0)" ::: "memory");
            const unsigned tk = __hip_atomic_fetch_add(tickets + 64 * tu, 1u, __ATOMIC_RELAXED, __HIP_MEMORY_SCOPE_AGENT);
            unsigned last = (tk == (unsigned)(nsl - 1)) ? 1u : 0u;
            if constexpr (ALLRED) { unsigned sp_ = 0u; while (__hip_atomic_load(tickets + 64 * tu, __ATOMIC_RELAXED, __HIP_MEMORY_SCOPE_AGENT) < (unsigned)nsl) { __builtin_amdgcn_s_sleep(2); if (++sp_ > (1u << 22)) break; } last = 1u; }
            if (last) { __builtin_amdgcn_fence(__ATOMIC_ACQUIRE, "agent"); asm volatile("s_waitcnt vmcnt(0)" ::: "memory"); }
            flag[0] = last;
        }
        asm volatile("s_waitcnt lgkmcnt(0)" ::: "memory");
        __syncthreads();
        if (flag[0] == 0u) return;
        const float* s0 = slabs + (size_t)tu * nsl * 65536;
        if constexpr (ALLRED) {
            const int R = (256 + nsl - 1) / nsl, r0 = sl * R, r1 = r0 + R < 256 ? r0 + R : 256, tid = wid * 64 + lane;
            for (int i = r0 * 64 + tid; i < r1 * 64; i += NTHREADS) { const int rl = i >> 6, cl = (i & 63) * 4;
                f32x4 t0 = *(const f32x4*)(s0 + rl * 256 + cl);
                for (int k = 1; k < nsl; ++k) t0 = t0 + *(const f32x4*)(s0 + (size_t)k * 65536 + rl * 256 + cl);
                *(uint2*)(O + (size_t)(un.pm * 256 + rl) * ldc + pnl * 256 + cl) = make_uint2(cvt_pk_bf16(t0[0], t0[1]), cvt_pk_bf16(t0[2], t0[3])); }
            return;
        }
#pragma unroll
        for (int ai = 0; ai < 2; ++ai)
#pragma unroll
            for (int m = 0; m < 4; ++m) { const int rl = ai * 128 + wr * 64 + m * 16 + fr;
#pragma unroll
                for (int bj = 0; bj < 2; ++bj) { const int cl = bj * 128 + wc * 32 + 8 * fq;
                    f32x4 t0 = *(const f32x4*)(s0 + rl * 256 + cl), t1 = *(const f32x4*)(s0 + rl * 256 + cl + 4);
                    for (int k = 1; k < nsl; ++k) { t0 = t0 + *(const f32x4*)(s0 + (size_t)k * 65536 + rl * 256 + cl); t1 = t1 + *(const f32x4*)(s0 + (size_t)k * 65536 + rl * 256 + cl + 4); }
                    *(u32x4*)(O + (size_t)(un.pm * 256 + rl) * ldc + pnl * 256 + cl) = pack8(t0, t1); } }
    }
};
typedef EpiSplitKT<false> EpiSplitK;
typedef EpiSplitKT<true> EpiSplitKAll;
namespace pg8 {
template <class Epi, class Sched, bool F8 = false>
__device__ __forceinline__ void gemm_phase_gather(PG8_LAS unsigned char* lds, const Gemm g, const int* __restrict__ rowtok, const Sched& S, const Epi& E, const int tid) {
    const int wid = __builtin_amdgcn_readfirstlane(tid >> 6), lane = tid & 63, wr = wid >> 2, wc = wid & 3, fr = lane & 15, fq = lane >> 4;
    const int K = g.Kp; int nt = g.K / BK; int ktm_ = ~0; if (PROBE_K2) { ktm_ = nt - 1; nt *= 2; } if constexpr (F8) asm volatile("" : "+s"(nt));
    unsigned voffB[2];
#pragma unroll
    for (int i = 0; i < 2; ++i) { int R, C; stage_rc(tid * 16 + i * 8192, R, C); voffB[i] = (unsigned)(R * K + C) * 2u; }
    const size_t kstep = (size_t)(BK * 2);
    const size_t hstep = (size_t)HALF * K * 2;
    const size_t tstep = 2 * hstep;
    const unsigned ldsw = (unsigned)wid * 1024u;
    const unsigned ldsb = (unsigned)(size_t)lds + ldsw;
    const int aoff = lds_byte(wr * 64 + fr, fq * 8), boff = lds_byte(wc * 32 + fr, fq * 8);
#define PG8_SA(b, h) (((b) * 2 + (h)) * HTB)
#define PG8_SB(b, h) ((4 + (b) * 2 + (h)) * HTB)
#define PG8_STAGE(bufoff, gbase, voff) do { _Pragma("unroll") for (int _i = 0; _i < 2; ++_i) glds16((gbase), (voff)[_i], ldsb + (unsigned)((bufoff) + _i * 8192)); } while (0)
#define PG8_LDA(dst, b, h) do { _Pragma("unroll") for (int m = 0; m < 4; ++m) _Pragma("unroll") for (int k = 0; k < 2; ++k) dst[m][k] = *(const PG8_LAS bf16x8*)(lds + PG8_SA(b, h) + aoff + m * 2048 + k * 1024); } while (0)
#define PG8_LDB(dst, b, h) do { _Pragma("unroll") for (int n = 0; n < 2; ++n) _Pragma("unroll") for (int k = 0; k < 2; ++k) dst[n][k] = *(const PG8_LAS bf16x8*)(lds + PG8_SB(b, h) + boff + n * 2048 + k * 1024); } while (0)
#define PG8_MMA(ai, bj, At, Bt) do { __builtin_amdgcn_s_setprio(1); _Pragma("unroll") for (int m = 0; m < 4; ++m) _Pragma("unroll") for (int n = 0; n < 2; ++n) { \
        if constexpr (F8) acc[ai][bj][m][n] = __builtin_amdgcn_mfma_scale_f32_16x16x128_f8f6f4(cat8(Bt[n][0], Bt[n][1]), cat8(At[m][0], At[m][1]), acc[ai][bj][m][n], 0, 0, 0, 0, 0, 0); \
        else { _Pragma("unroll") for (int k = 0; k < 2; ++k) acc[ai][bj][m][n] = __builtin_amdgcn_mfma_f32_16x16x32_bf16(Bt[n][k], At[m][k], acc[ai][bj][m][n], 0, 0, 0); } } __builtin_amdgcn_s_setprio(0); } while (0)
#define PG8_WAIT_V(n) asm volatile("s_waitcnt vmcnt(" #n ")" ::: "memory")
#define PG8_WAIT_L(n) asm volatile("s_waitcnt lgkmcnt(" #n ")" ::: "memory")
#define PG8_BAR __builtin_amdgcn_s_barrier()
#define PG8_SCHED __builtin_amdgcn_sched_barrier(0)
#define PG8_TLOAD(u, t0, t1) do { const int tl_ = wid * 64 + hw_lane(); _Pragma("unroll") for (int _i = 0; _i < 2; ++_i) { int R_, C_; stage_rc(tl_ * 16 + _i * 8192, R_, C_); \
        const int* p0_ = rowtok + (u).pm * BM + R_; const int* p1_ = p0_ + HALF; asm volatile("global_load_dword %0, %1, off" : "=v"(t0[_i]) : "v"(p0_) : "memory"); asm volatile("global_load_dword %0, %1, off" : "=v"(t1[_i]) : "v"(p1_) : "memory"); } } while (0)
#define PG8_TFIN(t0, t1) do { const int tl_ = wid * 64 + hw_lane(); _Pragma("unroll") for (int _i = 0; _i < 2; ++_i) { int R_, C_; stage_rc(tl_ * 16 + _i * 8192, R_, C_); asm volatile("" : "+v"(t0[_i]), "+v"(t1[_i])); \
        int a_ = (int)t0[_i], b_ = (int)t1[_i]; a_ = a_ < 0 ? 0 : a_; b_ = b_ < 0 ? 0 : b_; t0[_i] = (unsigned)a_ * (unsigned)(K * 2) + (unsigned)C_ * 2u; t1[_i] = (unsigned)b_ * (unsigned)(K * 2) + (unsigned)C_ * 2u; } } while (0)
#define PG8_GVOFF(u, v0, v1) do { const int tl_ = wid * 64 + hw_lane();   _Pragma("unroll") for (int _i = 0; _i < 2; ++_i) { int R_, C_; stage_rc(tl_ * 16 + _i * 8192, R_, C_); \
        int t0_ = rowtok[(u).pm * BM + R_], t1_ = rowtok[(u).pm * BM + HALF + R_]; t0_ = t0_ < 0 ? 0 : t0_; t1_ = t1_ < 0 ? 0 : t1_; \
        v0[_i] = (unsigned)t0_ * (unsigned)(K * 2) + (unsigned)C_ * 2u; v1[_i] = (unsigned)t1_ * (unsigned)(K * 2) + (unsigned)C_ * 2u; } } while (0)
    Unit cur, nxt; int ui = 0;
    if (!S.next(0, cur)) return;
    f32x4 acc[2][2][4][2];
#pragma unroll
    for (int a = 0; a < 2; ++a)
#pragma unroll
        for (int b = 0; b < 2; ++b)
#pragma unroll
            for (int m = 0; m < 4; ++m)
#pragma unroll
                for (int n = 0; n < 2; ++n) acc[a][b][m][n] = (f32x4){0.f, 0.f, 0.f, 0.f};
    bf16x8 At[4][2], B0[2][2], B1[2][2];
    const char* gA = (const char*)g.A; const char* cB = (const char*)g.Bt + (size_t)cur.pn * tstep;
    unsigned cv0[2], cv1[2], nv0[2], nv1[2];
    PG8_GVOFF(cur, cv0, cv1);
    if constexpr (EpiSide<Epi>::v) { cur.side = (unsigned)(size_t)lds + SIDE_OFF; E.side_issue(cur, wid); }
    S.a_ready(cur);
    PG8_STAGE(PG8_SB(0, 0), cB, voffB); PG8_STAGE(PG8_SB(0, 1), cB + hstep, voffB); PG8_STAGE(PG8_SA(0, 0), gA, cv0); PG8_STAGE(PG8_SA(0, 1), gA, cv1);
    if (wr == 1) PG8_BAR;
    PG8_WAIT_V(2); PG8_BAR;
    PG8_STAGE(PG8_SB(1, 0), cB + kstep, voffB); PG8_STAGE(PG8_SA(1, 0), gA + kstep, cv0); PG8_STAGE(PG8_SB(1, 1), cB + hstep + kstep, voffB);
    PG8_WAIT_V(6); PG8_BAR;
    for (;;) {
        const bool has_next = S.next(ui + 1, nxt);
        const char* nB = has_next ? (const char*)g.Bt + (size_t)nxt.pn * tstep : cB;
        if (has_next) { PG8_TLOAD(nxt, nv0, nv1); } else {
#pragma unroll
            for (int i = 0; i < 2; ++i) { nv0[i] = cv0[i]; nv1[i] = cv1[i]; } }
        for (int t = 0; t < nt; t += 2) {
            const bool last = (t == nt - 2);
            const char* a1 = gA + (size_t)((t + 1) & ktm_) * kstep;
            const char* a2 = last ? gA : gA + (size_t)((t + 2) & ktm_) * kstep; const char* b2 = last ? nB : cB + (size_t)((t + 2) & ktm_) * kstep;
            const char* a3 = a2 + kstep; const char* b3 = b2 + kstep;
            if (last && has_next) { S.a_ready(nxt); PG8_TFIN(nv0, nv1); }
            PG8_LDB(B0, 0, 0); PG8_LDB(B1, 0, 1); PG8_SCHED; PG8_LDA(At, 0, 0); PG8_STAGE(PG8_SA(1, 1), a1, cv1);
            PG8_WAIT_V(8); PG8_WAIT_L(0); PG8_BAR; PG8_MMA(0, 0, At, B0); PG8_MMA(0, 1, At, B1); PG8_BAR; PG8_SCHED;
            PG8_LDA(At, 0, 1); PG8_STAGE(PG8_SB(0, 0), b2, voffB); PG8_STAGE(PG8_SB(0, 1), b2 + hstep, voffB); if (last) { PG8_STAGE(PG8_SA(0, 0), a2, nv0); } else { PG8_STAGE(PG8_SA(0, 0), a2, cv0); }
            PG8_WAIT_V(8); PG8_WAIT_L(0); PG8_BAR; PG8_MMA(1, 0, At, B0); PG8_MMA(1, 1, At, B1); PG8_BAR; PG8_SCHED;
            PG8_LDB(B0, 1, 0); PG8_LDB(B1, 1, 1); PG8_SCHED; PG8_LDA(At, 1, 0); if (last) { PG8_STAGE(PG8_SA(0, 1), a2, nv1); } else { PG8_STAGE(PG8_SA(0, 1), a2, cv1); }
            PG8_WAIT_V(8); PG8_WAIT_L(0); PG8_BAR; PG8_MMA(0, 0, At, B0); PG8_MMA(0, 1, At, B1); PG8_BAR; PG8_SCHED;
            PG8_LDA(At, 1, 1); PG8_STAGE(PG8_SB(1, 0), b3, voffB); PG8_STAGE(PG8_SB(1, 1), b3 + hstep, voffB); if (last) { PG8_STAGE(PG8_SA(1, 0), a3, nv0); } else { PG8_STAGE(PG8_SA(1, 0), a3, cv0); }
            PG8_WAIT_V(8); PG8_WAIT_L(0); PG8_BAR; PG8_MMA(1, 0, At, B0); PG8_MMA(1, 1, At, B1); PG8_BAR; PG8_SCHED;
        }
        if (wr == 0) PG8_BAR;
        { const int l2 = hw_lane(); E(acc, cur, wr, wc, l2 & 15, l2 >> 4); } S.done(cur);
        if (!has_next) break;
#pragma unroll
        for (int a = 0; a < 2; ++a)
#pragma unroll
            for (int b = 0; b < 2; ++b)
#pragma unroll
                for (int m = 0; m < 4; ++m)
#pragma unroll
                    for (int n = 0; n < 2; ++n) acc[a][b][m][n] = (f32x4){0.f, 0.f, 0.f, 0.f};
        cur = nxt; cB = nB; ++ui;
        if constexpr (EpiSide<Epi>::v) { cur.side = (unsigned)(size_t)lds + SIDE_OFF + (ui & 1) * SIDE_BYTES; E.side_issue(cur, wid); }
#pragma unroll
        for (int i = 0; i < 2; ++i) { cv0[i] = nv0[i]; cv1[i] = nv1[i]; }
        if (wr == 1) PG8_BAR;
    }
    PG8_WAIT_V(0);
    PG8_BAR;
#undef PG8_SA
#undef PG8_SB
#undef PG8_STAGE
#undef PG8_LDA
#undef PG8_LDB
#undef PG8_MMA
#undef PG8_WAIT_V
#undef PG8_WAIT_L
#undef PG8_BAR
#undef PG8_SCHED
#undef PG8_GVOFF
#undef PG8_TLOAD
#undef PG8_TFIN
}
struct MoeOrder : StaticOrder {
    const PG8_LAS int* tile_e; int per_e;
    __device__ __forceinline__ bool next(int i, Unit& u) const { if (!StaticOrder::next(i, u)) return false; u.pn += __builtin_amdgcn_readfirstlane(tile_e[u.pm]) * per_e; return true; }
};
struct TailOrder {
    const int* tile_e; int rt0, ntail, per_e, nsl, kslice_bytes, c;
    __device__ __forceinline__ bool next(int i, Unit& u) const { if (i > 0 || c >= ntail * per_e * nsl) return false; const int sl = c % nsl, t = c / nsl, pnl = t % per_e, rt = rt0 + t / per_e;
        u.pm = rt; u.pn = __builtin_amdgcn_readfirstlane(tile_e[rt]) * per_e + pnl; u.koff = sl * kslice_bytes; return true; }
    __device__ __forceinline__ void a_ready(const Unit&) const {}
    __device__ __forceinline__ void done(const Unit&) const {}
};
}

__device__ __forceinline__ void f_route1(const Ctx& c, const float* __restrict__ x, const float* __restrict__ g, const float* __restrict__ rw, const float* __restrict__ rb,
                                         int* __restrict__ tope, float* __restrict__ topw, int* __restrict__ rank, int* __restrict__ cnt, int* __restrict__ rowtok, float* __restrict__ rrow) {
    for (int r = blockIdx.x * NTHREADS + c.tid; r < RCAP; r += c.G * NTHREADS) { rowtok[r] = -1; rrow[r] = 0.f; }
    LAS int* le = (LAS int*)c.lds;
    for (int ck = blockIdx.x; ck < T / 64; ck += c.G) {
        float gg[16];
#pragma unroll
        for (int q = 0; q < 16; ++q) gg[q] = g[c.lane + 64 * q];
        for (int j0 = 0; j0 < 8; j0 += 4) {
        float hh[4][16];
#pragma unroll
        for (int j = 0; j < 4; ++j) { const float* xr = x + (size_t)(ck * 64 + c.wave * 8 + j0 + j) * D;
#pragma unroll
            for (int q = 0; q < 16; ++q) hh[j][q] = xr[c.lane + 64 * q]; }
#pragma unroll
        for (int j = 0; j < 4; ++j) {
            const int tl = c.wave * 8 + j0 + j, t = ck * 64 + tl;
            float s = 0.f;
#pragma unroll
            for (int q = 0; q < 16; ++q) s += hh[j][q] * hh[j][q];
            const float r = rsqrtf(wave_sum(s, c.lane) * (1.f / D) + EPS);
            float lg[8];
#pragma unroll
            for (int e = 0; e < 8; ++e) lg[e] = 0.f;
#pragma unroll
            for (int q = 0; q < 16; ++q) { const int k = c.lane + 64 * q; const float hv = hh[j][q] * gg[q]; const f32x4 w0 = *(const f32x4*)(rw + k * 8), w1 = *(const f32x4*)(rw + k * 8 + 4);
                lg[0] += hv * w0[0]; lg[1] += hv * w0[1]; lg[2] += hv * w0[2]; lg[3] += hv * w0[3]; lg[4] += hv * w1[0]; lg[5] += hv * w1[1]; lg[6] += hv * w1[2]; lg[7] += hv * w1[3]; }
            {
                const bool h5 = (c.lane >> 5) & 1, h4 = (c.lane >> 4) & 1, h3 = (c.lane >> 3) & 1;
                float a4[4];
#pragma unroll
                for (int e = 0; e < 4; ++e) { const float keep = h5 ? lg[4 + e] : lg[e], send = h5 ? lg[e] : lg[4 + e]; a4[e] = keep + bperm(send, c.lane ^ 32); }
                float a2[2];
#pragma unroll
                for (int e = 0; e < 2; ++e) { const float keep = h4 ? a4[2 + e] : a4[e], send = h4 ? a4[e] : a4[2 + e]; a2[e] = keep + bperm(send, c.lane ^ 16); }
                float a1 = (h3 ? a2[1] : a2[0]) + bperm(h3 ? a2[0] : a2[1], c.lane ^ 8);
                a1 = xadd<4>(a1, c.lane); a1 = xadd<2>(a1, c.lane); a1 = xadd<1>(a1, c.lane);
#pragma unroll
                for (int e = 0; e < 8; ++e) lg[e] = __builtin_bit_cast(float, __builtin_amdgcn_readlane(__builtin_bit_cast(int, a1), 32 * (e >> 2) + 16 * ((e >> 1) & 1) + 8 * (e & 1))) * r + rb[e];
            }
            int e0 = 0; float v0 = lg[0];
#pragma unroll
            for (int e = 1; e < 8; ++e) if (lg[e] > v0) { v0 = lg[e]; e0 = e; }
            int e1 = -1; float v1 = -3.0e38f;
#pragma unroll
            for (int e = 0; e < 8; ++e) if (e != e0 && lg[e] > v1) { v1 = lg[e]; e1 = e; }
            if (c.lane == 0) { const float w1 = 1.f / (1.f + __expf(v0 - v1)); le[tl * 2] = e0; le[tl * 2 + 1] = e1; tope[t * 2] = e0; tope[t * 2 + 1] = e1; topw[t * 2] = (1.f - w1) * (1.f / MOE_WD_SCALE); topw[t * 2 + 1] = w1 * (1.f / MOE_WD_SCALE); }
        }
        }
        __syncthreads();
        if (c.wave == 0) {
            const int t = ck * 64 + c.lane; const int e0 = le[c.lane * 2], e1 = le[c.lane * 2 + 1];
            int r0 = 0, r1 = 0;
#pragma unroll
            for (int e = 0; e < 8; ++e) { const unsigned long long m = __ballot(e0 == e || e1 == e); const int pre = __popcll(m & ((1ull << c.lane) - 1ull));
                if (e0 == e) r0 = pre; if (e1 == e) r1 = pre; if (c.lane == e) cnt[ck * 8 + e] = __popcll(m); }
            rank[t * 2] = r0; rank[t * 2 + 1] = r1;
        }
        __syncthreads();
    }
}
__device__ __forceinline__ void f_route2(const Ctx& c, const int* __restrict__ tope, const int* __restrict__ rank, const int* __restrict__ cnt, int* __restrict__ pos, int* __restrict__ rowtok, int* __restrict__ tile_e, int* __restrict__ ntiles, const unsigned long long* __restrict__ xss, float* __restrict__ rrow) {
    LAS int* lbase = (LAS int*)c.lds;
    LAS int* ltot = lbase + 2048;
    {
        const int e = c.wave; int v[4]; int s = 0;
#pragma unroll
        for (int j = 0; j < 4; ++j) { v[j] = cnt[(4 * c.lane + j) * 8 + e]; s += v[j]; }
        int inc = s;
#pragma unroll
        for (int o = 1; o < 64; o <<= 1) { const int up = __builtin_amdgcn_ds_bpermute((c.lane - o) << 2, inc); if (c.lane >= o) inc += up; }
        int ex = inc - s;
#pragma unroll
        for (int j = 0; j < 4; ++j) { lbase[(4 * c.lane + j) * 8 + e] = ex; ex += v[j]; }
        if (c.lane == 63) ltot[e] = inc;
    }
    __syncthreads();
    int segoff[9]; segoff[0] = 0;
#pragma unroll
    for (int e = 0; e < 8; ++e) segoff[e + 1] = segoff[e] + ((ltot[e] + 255) & ~255);
    for (int ck = blockIdx.x; ck < T / 64; ck += c.G) {
        if (c.tid < 128) { const int tl = c.tid >> 1, k = c.tid & 1, t = ck * 64 + tl; const int e = tope[t * 2 + k];
            int so = 0;
#pragma unroll
            for (int q = 0; q < 8; ++q) so = (e == q) ? segoff[q] : so;
            const int p = so + lbase[ck * 8 + e] + rank[t * 2 + k]; pos[t * 2 + k] = p; rowtok[p] = t; rrow[p] = rsqrtf((float)xss[t] * (1.f / 65536.f) * (1.f / D) + EPS) * (1.f / MOE_WGU_SCALE) * (PROBE_K2 ? 0.5f : 1.f); }
    }
    if (blockIdx.x == 0) {
        for (int rt = c.tid; rt < RCAP / 256; rt += NTHREADS) { int e = -1;
#pragma unroll
            for (int q = 0; q < 8; ++q) if (rt * 256 >= segoff[q] && rt * 256 < segoff[q + 1]) e = q;
            tile_e[rt] = e; }
        if (c.tid == 0) ntiles[0] = segoff[8] / 256;
    }
}
__device__ __forceinline__ void f_combine(const Ctx& c, float* __restrict__ x, const bf16_t* __restrict__ Y, const int* __restrict__ pos, const float* __restrict__ topw) {
    const int stride = c.G * NTHREADS;
    for (int i0 = blockIdx.x * NTHREADS + c.tid; i0 < T * 128; i0 += 4 * stride) {
        int p0[4], p1[4]; float w0[4], w1[4]; bool ok[4];
#pragma unroll
        for (int k = 0; k < 4; ++k) { const int i = i0 + k * stride; ok[k] = i < T * 128; const int t = ok[k] ? (i >> 7) : 0; const int2 pp = *(const int2*)(pos + t * 2); const float2 ww = *(const float2*)(topw + t * 2); p0[k] = pp.x; p1[k] = pp.y; w0[k] = ww.x; w1[k] = ww.y; }
        u32x4 ya[4], yb[4]; f32x4 xa[4], xb[4];
#pragma unroll
        for (int k = 0; k < 4; ++k) { const int i = ok[k] ? i0 + k * stride : 0; const int t = i >> 7, cc = (i & 127) * 8;
            ya[k] = *(const u32x4*)(Y + (size_t)p0[k] * D + cc); yb[k] = *(const u32x4*)(Y + (size_t)p1[k] * D + cc);
            const f32x4* xp = (const f32x4*)(x + (size_t)t * D + cc); xa[k] = xp[0]; xb[k] = xp[1]; }
#pragma unroll
        for (int k = 0; k < 4; ++k) { if (!ok[k]) continue; const int i = i0 + k * stride; const int t = i >> 7, cc = (i & 127) * 8;
            f32x4 a0, a1, b0, b1; unpack8(ya[k], a0, a1); unpack8(yb[k], b0, b1);
            f32x4* xp = (f32x4*)(x + (size_t)t * D + cc);
            xp[0] = xa[k] + a0 * w0[k] + b0 * w1[k]; xp[1] = xb[k] + a1 * w0[k] + b1 * w1[k]; }
    }
}
namespace att {
using s16x4 = __attribute__((ext_vector_type(4))) short;
using f32x16 = __attribute__((ext_vector_type(16))) float;
constexpr int QBLK = 32, KVBLK = 64, SHM_K = 64 * 128  , SHM_V = 64 * 64  , OPITCH = 144  , SHM_ATTN = 8 * 32 * OPITCH;
constexpr float THR = 8.f;
constexpr int ATT_PITCH = 1024;
#define KSWZ(row, colB) ((row) * 256 + ((colB) ^ (((row) & 15) << 4)))
#define SBAR() __builtin_amdgcn_sched_barrier(0)
#define KSWZ8(row, colB) ((row) * 128 + ((colB) ^ ((((row) >> 1) & 7) << 4)))
__device__ __forceinline__ int crow(int r, int hi) { return (r & 3) + 8 * (r >> 2) + 4 * hi; }
__device__ __forceinline__ void cmask(f32x16& p0, f32x16& p1, int jb, int qrel, int hi) {
    const int kb = 64 * jb + 4 * hi;
#pragma unroll
    for (int r = 0; r < 16; ++r) { const int kv = kb + (r & 3) + 8 * (r >> 2); if (kv > qrel) p0[r] = -INFINITY; if (kv + 32 > qrel) p1[r] = -INFINITY; }
}
template <bool FAST>
__device__ __forceinline__ void partialSM(f32x16& p0, f32x16& p1, float& m_reg, float& alpha) {
    if (FAST) {
        alpha = 1.f;
#pragma unroll
        for (int r = 0; r < 16; ++r) p0[r] = __builtin_amdgcn_exp2f(p0[r]);
        return;
    }
    float pmax = p0[0];
#pragma unroll
    for (int r = 1; r < 16; ++r) pmax = fmaxf(pmax, p0[r]);
#pragma unroll
    for (int r = 0; r < 16; ++r) pmax = fmaxf(pmax, p1[r]);
    { auto rr = __builtin_amdgcn_permlane32_swap(__float_as_uint(pmax), __float_as_uint(pmax), false, false); pmax = fmaxf(__uint_as_float(rr[0]), __uint_as_float(rr[1])); }
    float mn;
    if (__builtin_expect(__all(pmax - m_reg <= THR), 1)) { mn = m_reg; alpha = 1.f; }
    else { mn = fmaxf(m_reg, pmax); alpha = __builtin_amdgcn_exp2f(m_reg - mn); m_reg = mn; }
#pragma unroll
    for (int r = 0; r < 16; ++r) { p0[r] = p0[r] - mn; p1[r] = p1[r] - mn; }
#pragma unroll
    for (int r = 0; r < 16; ++r) p0[r] = __builtin_amdgcn_exp2f(p0[r]);
}
__device__ __forceinline__ void partialSM_rel(f32x16& p0, f32x16& p1, float& m_reg, float& alpha) {
    float pmax = p0[0];
#pragma unroll
    for (int r = 1; r < 16; ++r) pmax = fmaxf(pmax, p0[r]);
#pragma unroll
    for (int r = 0; r < 16; ++r) pmax = fmaxf(pmax, p1[r]);
    { auto rr = __builtin_amdgcn_permlane32_swap(__float_as_uint(pmax), __float_as_uint(pmax), false, false); pmax = fmaxf(__uint_as_float(rr[0]), __uint_as_float(rr[1])); }
    if (__builtin_expect(__all(pmax <= THR), 1)) alpha = 1.f;
    else { const float dl = fmaxf(pmax, 0.f); m_reg += dl; alpha = __builtin_amdgcn_exp2f(-dl);
#pragma unroll
        for (int r = 0; r < 16; ++r) { p0[r] -= dl; p1[r] -= dl; } }
#pragma unroll
    for (int r = 0; r < 16; ++r) p0[r] = __builtin_amdgcn_exp2f(p0[r]);
}
__device__ __forceinline__ void finishSM(f32x16& p0, f32x16& p1, float alpha, float& l_reg, bf16x8& pa0, bf16x8& pa1, bf16x8& pa2, bf16x8& pa3) {
#pragma unroll
    for (int r = 0; r < 16; ++r) p1[r] = __builtin_amdgcn_exp2f(p1[r]);
    float ps = 0;
#pragma unroll
    for (int r = 0; r < 16; ++r) ps += p0[r];
#pragma unroll
    for (int r = 0; r < 16; ++r) ps += p1[r];
    { auto rr = __builtin_amdgcn_permlane32_swap(__float_as_uint(ps), __float_as_uint(ps), false, false); ps = __uint_as_float(rr[0]) + __uint_as_float(rr[1]); }
    l_reg = l_reg * alpha + ps;
#define PK4(P, BASE, OUT) do { unsigned a0 = cvt_pk_bf16(P[BASE + 0], P[BASE + 1]), a1 = cvt_pk_bf16(P[BASE + 2], P[BASE + 3]);   \
    unsigned b0 = cvt_pk_bf16(P[BASE + 4], P[BASE + 5]), b1 = cvt_pk_bf16(P[BASE + 6], P[BASE + 7]);                              \
    auto r0 = __builtin_amdgcn_permlane32_swap(a0, b0, false, false); auto r1 = __builtin_amdgcn_permlane32_swap(a1, b1, false, false); \
    u32x4 w = {r0[0], r1[0], r0[1], r1[1]}; OUT = *reinterpret_cast<bf16x8*>(&w); } while (0)
    PK4(p0, 0, pa0); PK4(p0, 8, pa1); PK4(p1, 0, pa2); PK4(p1, 8, pa3);
#undef PK4
}
__device__ __forceinline__ void qkt(f32x16& p0, f32x16& p1, const char* Ks, const bf16x8* qr, int r32, int hi) {
    p0 = f32x16{}; p1 = f32x16{};
#pragma unroll
    for (int d0 = 0; d0 < 6; ++d0) { const int cb = (d0 * 16 + hi * 8) * 2;
        const bf16x8 b0 = *reinterpret_cast<const bf16x8*>(Ks + KSWZ(r32, cb));
        const bf16x8 b1 = *reinterpret_cast<const bf16x8*>(Ks + KSWZ(32 + r32, cb));
        p0 = __builtin_amdgcn_mfma_f32_32x32x16_bf16(b0, qr[d0], p0, 0, 0, 0);
        p1 = __builtin_amdgcn_mfma_f32_32x32x16_bf16(b1, qr[d0], p1, 0, 0, 0); }
}
template <bool ZERO> __device__ __forceinline__ void qkt8(f32x16& p0, f32x16& p1, const char* Ks, const pg8::i32x8v* qf, int r32, int hi, float cinit = 0.f) {
    if constexpr (ZERO) { p0 = f32x16{}; p1 = f32x16{}; } else {
#pragma unroll
    for (int r = 0; r < 16; ++r) { p0[r] = cinit; p1[r] = cinit; } }
#pragma unroll
    for (int sx = 0; sx < 2; ++sx) { const int cb = (2 * sx + hi) * 32;
        const bf16x8 a0 = *reinterpret_cast<const bf16x8*>(Ks + KSWZ8(r32, cb)), a1 = *reinterpret_cast<const bf16x8*>(Ks + KSWZ8(r32, cb + 16));
        const bf16x8 b0 = *reinterpret_cast<const bf16x8*>(Ks + KSWZ8(32 + r32, cb)), b1 = *reinterpret_cast<const bf16x8*>(Ks + KSWZ8(32 + r32, cb + 16));
        p0 = __builtin_amdgcn_mfma_scale_f32_32x32x64_f8f6f4(pg8::cat8(a0, a1), qf[sx], p0, 0, 0, 0, 0, 0, 0);
        p1 = __builtin_amdgcn_mfma_scale_f32_32x32x64_f8f6f4(pg8::cat8(b0, b1), qf[sx], p1, 0, 0, 0, 0, 0, 0); }
}
__device__ __forceinline__ int v_st(int k, int c) { const int kk = (k & ~0xC) | ((k & 4) << 1) | ((k & 8) >> 1); return ((kk >> 3) * 2 + (c >> 5)) * 512 + ((kk & 7) * 32 + (c & 31)) * 2; }
__device__ __forceinline__ int v_rd_base(int lane) { return ((lane & 3) << 3) | (((lane >> 2) & 3) << 6) | (((lane >> 4) & 1) << 5) | (((lane >> 5) & 1) << 8); }
constexpr int v_rd_off(int d0, int ks, int half) { return d0 * 512 + ks * 2048 + half * 1024; }
template <int OFF> __device__ __forceinline__ s16x4 tr_read(int vb) { s16x4 r; asm volatile("ds_read_b64_tr_b16 %0, %1 offset:%2" : "=&v"(r) : "v"(vb), "i"(OFF) : "memory"); return r; }
template <int D0> __device__ __forceinline__ void pv_one(f32x16& od, int vb, bf16x8 pa0, bf16x8 pa1, bf16x8 pa2, bf16x8 pa3) {
    const s16x4 l0 = tr_read<v_rd_off(D0, 0, 0)>(vb), h0 = tr_read<v_rd_off(D0, 0, 1)>(vb), l1 = tr_read<v_rd_off(D0, 1, 0)>(vb), h1 = tr_read<v_rd_off(D0, 1, 1)>(vb);
    const s16x4 l2 = tr_read<v_rd_off(D0, 2, 0)>(vb), h2 = tr_read<v_rd_off(D0, 2, 1)>(vb), l3 = tr_read<v_rd_off(D0, 3, 0)>(vb), h3 = tr_read<v_rd_off(D0, 3, 1)>(vb);
    asm volatile("s_waitcnt lgkmcnt(0)" ::: "memory"); SBAR();
#define PK(L, H) (bf16x8){L[0], L[1], L[2], L[3], H[0], H[1], H[2], H[3]}
    od = __builtin_amdgcn_mfma_f32_32x32x16_bf16(pa0, PK(l0, h0), od, 0, 0, 0);
    od = __builtin_amdgcn_mfma_f32_32x32x16_bf16(pa1, PK(l1, h1), od, 0, 0, 0);
    od = __builtin_amdgcn_mfma_f32_32x32x16_bf16(pa2, PK(l2, h2), od, 0, 0, 0);
    od = __builtin_amdgcn_mfma_f32_32x32x16_bf16(pa3, PK(l3, h3), od, 0, 0, 0);
#undef PK
}
#define VSWZ(d, cB) ((d) * 64 + ((cB) ^ ((((d) >> 2) & 3) << 4)))
__device__ __forceinline__ unsigned pk4_bf8(float a, float b, float c, float d, int old) { const int w = __builtin_amdgcn_cvt_pk_bf8_f32(a, b, old, false); return (unsigned)__builtin_amdgcn_cvt_pk_bf8_f32(c, d, w, true); }
__device__ __forceinline__ void finishSM8(f32x16& p0, f32x16& p1, float alpha, float& l_reg, pg8::i32x8v& pb) {
#pragma unroll
    for (int r = 0; r < 16; ++r) p1[r] = __builtin_amdgcn_exp2f(p1[r]);
    (void)alpha; (void)l_reg;
#pragma unroll
    for (int g = 0; g < 4; ++g) { pb[g] = (int)pk4_bf8(p0[4 * g], p0[4 * g + 1], p0[4 * g + 2], p0[4 * g + 3], pb[g]); pb[4 + g] = (int)pk4_bf8(p1[4 * g], p1[4 * g + 1], p1[4 * g + 2], p1[4 * g + 3], pb[4 + g]); }
}
__device__ __forceinline__ void pv8(f32x16 (&o)[2], f32x16& ol, const char* Vs, const pg8::i32x8v pb, int r32, int hi, const pg8::i32x8v ones) {
    ol = __builtin_amdgcn_mfma_scale_f32_32x32x64_f8f6f4(ones, pb, ol, 0, 1, 0, 0, 0, 0);
#pragma unroll
    for (int dh = 0; dh < 2; ++dh) { const int d = 32 * dh + r32;
        const bf16x8 a0 = *reinterpret_cast<const bf16x8*>(Vs + VSWZ(d, 32 * hi)), a1 = *reinterpret_cast<const bf16x8*>(Vs + VSWZ(d, 32 * hi + 16));
        o[dh] = __builtin_amdgcn_mfma_scale_f32_32x32x64_f8f6f4(pg8::cat8(a0, a1), pb, o[dh], 0  , 1  , 0, 0, 0, 0); }
}
template <bool FAST>
__device__ __forceinline__ void attn_unit(const bf16_t* __restrict__ Qn, const bf16_t* __restrict__ Kn, const bf16_t* __restrict__ Vn, bf16_t* __restrict__ att, const float* __restrict__ gq, const float* __restrict__ rope, int bh, int qb, char* lds, int tid, float cshift) {
    const int wid = __builtin_amdgcn_readfirstlane(tid >> 6), lane = tid & 63, r32 = lane & 31, hi = lane >> 5;
    char* V_lds = lds; char* K_lds = lds + 6 * SHM_V;
    float m_reg = -1e30f, l_reg = 0; f32x16 o[2] = {}, ol = {}; pg8::i32x8v qf[2];
    const int q0 = qb * 256;
    {
        const int bq = bh >> 3, hq = bh & 7, sq = q0 + wid * QBLK + r32;
        const bf16_t* Qw = Qn + ((size_t)bq * SEQ + sq) * 768 + hq * 96 + hi * 8;
        float v[6][8]; float ss = 0.f;
#pragma unroll
        for (int d0 = 0; d0 < 6; ++d0) { f32x4 x0, x1; unpack8(*reinterpret_cast<const u32x4*>(Qw + d0 * 16), x0, x1);
#pragma unroll
            for (int j = 0; j < 4; ++j) { v[d0][j] = x0[j]; v[d0][4 + j] = x1[j]; ss += x0[j] * x0[j] + x1[j] * x1[j]; } }
        { auto rr = __builtin_amdgcn_permlane32_swap(__float_as_uint(ss), __float_as_uint(ss), false, false); ss = __uint_as_float(rr[0]) + __uint_as_float(rr[1]); }
        const float rq = rsqrtf(ss * (1.f / 96.f) + EPS) * ATT_KSC;
#pragma unroll
        for (int d0 = 0; d0 < 6; ++d0) { const f32x4 g0 = *(const f32x4*)(gq + d0 * 16 + hi * 8), g1 = *(const f32x4*)(gq + d0 * 16 + hi * 8 + 4);
#pragma unroll
            for (int j = 0; j < 4; ++j) { v[d0][j] *= rq * g0[j]; v[d0][4 + j] *= rq * g1[j]; } }
        const f32x4* rp = (const f32x4*)(rope + ((size_t)sq * 16 + 8 * hi) * 2);
#pragma unroll
        for (int jj = 0; jj < 4; ++jj) { const f32x4 cs = rp[jj];
#pragma unroll
            for (int k = 0; k < 2; ++k) { const int j = 2 * jj + k; const float c_ = cs[2 * k], s_ = cs[2 * k + 1], x1 = v[4][j], x2 = v[5][j]; v[4][j] = x1 * c_ - x2 * s_; v[5][j] = x2 * c_ + x1 * s_; } }
#pragma unroll
        for (int d0 = 0; d0 < 6; ++d0) { qf[d0 >> 2][2 * (d0 & 3)] = (int)pk4_f8(v[d0][0], v[d0][1], v[d0][2], v[d0][3]); qf[d0 >> 2][2 * (d0 & 3) + 1] = (int)pk4_f8(v[d0][4], v[d0][5], v[d0][6], v[d0][7]); }
        qf[1][4] = (FAST && hi == 0) ? (int)(pk4_f8(-cshift, 0.f, 0.f, 0.f) & 0xffu) : 0; qf[1][5] = 0; qf[1][6] = 0; qf[1][7] = 0;
    }
    const char* Kh = (const char*)Kn + (size_t)bh * SEQ * 128; const char* Vh = (const char*)Vn + (size_t)bh * SEQ * 64;
    const int kst0 = KSWZ8(tid >> 3, (tid & 7) * 16);
    const int vst0 = VSWZ(tid >> 3, (8 * (tid & 7)) & 48) + ((8 * (tid & 7)) & 15);
    struct { uint2 v; bf16x8 k0; } sr_[3];
#define SLOAD(i, t) do { sr_[i].v = *reinterpret_cast<const uint2*>(Vh + (size_t)(t) * (KVBLK * 64) + tid * 8); sr_[i].k0 = *reinterpret_cast<const bf16x8*>(Kh + (size_t)(t) * (KVBLK * 128) + tid * 16); } while (0)
#define SWRITE(b, i) do { *(uint2*)(V_lds + (b) * SHM_V + vst0) = sr_[i].v; \
    *(bf16x8*)(K_lds + (b) * SHM_K + kst0) = sr_[i].k0; } while (0)
#define SWAIT() asm volatile("s_waitcnt vmcnt(2)" ::: "memory")
#define RESC(a) do { if (!FAST && __any((a) < 1.f)) { _Pragma("unroll") for (int d = 0; d < 2; ++d) _Pragma("unroll") for (int r = 0; r < 16; ++r) o[d][r] *= (a); ol[0] *= (a); } } while (0)
#define CMASK(P0, P1, t) do { const int jb_ = (t) - (NT - 4); if (jb_ >= 0) cmask(P0, P1, jb_, qrel, hi); } while (0)
    f32x16 pA0, pA1, pB0, pB1; float alA, alB; pg8::i32x8v pb = {};
    pg8::i32x8v ones; { int o4 = 0x38383838; asm volatile("" : "+v"(o4)); ones = (pg8::i32x8v){o4, o4, o4, o4, o4, o4, o4, o4}; asm volatile("" : "+v"(ones)); }
    const int NT = (q0 + 256) / KVBLK; const int qrel = wid * QBLK + r32;
    SLOAD(0, 0); SLOAD(1, 1); SLOAD(2, 2);     asm volatile("s_waitcnt vmcnt(4)" ::: "memory"); SWRITE(1, 0); __syncthreads();
    qkt8<true>(pA0, pA1, K_lds + SHM_K, qf, r32, hi); CMASK(pA0, pA1, 0); partialSM<FAST>(pA0, pA1, m_reg, alA);
    asm volatile("s_waitcnt vmcnt(0)" ::: "memory"); SWRITE(2, 1); SWRITE(3, 2);
    if (3 < NT) SLOAD(0, 3); if (4 < NT) SLOAD(1, 4);
    __syncthreads();
#define ILV4() do { __builtin_amdgcn_sched_group_barrier(0x100, 4, 0); __builtin_amdgcn_sched_group_barrier(0x008, 1, 0); __builtin_amdgcn_sched_group_barrier(0x400, 4, 0); __builtin_amdgcn_sched_group_barrier(0x100, 2, 0); __builtin_amdgcn_sched_group_barrier(0x008, 1, 0); __builtin_amdgcn_sched_group_barrier(0x400, 4, 0); __builtin_amdgcn_sched_group_barrier(0x100, 2, 0); __builtin_amdgcn_sched_group_barrier(0x008, 1, 0); __builtin_amdgcn_sched_group_barrier(0x400, 4, 0); __builtin_amdgcn_sched_group_barrier(0x008, 1, 0); __builtin_amdgcn_sched_group_barrier(0x400, 4, 0); } while (0)
#define ILV3() do { __builtin_amdgcn_sched_group_barrier(0x008, 1, 0); __builtin_amdgcn_sched_group_barrier(0x100, 4, 0); __builtin_amdgcn_sched_group_barrier(0x400, 4, 0); __builtin_amdgcn_sched_group_barrier(0x008, 1, 0); __builtin_amdgcn_sched_group_barrier(0x400, 6, 0); __builtin_amdgcn_sched_group_barrier(0x008, 1, 0); __builtin_amdgcn_sched_group_barrier(0x400, 6, 0); } while (0)
    int z0 = 0, z1 = 1, z2 = 2;
    for (int j = 1; j + 1 < NT; j += 2) {
        SBAR(); qkt8<FAST>(pB0, pB1, K_lds + (2 * z1) * SHM_K, qf, r32, hi, -m_reg);
        finishSM8(pA0, pA1, alA, l_reg, pb); ILV4(); SBAR(); CMASK(pB0, pB1, j); SBAR();
        pv8(o, ol, V_lds + (2 * z0 + 1) * SHM_V, pb, r32, hi, ones); if constexpr (FAST) { partialSM<true>(pB0, pB1, m_reg, alB); ILV3(); } else partialSM_rel(pB0, pB1, m_reg, alB);
        RESC(alB);
        SBAR(); qkt8<FAST>(pA0, pA1, K_lds + (2 * z1 + 1) * SHM_K, qf, r32, hi, -m_reg);
        finishSM8(pB0, pB1, alB, l_reg, pb); ILV4(); SBAR(); CMASK(pA0, pA1, j + 1); SBAR();
        pv8(o, ol, V_lds + (2 * z1) * SHM_V, pb, r32, hi, ones); if constexpr (FAST) { partialSM<true>(pA0, pA1, m_reg, alA); ILV3(); } else partialSM_rel(pA0, pA1, m_reg, alA);
        asm volatile("s_waitcnt vmcnt(0)" ::: "memory"); SWRITE(2 * z2, 0); SWRITE(2 * z2 + 1, 1);
        if (j + 4 < NT) SLOAD(0, j + 4); if (j + 5 < NT) SLOAD(1, j + 5);
        RESC(alA); __syncthreads();
        { const int t0_ = z0; z0 = z1; z1 = z2; z2 = t0_; }
    }
    SBAR(); qkt8<FAST>(pB0, pB1, K_lds + (2 * z1) * SHM_K, qf, r32, hi, -m_reg); CMASK(pB0, pB1, NT - 1);
    finishSM8(pA0, pA1, alA, l_reg, pb); SBAR();
    pv8(o, ol, V_lds + (2 * z0 + 1) * SHM_V, pb, r32, hi, ones); if constexpr (FAST) partialSM<true>(pB0, pB1, m_reg, alB); else partialSM_rel(pB0, pB1, m_reg, alB);
    RESC(alB);
    finishSM8(pB0, pB1, alB, l_reg, pb); SBAR();
    pv8(o, ol, V_lds + (2 * z1) * SHM_V, pb, r32, hi, ones);
    __syncthreads();
    { const float rl = __builtin_amdgcn_rcpf(ol[0]); char* img = lds + wid * (32 * OPITCH);
#pragma unroll
      for (int dh = 0; dh < 2; ++dh)
#pragma unroll
        for (int g = 0; g < 4; ++g) *(uint2*)(img + r32 * OPITCH + (32 * dh + 8 * g + 4 * hi) * 2) = make_uint2(cvt_pk_bf16(o[dh][4 * g] * rl, o[dh][4 * g + 1] * rl), cvt_pk_bf16(o[dh][4 * g + 2] * rl, o[dh][4 * g + 3] * rl));
      asm volatile("s_waitcnt lgkmcnt(0)" ::: "memory");
      const int b = bh >> 3, h = bh & 7;
      bf16_t* Ow = att + ((size_t)b * SEQ + q0 + wid * QBLK) * ATT_PITCH + h * 64;
#pragma unroll
      for (int p = 0; p < 4; ++p) { const int qr_ = 8 * p + (lane >> 3), cch = lane & 7; *(u32x4*)(Ow + (size_t)qr_ * ATT_PITCH + 8 * cch) = *(const u32x4*)(img + qr_ * OPITCH + 16 * cch); } }
    __syncthreads();
#undef SLOAD
#undef SWRITE
#undef SWAIT
#undef RESC
#undef CMASK
}
#undef KSWZ
#undef KSWZ8
#undef VSWZ
#undef SBAR
}
__device__ __forceinline__ void f_attn_part(const Ctx& c, const bf16_t* Qn, const bf16_t* Kn, const bf16_t* Vn, bf16_t* att_out, const float* gq, const float* rope, int part, bool fast, float cshift) {
    const int bx = blockIdx.x, G = c.G;
    const int vcu = (G % 8 == 0) ? (bx % 8) * (G / 8) + bx / 8 : bx;
    for (int p = vcu; p < 256; p += G) {
        const int bh = p >> 4, j = p & 15;
        int tid_ = c.tid; asm volatile("" : "+v"(tid_));
        if (fast) att::attn_unit<true>(Qn, Kn, Vn, att_out, gq, rope, bh, part ? j : 31 - j, (char*)c.lds, tid_, cshift);
        else att::attn_unit<false>(Qn, Kn, Vn, att_out, gq, rope, bh, part ? j : 31 - j, (char*)c.lds, tid_, 0.f);
    }
}
__device__ __forceinline__ float attn_score_bound(const Ctx& c, const float* __restrict__ gq, const float* __restrict__ gk) {
    float mq = 0.f, mk = 0.f;
    for (int i = c.lane; i < QKD; i += 64) { mq = fmaxf(mq, fabsf(gq[i])); mk = fmaxf(mk, fabsf(gk[i])); }
#pragma unroll
    for (int o = 1; o < 64; o <<= 1) { mq = fmaxf(mq, bperm(mq, c.lane ^ o)); mk = fmaxf(mk, bperm(mk, c.lane ^ o)); }
    return __builtin_bit_cast(float, __builtin_amdgcn_readfirstlane(__builtin_bit_cast(int, 14.1358f * mq * mk)));
}
typedef float f32x2_ __attribute__((ext_vector_type(2)));
constexpr int S5_MT_ELEMS = 256 * 384, S5_W_ELEMS = 128 * 256, S5_APITCH = 784;
__device__ __forceinline__ void s5_tables(const Ctx& c, int g, const float* __restrict__ lam_re, const float* __restrict__ lam_im, const float* __restrict__ log_step, const float* __restrict__ b_re, const float* __restrict__ b_im,
                                          const float* __restrict__ c_re, const float* __restrict__ c_im, bf16_t* __restrict__ MT, bf16_t* __restrict__ W, float* __restrict__ LB16) {
    LAS f32x2_* pw = (LAS f32x2_*)c.lds;
    LAS f32x2_* Bb = pw + 17 * 64;
    LAS f32x2_* Cm = Bb + 64 * 16;
    LAS float* Kt = (LAS float*)(Cm + 16 * 64);
    const int tid = c.tid;
    if (tid < 64) {
        const int p = tid;
        const float lre = lam_re[g * 64 + p], lim = lam_im[g * 64 + p], st = __expf(log_step[g]);
        const float mag = __expf(lre * st);
        float sn, cs; sincos_rev((double)lim * (double)st * 0.15915494309189535, sn, cs);
        const float lbr = mag * cs, lbi = mag * sn;
        const float nr = lbr - 1.f, ni = lbi, den = 1.f / (lre * lre + lim * lim);
        const float cr = (nr * lre + ni * lim) * den, ci = (ni * lre - nr * lim) * den;
        float pr = 1.f, pi = 0.f;
        for (int tau = 0; tau <= 16; ++tau) { pw[tau * 64 + p] = (f32x2_){pr, pi}; const float nr2 = pr * lbr - pi * lbi, ni2 = pr * lbi + pi * lbr; pr = nr2; pi = ni2; }
        const f32x2_ l16 = pw[16 * 64 + p]; LB16[(g * 64 + p) * 2] = l16.x; LB16[(g * 64 + p) * 2 + 1] = l16.y;
        for (int k = 0; k < 16; ++k) { const float br = b_re[(g * 64 + p) * 16 + k], bi = b_im[(g * 64 + p) * 16 + k]; Bb[p * 16 + k] = (f32x2_){cr * br - ci * bi, cr * bi + ci * br};
            Cm[k * 64 + p] = (f32x2_){c_re[(g * 16 + k) * 64 + p], c_im[(g * 16 + k) * 64 + p]}; }
    }
    __syncthreads();
    {
        const int tau = tid >> 5, cc = (tid >> 1) & 15, hf = tid & 1;
        float s8[8];
#pragma unroll
        for (int j = 0; j < 8; ++j) s8[j] = 0.f;
        for (int p = 0; p < 64; ++p) { const f32x2_ cm = Cm[cc * 64 + p], w = pw[tau * 64 + p]; const float ar = cm.x * w.x - cm.y * w.y, ai = cm.x * w.y + cm.y * w.x;
            const LAS f32x4* bp = (const LAS f32x4*)(Bb + p * 16 + 8 * hf);
#pragma unroll
            for (int j2 = 0; j2 < 4; ++j2) { const f32x4 b = bp[j2]; s8[2 * j2] += ar * b[0] - ai * b[1]; s8[2 * j2 + 1] += ar * b[2] - ai * b[3]; } }
#pragma unroll
        for (int j = 0; j < 8; ++j) Kt[(tau << 8) + (cc << 4) + 8 * hf + j] = s8[j];
    }
    __syncthreads();
    {
        const int lane = c.lane, w8 = c.wave;
        for (int n = w8; n < 256; n += 8) { const int j = n >> 4, cc = n & 15; bf16_t* row = MT + (size_t)n * 384;
#pragma unroll
            for (int q = 0; q < 2; ++q) { const int k = 2 * (lane + 64 * q), sx = k >> 4, c2 = k & 15;
                f32x2_ v = (f32x2_){0.f, 0.f}; if (sx <= j) v = *(const LAS f32x2_*)(Kt + ((j - sx) << 8) + (cc << 4) + c2);
                *(unsigned*)(row + k) = f2bf(v.x) | (f2bf(v.y) << 16); }
            { const int kk = 2 * lane, ri = kk >> 6, p = kk & 63; const LAS f32x4* cp = (const LAS f32x4*)(Cm + cc * 64 + p); const LAS f32x4* wp = (const LAS f32x4*)(pw + (j + 1) * 64 + p); const f32x4 cm = cp[0], w = wp[0];
              const float v0 = ri ? -(cm[0] * w[1] + cm[1] * w[0]) : (cm[0] * w[0] - cm[1] * w[1]), v1 = ri ? -(cm[2] * w[3] + cm[3] * w[2]) : (cm[2] * w[2] - cm[3] * w[3]);
              *(unsigned*)(row + 256 + kk) = f2bf(v0) | (f2bf(v1) << 16); } }
        for (int n = w8; n < 128; n += 8) { const int ri = n >> 6, p = n & 63; bf16_t* row = W + (size_t)n * 256;
#pragma unroll
            for (int q = 0; q < 2; ++q) { const int k = 2 * (lane + 64 * q), sx = k >> 4, c2 = k & 15; const f32x2_ w = pw[(15 - sx) * 64 + p]; const f32x4 b = *(const LAS f32x4*)(Bb + p * 16 + c2);
                const float v0 = ri ? (w.x * b[1] + w.y * b[0]) : (w.x * b[0] - w.y * b[1]), v1 = ri ? (w.x * b[3] + w.y * b[2]) : (w.x * b[2] - w.y * b[3]);
                *(unsigned*)(row + k) = f2bf(v0) | (f2bf(v1) << 16); } }
    }
    __syncthreads();
}
__device__ __forceinline__ void s5_stage(const Ctx& c, const bf16_t* __restrict__ U, const bf16_t* __restrict__ xin, int b, int blk, int g, int loff = 0) {
#pragma unroll
    for (int i = 0; i < 4; ++i) { const int q = c.tid + NTHREADS * i, m = q >> 5, w = q & 31;
        const u32x4 v = *(const u32x4*)(U + ((size_t)b * SEQ + (blk * 64 + m) * 16 + (w >> 1)) * 512 + 16 * g + 8 * (w & 1));
        *(LAS u32x4*)(c.lds + loff + m * S5_APITCH + w * 16) = v; }
    if (xin) {
#pragma unroll
        for (int i = 0; i < 2; ++i) { const int q = c.tid + NTHREADS * i, m = q >> 4, w = q & 15;
            const u32x4 v = *(const u32x4*)(xin + (((size_t)b * 512 + blk * 64 + m) * 32 + g) * 128 + 8 * w);
            *(LAS u32x4*)(c.lds + loff + m * S5_APITCH + 512 + w * 16) = v; }
    }
}
__device__ __forceinline__ void f_s5_e(const Ctx& c, const bf16_t* __restrict__ U, const bf16_t* __restrict__ Wt, float* __restrict__ E) {
    const int lane = c.lane, r16 = lane & 15, q = lane >> 4, w = c.wave;
    if (c.G == 256) {
        const int it = blockIdx.x, g = it & 31, blk = (it >> 5) & 7; constexpr int T2 = 64 * S5_APITCH;
        s5_stage(c, U, nullptr, 0, blk, g, 0); s5_stage(c, U, nullptr, 1, blk, g, T2);
        const bf16_t* wp = Wt + (size_t)g * S5_W_ELEMS + (16 * w + r16) * 256 + 8 * q;
        bf16x8 bfr8[8];
#pragma unroll
        for (int ks = 0; ks < 8; ++ks) bfr8[ks] = *(const bf16x8*)(wp + 32 * ks);
        __syncthreads();
#pragma unroll
        for (int bb = 0; bb < 2; ++bb) { f32x4 acc[4];
#pragma unroll
            for (int mt = 0; mt < 4; ++mt) acc[mt] = (f32x4){0.f, 0.f, 0.f, 0.f};
#pragma unroll
            for (int ks = 0; ks < 8; ++ks)
#pragma unroll
                for (int mt = 0; mt < 4; ++mt) { const bf16x8 a = *(const LAS bf16x8*)(c.lds + bb * T2 + (16 * mt + r16) * S5_APITCH + (32 * ks + 8 * q) * 2); acc[mt] = __builtin_amdgcn_mfma_f32_16x16x32_bf16(a, bfr8[ks], acc[mt], 0, 0, 0); }
#pragma unroll
            for (int mt = 0; mt < 4; ++mt)
#pragma unroll
                for (int r = 0; r < 4; ++r) E[(((size_t)bb * 512 + blk * 64 + 16 * mt + 4 * q + r) * 32 + g) * 128 + 16 * w + r16] = acc[mt][r]; }
        __syncthreads();
        return;
    }
    for (int it = blockIdx.x; it < 512; it += c.G) {
        const int g = it & 31, blk = (it >> 5) & 7, b = it >> 8;
        s5_stage(c, U, nullptr, b, blk, g);
        __syncthreads();
        f32x4 acc[4];
#pragma unroll
        for (int mt = 0; mt < 4; ++mt) acc[mt] = (f32x4){0.f, 0.f, 0.f, 0.f};
        const bf16_t* wp = Wt + (size_t)g * S5_W_ELEMS + (16 * w + r16) * 256 + 8 * q;
#pragma unroll
        for (int ks = 0; ks < 8; ++ks) {
            const bf16x8 bfr = *(const bf16x8*)(wp + 32 * ks);
#pragma unroll
            for (int mt = 0; mt < 4; ++mt) { const bf16x8 a = *(const LAS bf16x8*)(c.lds + (16 * mt + r16) * S5_APITCH + (32 * ks + 8 * q) * 2); acc[mt] = __builtin_amdgcn_mfma_f32_16x16x32_bf16(a, bfr, acc[mt], 0, 0, 0); }
        }
#pragma unroll
        for (int mt = 0; mt < 4; ++mt)
#pragma unroll
            for (int r = 0; r < 4; ++r) E[(((size_t)b * 512 + blk * 64 + 16 * mt + 4 * q + r) * 32 + g) * 128 + 16 * w + r16] = acc[mt][r];
        __syncthreads();
    }
}
__device__ __forceinline__ void f_s5_scan(const Ctx& c, const float* __restrict__ E, const float* __restrict__ LB16, bf16_t* __restrict__ xin) {
    LAS f32x2_* Ssh = (LAS f32x2_*)c.lds;
    for (int bg = blockIdx.x; bg < BATCH * S5G; bg += c.G) {
        const int b = bg / S5G, g = bg % S5G, p = c.lane, seg = c.wave;
        const float lr = LB16[(g * 64 + p) * 2], li = LB16[(g * 64 + p) * 2 + 1];
        const float* ep = E + (((size_t)b * 512 + seg * 64) * 32 + g) * 128 + p; bf16_t* xp = xin + (((size_t)b * 512 + seg * 64) * 32 + g) * 128 + p;
        float er[64], ei[64];
#pragma unroll
        for (int i = 0; i < 64; ++i) { er[i] = ep[(size_t)i * 4096]; ei[i] = ep[(size_t)i * 4096 + 64]; }
        float xr = 0.f, xi = 0.f;
#pragma unroll
        for (int i = 0; i < 64; ++i) { const float nr = lr * xr - li * xi + er[i], ni = lr * xi + li * xr + ei[i]; er[i] = xr; ei[i] = xi; xr = nr; xi = ni; }
        Ssh[seg * 64 + p] = (f32x2_){xr, xi};
        float qr = lr, qi = li;
#pragma unroll
        for (int k = 0; k < 6; ++k) { const float nr = qr * qr - qi * qi, ni = 2.f * qr * qi; qr = nr; qi = ni; }
        __syncthreads();
        float cr = 0.f, ci = 0.f;
        for (int s2 = 0; s2 < seg; ++s2) { const f32x2_ sv = Ssh[s2 * 64 + p]; const float nr = qr * cr - qi * ci + sv.x, ni = qr * ci + qi * cr + sv.y; cr = nr; ci = ni; }
        float fr = 1.f, fi = 0.f;
#pragma unroll
        for (int i = 0; i < 64; ++i) { const float vr = er[i] + fr * cr - fi * ci, vi = ei[i] + fr * ci + fi * cr;
            xp[(size_t)i * 4096] = (bf16_t)f2bf(vr); xp[(size_t)i * 4096 + 64] = (bf16_t)f2bf(vi);
            const float nr = fr * lr - fi * li, ni = fr * li + fi * lr; fr = nr; fi = ni; }
        __syncthreads();
    }
}
__device__ __forceinline__ void f_s5_y(const Ctx& c, const bf16_t* __restrict__ U, const bf16_t* __restrict__ xin, const bf16_t* __restrict__ MTt, const float* __restrict__ dsk, bf16_t* __restrict__ YG) {
    const int lane = c.lane, r16 = lane & 15, q = lane >> 4, w = c.wave;
    if (c.G == 256) {
        const int it = blockIdx.x, g = it & 31, blk = (it >> 5) & 7; constexpr int T2 = 64 * S5_APITCH;
        s5_stage(c, U, xin, 0, blk, g, 0); s5_stage(c, U, xin, 1, blk, g, T2);
        const bf16_t* mp = MTt + (size_t)g * S5_MT_ELEMS + (32 * w + r16) * 384 + 8 * q;
        bf16x8 b0[12], b1[12];
#pragma unroll
        for (int ks = 0; ks < 12; ++ks) { b0[ks] = (bf16x8){0, 0, 0, 0, 0, 0, 0, 0}; b1[ks] = b0[ks]; if (ks <= w || ks >= 8) { b0[ks] = *(const bf16x8*)(mp + 32 * ks); b1[ks] = *(const bf16x8*)(mp + 16 * 384 + 32 * ks); } }
        const float dk = dsk[16 * g + r16];
        __syncthreads();
#pragma unroll
        for (int bb = 0; bb < 2; ++bb) { f32x4 acc[4][2];
#pragma unroll
            for (int mt = 0; mt < 4; ++mt) { acc[mt][0] = (f32x4){0.f, 0.f, 0.f, 0.f}; acc[mt][1] = (f32x4){0.f, 0.f, 0.f, 0.f}; }
#pragma unroll
            for (int ks = 0; ks < 12; ++ks) {
                if (ks <= w || ks >= 8) {
#pragma unroll
                    for (int mt = 0; mt < 4; ++mt) { const bf16x8 a = *(const LAS bf16x8*)(c.lds + bb * T2 + (16 * mt + r16) * S5_APITCH + (32 * ks + 8 * q) * 2);
                        acc[mt][0] = __builtin_amdgcn_mfma_f32_16x16x32_bf16(a, b0[ks], acc[mt][0], 0, 0, 0); acc[mt][1] = __builtin_amdgcn_mfma_f32_16x16x32_bf16(a, b1[ks], acc[mt][1], 0, 0, 0); }
                }
            }
#pragma unroll
            for (int mt = 0; mt < 4; ++mt)
#pragma unroll
                for (int jj = 0; jj < 2; ++jj)
#pragma unroll
                    for (int r = 0; r < 4; ++r) { const int m = 16 * mt + 4 * q + r, j = 2 * w + jj;
                        const float uv = bf2f(*(const LAS bf16_t*)(c.lds + bb * T2 + m * S5_APITCH + (16 * j + r16) * 2));
                        YG[((size_t)bb * SEQ + (blk * 64 + m) * 16 + j) * 512 + 16 * g + r16] = (bf16_t)f2bf(gelu_tanh(acc[mt][jj][r] + dk * uv)); } }
        __syncthreads();
        return;
    }
    for (int it = blockIdx.x; it < 512; it += c.G) {
        const int g = it & 31, blk = (it >> 5) & 7, b = it >> 8;
        s5_stage(c, U, xin, b, blk, g);
        f32x4 acc[4][2];
#pragma unroll
        for (int mt = 0; mt < 4; ++mt) { acc[mt][0] = (f32x4){0.f, 0.f, 0.f, 0.f}; acc[mt][1] = (f32x4){0.f, 0.f, 0.f, 0.f}; }
        const bf16_t* mp = MTt + (size_t)g * S5_MT_ELEMS + (32 * w + r16) * 384 + 8 * q;
        bf16x8 b0[12], b1[12];
#pragma unroll
        for (int ks = 0; ks < 12; ++ks) { b0[ks] = (bf16x8){0, 0, 0, 0, 0, 0, 0, 0}; b1[ks] = b0[ks]; if (ks <= w || ks >= 8) { b0[ks] = *(const bf16x8*)(mp + 32 * ks); b1[ks] = *(const bf16x8*)(mp + 16 * 384 + 32 * ks); } }
        __syncthreads();
#pragma unroll
        for (int ks = 0; ks < 12; ++ks) {
            if (ks <= w || ks >= 8) {
#pragma unroll
                for (int mt = 0; mt < 4; ++mt) { const bf16x8 a = *(const LAS bf16x8*)(c.lds + (16 * mt + r16) * S5_APITCH + (32 * ks + 8 * q) * 2);
                    acc[mt][0] = __builtin_amdgcn_mfma_f32_16x16x32_bf16(a, b0[ks], acc[mt][0], 0, 0, 0); acc[mt][1] = __builtin_amdgcn_mfma_f32_16x16x32_bf16(a, b1[ks], acc[mt][1], 0, 0, 0); }
            }
        }
        const float dk = dsk[16 * g + r16];
#pragma unroll
        for (int mt = 0; mt < 4; ++mt)
#pragma unroll
            for (int jj = 0; jj < 2; ++jj)
#pragma unroll
                for (int r = 0; r < 4; ++r) { const int m = 16 * mt + 4 * q + r, j = 2 * w + jj;
                    const float uv = bf2f(*(const LAS bf16_t*)(c.lds + m * S5_APITCH + (16 * j + r16) * 2));
                    YG[((size_t)b * SEQ + (blk * 64 + m) * 16 + j) * 512 + 16 * g + r16] = (bf16_t)f2bf(gelu_tanh(acc[mt][jj][r] + dk * uv)); }
        __syncthreads();
    }
}
#ifndef REP_PRO
#define REP_PRO 1
#endif
#ifndef REP_P2
#define REP_P2 1
#endif
#ifndef REP_HEADS
#define REP_HEADS 1
#endif
#ifndef REP_ATTN
#define REP_ATTN 1
#endif
#ifndef REP_S5Y
#define REP_S5Y 1
#endif
#ifndef REP_GLU
#define REP_GLU 1
#endif
#ifndef REP_MIXB
#define REP_MIXB 1
#endif
#ifndef REP_FFN1
#define REP_FFN1 1
#endif
#ifndef REP_ROUTE1
#define REP_ROUTE1 1
#endif
#ifndef REP_ROUTE2
#define REP_ROUTE2 1
#endif
#ifndef REP_GEMM1
#define REP_GEMM1 1
#endif
#ifndef REP_GEMM2
#define REP_GEMM2 1
#endif
#ifndef PROBE_ONLINE
#define PROBE_ONLINE 0
#endif
#ifndef PROBE_MASK
#define PROBE_MASK 0ull
#endif
#ifndef PROBE_BAR
#define PROBE_BAR 0
#endif
struct Args { const float* in[32]; float* out; unsigned char* ws; int ph_lo, ph_hi; };
constexpr size_t WS_CTL = 0, CTL_ZERO_BYTES = 2 * MiB;
constexpr int CW_BAR = 4096;
constexpr size_t WS_XSSM = 64 * 1024, WS_XSSF = WS_XSSM + 2 * 131072, WS_QSS = WS_XSSF + 2 * 131072, WS_KVSS = WS_QSS + 2 * 131072, WS_KRSS = WS_KVSS + 2 * 131072, WS_TICKETS = WS_KRSS + 65536;
constexpr size_t WS_SCANCNT = 48 * 1024;
constexpr size_t WS_XB = 2 * MiB;
constexpr size_t WS_WGLU = 34 * MiB, WS_WPA = 35 * MiB, WS_WPS = 37 * MiB, WS_WOUT = 39 * MiB, WS_S5MT = 43 * MiB, WS_S5LB = 55 * MiB, WS_BIASL = 56 * MiB, WS_GA = 57 * MiB, WS_GB = 89 * MiB, WS_QRAW = 121 * MiB  , WS_K = 145 * MiB,
    WS_U = 169 * MiB, WS_V = 185 * MiB, WS_ATT = 201 * MiB  , WS_S5X = 233 * MiB;
constexpr size_t WS_MIX = 153 * MiB, WS_HD = 57 * MiB;
constexpr size_t WS_WIN = 241 * MiB, WS_WUQ = 253 * MiB, WS_WUKV = 254 * MiB, WS_WFGU = 255 * MiB, WS_WFD = 266 * MiB, WS_S5W = 272 * MiB, WS_QLAT = 276 * MiB, WS_KVLAT = 284 * MiB, WS_YG = 276 * MiB  , WS_ROPE = 292 * MiB, WS_KVRAW = 316 * MiB, WS_S5E = 365 * MiB  ;
constexpr size_t WS_WMGU = 309 * MiB, WS_WMD = 421 * MiB, WS_H1 = 34 * MiB, WS_YB = 309 * MiB, WS_MT = 303 * MiB, WS_TOPE = WS_MT, WS_TOPW = WS_MT + 256 * 1024, WS_RANK = WS_MT + 512 * 1024, WS_CNT = WS_MT + 768 * 1024,
    WS_TILEE = WS_MT + 800 * 1024, WS_NTILES = WS_MT + 804 * 1024, WS_POS = 304 * MiB, WS_ROWTOK = 305 * MiB, WS_RROW = 306 * MiB, WS_SLAB = 185 * MiB  , WS_WIN8 = 381 * MiB  , WS_XB8 = 185 * MiB  , WS_END = 477 * MiB;

constexpr int MOE_TILES = NE * (D / 64) * (FFE / 64) * 3, MOE_S0 = 2048, MOE_S1 = MOE_S0 + 4096, MOE_S2 = MOE_S1 + 2048;
#define MOE_SLICE(lo_, hi_) do { if (c.G == 256 && bid >= 128) { __syncthreads(); Ctx cj_ = c; cj_.lane = hw_lane(); cj_.tid = cj_.wave * 64 + cj_.lane; { const Ctx& c = cj_; ConvDist cd_{c.gw - 128 * NWAVES, 128 * NWAVES, 0, (lo_), (hi_)}; JOB_MOE(); } __syncthreads(); } } while (0)
constexpr int TAIL_NSL7 = 7;
constexpr int TAIL_NSL = 2;
#define CONV_SCR(c) ((LAS float*)((c).lds + (c).wave * CONV_SCR_BYTES))
#define JOB_MIXER(l) do { \
    conv_proj(c, cd_, CONV_SCR(c), IN(2) + (size_t)(l) * D * INC, WSP(bf16_t, WS_WIN) + (size_t)(l) * 3072 * D, IN(1) + (l) * D); \
    conv_plain<true>(c, cd_, CONV_SCR(c), IN(2) + (size_t)(l) * D * INC + 928, D, 2048, WSP(bf16_t, WS_WIN8) + (size_t)(l) * 2048 * (D / 2), D, IN(1) + (l) * D, 64.f, INC); \
    conv_plain(c, cd_, CONV_SCR(c), IN(5) + (size_t)(l) * QLR * 768, QLR, 768, WSP(bf16_t, WS_WUQ) + (size_t)(l) * 768 * 256, 256, IN(4) + (l) * QLR); \
    conv_kv(c, cd_, CONV_SCR(c), IN(7) + (size_t)(l) * KVLR * 1024, WSP(bf16_t, WS_WUKV) + (size_t)(l) * 1024 * 256, IN(6) + (l) * KVLR); \
    conv_plain(c, cd_, CONV_SCR(c), IN(18) + (size_t)(l) * 512 * 512, 512, 512, WSP(bf16_t, WS_WGLU) + (size_t)(l) * 512 * 512, 512, nullptr); \
    conv_plain_at(c, cd_, CONV_SCR(c), IN(20) + (size_t)(l) * 512 * 1024, 512, 1024, WSP(bf16_t, WS_WPA) + (size_t)(l) * 1024 * 1024, 1024, 0); \
    conv_plain_at(c, cd_, CONV_SCR(c), IN(21) + (size_t)(l) * 512 * 1024, 512, 1024, WSP(bf16_t, WS_WPA) + (size_t)(l) * 1024 * 1024, 1024, 512); \
    conv_plain(c, cd_, CONV_SCR(c), IN(22) + (size_t)(l) * D * D, D, D, WSP(bf16_t, WS_WOUT) + (size_t)(l) * D * D, D, nullptr); \
    for (int i_ = blockIdx.x * NTHREADS + c.tid; i_ < 3072; i_ += c.G * NTHREADS) { const int s_ = proj_src(i_); WSP(float, WS_BIASL)[(l) * 3072 + i_] = s_ >= 0 ? IN(3)[(l) * INC + s_] : 0.f; } } while (0)
#define JOB_FFN() do { conv_gateup(c, cd_, CONV_SCR(c), IN(24), IN(25), FFD, WSP(bf16_t, WS_WFGU), IN(23), 1); conv_plain(c, cd_, CONV_SCR(c), IN(26), FFD, D, WSP(bf16_t, WS_WFD), FFD, nullptr); } while (0)
#define JOB_MOE() do { conv_gateup<true>(c, cd_, CONV_SCR(c), IN(29), IN(30), FFE, WSP(bf16_t, WS_WMGU), IN(23) + D, NE, MOE_WGU_SCALE); conv_plain_n<true>(c, cd_, CONV_SCR(c), IN(31), FFE, D, WSP(bf16_t, WS_WMD), NE, MOE_WD_SCALE); } while (0)

__global__ void __launch_bounds__(NTHREADS, 2) mk_fwd(Args a) {
    extern __shared__ __attribute__((aligned(16))) unsigned char lds_raw[];
    Ctx c0; c0.lds = (LAS unsigned char*)lds_raw;
    c0.tid = threadIdx.x; c0.lane = c0.tid & 63; c0.wave = __builtin_amdgcn_readfirstlane(c0.tid >> 6); c0.G = gridDim.x; c0.gw = blockIdx.x * NWAVES + c0.wave; c0.NGW = c0.G * NWAVES;
    volatile LAS unsigned* MISC = (volatile LAS unsigned*)(c0.lds + LDSCTL_OFF);
    for (int u = c0.tid; u < (LDS_BYTES - LDSCTL_OFF) / 4; u += NTHREADS) ((LAS unsigned*)(c0.lds + LDSCTL_OFF))[u] = 0u;
    __syncthreads();
    unsigned char* ws0 = a.ws;
    XcdBarrier bar = xcd_barrier_post((unsigned*)(ws0 + WS_CTL) + CW_BAR, MISC + 8); bar.w = (unsigned)c0.wave;
    const int lo = a.ph_lo, hi = a.ph_hi; int ph = 0;
    volatile LAS unsigned long long* PRB = (volatile LAS unsigned long long*)(c0.lds + LDSCTL_OFF + 128);
#define PH_BEGIN if (ph >= lo && ph < hi) { if (PROBE_MASK != 0ull && ((PROBE_MASK >> ph) & 1ull)) PRB[1] = __builtin_amdgcn_s_memrealtime(); Ctx c = c0; c.lane = hw_lane(); asm volatile("" : "+s"(c.wave), "+s"(c.gw), "+s"(c.G), "+s"(c.NGW)); c.tid = c.wave * 64 + c.lane; unsigned char* ws = ws0; asm volatile("" : "+s"(ws)); float* X = a.out; asm volatile("" : "+s"(X)); const int bid = __builtin_amdgcn_readfirstlane(blockIdx.x);
#define PH_END if (PROBE_MASK != 0ull && ((PROBE_MASK >> ph) & 1ull)) { __syncthreads(); if ((c0.wave == 0 && hw_lane() == 0)) PRB[0] = PRB[0] + (__builtin_amdgcn_s_memrealtime() - PRB[1]); } if (PROBE_BAR && (c0.wave == 0 && hw_lane() == 0)) PRB[1] = __builtin_amdgcn_s_memrealtime(); if (ph + 1 < hi) xcd_barrier(bar); if (PROBE_BAR && (c0.wave == 0 && hw_lane() == 0)) PRB[0] = PRB[0] + (__builtin_amdgcn_s_memrealtime() - PRB[1]); } ++ph;
#define IN(k) ({ const float* p_ = a.in[k]; asm volatile("" : "+s"(p_)); p_; })
#define WSP(type, off) ((type*)(ws + (off)))
#define COMMA ,
#define GEMM(EpiT, Aptr, Bptr, N_, K_, ...) do { pg8::Gemm g_{(const pg8::bf16_t*)(Aptr), (const pg8::bf16_t*)(Bptr), T, (N_), (K_), (K_)}; pg8::StaticOrder S_; S_.init(T, (N_), c.G, bid); EpiT E_{__VA_ARGS__}; \
        int tid_ = c.tid; asm volatile("" : "+v"(tid_)); pg8::gemm_phase<EpiT, pg8::StaticOrder, true, true>(c.lds, g_, S_, E_, tid_); } while (0)
#define GEMM8(EpiT, Aptr, Bptr, N_, K_, ...) do { pg8::Gemm g_{(const pg8::bf16_t*)(Aptr), (const pg8::bf16_t*)(Bptr), T, (N_), (K_), (K_)}; pg8::StaticOrder S_; S_.init(T, (N_), c.G, bid); EpiT E_{__VA_ARGS__}; \
        int tid_ = c.tid; asm volatile("" : "+v"(tid_)); pg8::gemm_phase<EpiT, pg8::StaticOrder, true, true, true>(c.lds, g_, S_, E_, tid_); } while (0)

#ifndef STAG_P1
#define STAG_P1 0
#endif
#ifndef STAG_FFN1
#define STAG_FFN1 0
#endif
#ifndef STAG_GEMM1
#define STAG_GEMM1 0
#endif
#define STAGGER(ticks) do { if ((ticks) > 0 && ((bid >> 3) & 1)) { const unsigned long long t0_ = __builtin_amdgcn_s_memrealtime(); while (__builtin_amdgcn_s_memrealtime() - t0_ < (unsigned long long)(ticks)) __builtin_amdgcn_s_sleep(4); } } while (0)
    PH_BEGIN for (int rep_ = 0; rep_ < REP_PRO; ++rep_) {
        for (int wgi = bid; wgi < DEPTH * S5G; wgi += c.G) { const int l = wgi >> 5, g = wgi & 31;
            s5_tables(c, g, IN(10) + l * 2048, IN(11) + l * 2048, IN(12) + l * 32, IN(13) + (size_t)l * 32768, IN(14) + (size_t)l * 32768, IN(15) + (size_t)l * 32768, IN(16) + (size_t)l * 32768,
                      WSP(bf16_t, WS_S5MT) + (size_t)wgi * S5_MT_ELEMS, WSP(bf16_t, WS_S5W) + (size_t)wgi * S5_W_ELEMS, WSP(float, WS_S5LB) + l * 4096); }
        { ConvDist cd_{c.G >= 128 ? (bid >= DEPTH * S5G ? c.gw - DEPTH * S5G * NWAVES : -1) : c.gw, c.G >= 128 ? c.NGW - DEPTH * S5G * NWAVES : c.NGW, 0};
          JOB_MIXER(0); }
        f_rope_table(c, WSP(float, WS_ROPE));
        f_xbss(c, IN(0), WSP(bf16_t, WS_XB), WSP(unsigned char, WS_XB8), WSP(u64, WS_XSSM), c.G >= 128 ? DEPTH * S5G : 0);
    } PH_END

    { constexpr int l = 0;
        PH_BEGIN STAGGER(STAG_P1); GEMM(EpiProjF, WSP(bf16_t, WS_XB), WSP(bf16_t, WS_WIN) + (size_t)l * 3072 * D, 1024, D, WSP(u64, WS_XSSM) + l * T, WSP(float, WS_BIASL) + l * 3072, WSP(bf16_t, WS_QLAT), WSP(bf16_t, WS_KVLAT),
                      WSP(bf16_t, WS_U), WSP(bf16_t, WS_GA), WSP(bf16_t, WS_GB), WSP(u64, WS_QSS) + l * T, WSP(u64, WS_KVSS) + l * T, WSP(float, WS_KRSS), 0, 1.f);
                 __syncthreads();
                 GEMM8(EpiProjF, WSP(bf16_t, WS_XB8), WSP(bf16_t, WS_WIN8) + (size_t)l * 2048 * (D / 2), 2048, D / 2, WSP(u64, WS_XSSM) + l * T, WSP(float, WS_BIASL) + l * 3072, WSP(bf16_t, WS_QLAT), WSP(bf16_t, WS_KVLAT),
                      WSP(bf16_t, WS_U), WSP(bf16_t, WS_GA), WSP(bf16_t, WS_GB), WSP(u64, WS_QSS) + l * T, WSP(u64, WS_KVSS) + l * T, WSP(float, WS_KRSS), 4, 1.f / 64.f); PH_END
        PH_BEGIN for (int rep_ = 0; rep_ < REP_P2; ++rep_) { GEMM(EpiRowScale, WSP(bf16_t, WS_QLAT), WSP(bf16_t, WS_WUQ) + (size_t)l * 768 * 256, 768, 256, WSP(bf16_t, WS_QRAW), WSP(u64, WS_QSS) + l * T, 768, 1.f / 256.f);
                 __syncthreads();
                 if (c.G == 256) { GEMM(EpiKV, WSP(bf16_t, WS_KVLAT), WSP(bf16_t, WS_WUKV) + (size_t)l * 1024 * 256, 1024, 256, WSP(u64, WS_KVSS) + l * T, WSP(float, WS_KRSS), WSP(bf16_t, WS_KVLAT), IN(9) + l * QKD, WSP(float, WS_ROPE), WSP(bf16_t, WS_K), WSP(bf16_t, WS_V)); }
                 else { GEMM(EpiKVslow, WSP(bf16_t, WS_KVLAT), WSP(bf16_t, WS_WUKV) + (size_t)l * 1024 * 256, 1024, 256, WSP(u64, WS_KVSS) + l * T, WSP(float, WS_KRSS), WSP(bf16_t, WS_KVLAT), IN(9) + l * QKD, WSP(float, WS_ROPE), WSP(bf16_t, WS_K), WSP(bf16_t, WS_V)); }
                 __syncthreads();
                 f_s5_e(c, WSP(bf16_t, WS_U), WSP(bf16_t, WS_S5W) + (size_t)l * 32 * S5_W_ELEMS, WSP(float, WS_S5E));
 __syncthreads(); }
                 PH_END
        PH_BEGIN { unsigned* scnt_ = WSP(unsigned, WS_SCANCNT) + 64 * l; const int nscan_ = bid < BATCH * S5G ? (BATCH * S5G - bid + c.G - 1) / c.G : 0;
                 if (nscan_ > 0) { f_s5_scan(c, WSP(float, WS_S5E), WSP(float, WS_S5LB) + l * 4096, WSP(bf16_t, WS_S5X)); asm volatile("s_waitcnt vmcnt(0)" ::: "memory"); __syncthreads();
                     if (c.tid == 0) { __builtin_amdgcn_fence(__ATOMIC_RELEASE, "agent"); asm volatile("s_waitcnt vmcnt(0)" ::: "memory"); (void)__hip_atomic_fetch_add(scnt_, (unsigned)nscan_, __ATOMIC_RELAXED, __HIP_MEMORY_SCOPE_AGENT); } }
                 { const float sb_ = attn_score_bound(c, IN(8) + l * QKD, IN(9) + l * QKD); const float sbe_ = sb_ * 1.02f;     const bool fast_ = sbe_ <= 17.0f && !PROBE_ONLINE; const float csh_ = ceilf(fmaxf(sbe_ - 15.7f, 0.f) * 8.f) * 0.125f;         const int slot_ = (c.G % 8 == 0 ? (bid % 8) * (c.G / 8) + bid / 8 : bid) % 3;
                 for (int part_ = 0; part_ < 3; ++part_) {
                     if (part_ == slot_) { __syncthreads(); { Ctx cj_ = c; cj_.lane = hw_lane(); cj_.tid = cj_.wave * 64 + cj_.lane; const Ctx& c = cj_;     const int nsw_ = (c.G >= 128 ? BATCH * S5G : 0) * NWAVES;     ConvDist cd_{l == 0 ? (c.gw >= nsw_ ? c.gw - nsw_ : -1) : (c.gw >= nsw_ ? c.gw - nsw_ : c.gw + c.NGW - nsw_), l == 0 ? c.NGW - nsw_ : c.NGW, 0, (l == 1 && c.G == 256) ? MOE_S2 : 0, 0x7fffffff}; if (l == 0) { JOB_MIXER(1); JOB_FFN(); } else { JOB_MOE(); } } __syncthreads(); }
                     if (part_ < 2) f_attn_part(c, WSP(bf16_t, WS_QRAW), WSP(bf16_t, WS_K), WSP(bf16_t, WS_V), WSP(bf16_t, WS_ATT), IN(8) + l * QKD, WSP(float, WS_ROPE), part_, fast_, csh_); } }
                 __syncthreads();
                 if (c.tid == 0) { unsigned sp_ = 0u; while (__hip_atomic_load(scnt_, __ATOMIC_RELAXED, __HIP_MEMORY_SCOPE_AGENT) < (unsigned)(BATCH * S5G)) { __builtin_amdgcn_s_sleep(4); if (++sp_ > (1u << 22)) break; }
                     __builtin_amdgcn_fence(__ATOMIC_ACQUIRE, "agent"); asm volatile("s_waitcnt vmcnt(0)" ::: "memory"); }
                 __syncthreads();
                 for (int rep_ = 0; rep_ < REP_S5Y; ++rep_) { f_s5_y(c, WSP(bf16_t, WS_U), WSP(bf16_t, WS_S5X), WSP(bf16_t, WS_S5MT) + (size_t)l * 32 * S5_MT_ELEMS, IN(17) + l * 512, WSP(bf16_t, WS_YG)); } } PH_END
        PH_BEGIN GEMM(EpiGluF, WSP(bf16_t, WS_YG), WSP(bf16_t, WS_WGLU) + (size_t)l * 512 * 512, 512, 512, WSP(bf16_t, WS_YG), IN(19) + l * 512, WSP(bf16_t, WS_ATT) + 512, 1024, 0);
                 if (l == 0) MOE_SLICE(0, MOE_S0); else MOE_SLICE(MOE_S1, MOE_S2); PH_END
        PH_BEGIN GEMM(EpiMixFused, WSP(bf16_t, WS_ATT), WSP(bf16_t, WS_WPA) + (size_t)l * 1024 * 1024, 1024, 1024, WSP(bf16_t, WS_GA), WSP(bf16_t, WS_GB), WSP(bf16_t, WS_MIX)); PH_END
        PH_BEGIN if (l == 0) { GEMM(EpiResidF<false COMMA false>, WSP(bf16_t, WS_MIX), WSP(bf16_t, WS_WOUT), D, D, IN(0), nullptr, WSP(bf16_t, WS_XB), WSP(u64, WS_XSSF), nullptr); }
                 else { GEMM(EpiResidF<true COMMA true>, WSP(bf16_t, WS_MIX), WSP(bf16_t, WS_WOUT) + (size_t)D * D, D, D, nullptr, X, WSP(bf16_t, WS_XB), WSP(u64, WS_XSSF) + T, WSP(unsigned char, WS_XB8)); } PH_END
        if (l == 0) {
            PH_BEGIN STAGGER(STAG_FFN1); for (int rep_ = 0; rep_ < REP_FFN1; ++rep_) { GEMM(EpiSwigluF, WSP(bf16_t, WS_XB), WSP(bf16_t, WS_WFGU), 2 * FFD, D, WSP(bf16_t, WS_HD), WSP(u64, WS_XSSF), nullptr, FFD, 22, 1.f); } MOE_SLICE(MOE_S0, MOE_S1); PH_END
            PH_BEGIN GEMM(EpiResidF<true COMMA false COMMA true COMMA true>, WSP(bf16_t, WS_HD), WSP(bf16_t, WS_WFD), D, FFD, nullptr, nullptr, WSP(bf16_t, WS_XB), WSP(u64, WS_XSSM) + T, WSP(unsigned char, WS_XB8)); PH_END
        } else {
            PH_BEGIN for (int rep_ = 0; rep_ < REP_ROUTE1; ++rep_) { __syncthreads(); f_route1(c, X, IN(23) + l * D, IN(27), IN(28), WSP(int, WS_TOPE), WSP(float, WS_TOPW), WSP(int, WS_RANK), WSP(int, WS_CNT), WSP(int, WS_ROWTOK), WSP(float, WS_RROW));
 } PH_END
            PH_BEGIN for (int rep_ = 0; rep_ < REP_ROUTE2; ++rep_) { f_route2(c, WSP(int, WS_TOPE), WSP(int, WS_RANK), WSP(int, WS_CNT), WSP(int, WS_POS), WSP(int, WS_ROWTOK), WSP(int, WS_TILEE), WSP(int, WS_NTILES), WSP(u64, WS_XSSF) + T, WSP(float, WS_RROW)); } PH_END
            PH_BEGIN { const int ntl = __builtin_amdgcn_readfirstlane(WSP(int, WS_NTILES)[0]);
                pg8::Gemm g_{(const pg8::bf16_t*)WSP(bf16_t, WS_XB8), (const pg8::bf16_t*)WSP(bf16_t, WS_WMGU), ntl * 256, 2 * FFE, D / 2, D / 2};     LAS int* lte_ = (LAS int*)(c.lds + pg8::STAGE_BYTES); for (int i_ = c.tid; i_ < RCAP / 256; i_ += NTHREADS) lte_[i_] = WSP(int, WS_TILEE)[i_]; __syncthreads();
                pg8::MoeOrder S_; S_.init(ntl * 256, 2 * FFE, c.G, bid); S_.tile_e = lte_; S_.per_e = 2 * FFE / 256;
                EpiSwigluF8 E_{WSP(bf16_t, WS_H1), nullptr, WSP(float, WS_RROW), FFE, 2 * FFE / 256, 1.f};
                STAGGER(STAG_GEMM1); int tid_ = c.tid; asm volatile("" : "+v"(tid_)); for (int rep_ = 0; rep_ < REP_GEMM1; ++rep_) pg8::gemm_phase_gather<EpiSwigluF8, pg8::MoeOrder, true>(c.lds, g_, WSP(int, WS_ROWTOK), S_, E_, tid_); } PH_END
            PH_BEGIN { const int ntl = __builtin_amdgcn_readfirstlane(WSP(int, WS_NTILES)[0]); const int nfull = ntl < 128 ? ntl : 128;
                { pg8::Gemm g_{(const pg8::bf16_t*)WSP(bf16_t, WS_H1), (const pg8::bf16_t*)WSP(bf16_t, WS_WMD), nfull * 256, D, FFE / 2, FFE / 2}; LAS int* lte_ = (LAS int*)(c.lds + pg8::STAGE_BYTES); for (int i_ = c.tid; i_ < RCAP / 256; i_ += NTHREADS) lte_[i_] = WSP(int, WS_TILEE)[i_]; __syncthreads();
                  pg8::MoeOrder S_; S_.init(nfull * 256, D, c.G, bid); S_.tile_e = lte_; S_.per_e = D / 256;
                  EpiStoreBf16 E_{WSP(bf16_t, WS_YB), D, D / 256};
                  int tid_ = c.tid; asm volatile("" : "+v"(tid_)); for (int rep_ = 0; rep_ < REP_GEMM2; ++rep_) pg8::gemm_phase<EpiStoreBf16, pg8::MoeOrder, true, true, true>(c.lds, g_, S_, E_, tid_); }
                __syncthreads();
                if (ntl > nfull) {
                    if ((ntl - nfull) * (D / 256) * TAIL_NSL7 <= c.G) {
                        pg8::Gemm g_{(const pg8::bf16_t*)WSP(bf16_t, WS_H1), (const pg8::bf16_t*)WSP(bf16_t, WS_WMD), ntl * 256, D, FFE / 2 / TAIL_NSL7, FFE / 2};
                        EpiSplitKAll E_{WSP(bf16_t, WS_YB), WSP(float, WS_SLAB), WSP(unsigned, WS_TICKETS), D, D / 256, nfull, TAIL_NSL7, FFE / TAIL_NSL7};
                        pg8::TailOrder S_{WSP(int, WS_TILEE), nfull, ntl - nfull, D / 256, TAIL_NSL7, FFE / TAIL_NSL7, bid};
                        int tid_ = c.tid; asm volatile("" : "+v"(tid_)); pg8::gemm_phase<EpiSplitKAll, pg8::TailOrder, false, true, true>(c.lds, g_, S_, E_, tid_); __syncthreads();
                    } else {
                    pg8::Gemm g_{(const pg8::bf16_t*)WSP(bf16_t, WS_H1), (const pg8::bf16_t*)WSP(bf16_t, WS_WMD), ntl * 256, D, FFE / 2 / TAIL_NSL, FFE / 2};
                    EpiSplitK E_{WSP(bf16_t, WS_YB), WSP(float, WS_XB), WSP(unsigned, WS_TICKETS), D, D / 256, nfull, TAIL_NSL, FFE / TAIL_NSL};
                    for (int base_ = 0; base_ < (ntl - nfull) * (D / 256) * TAIL_NSL; base_ += c.G) {
                        pg8::TailOrder S_{WSP(int, WS_TILEE), nfull, ntl - nfull, D / 256, TAIL_NSL, FFE / TAIL_NSL, bid + base_};
                        int tid_ = c.wave * 64 + hw_lane(); asm volatile("" : "+v"(tid_)); pg8::gemm_phase<EpiSplitK, pg8::TailOrder, false, true, true>(c.lds, g_, S_, E_, tid_); __syncthreads(); } } } } PH_END
            PH_BEGIN f_combine(c, X, WSP(bf16_t, WS_YB), WSP(int, WS_POS), WSP(float, WS_TOPW)); PH_END
        }

    }
    { constexpr int l = 1;
        PH_BEGIN STAGGER(STAG_P1); GEMM(EpiProjF, WSP(bf16_t, WS_XB), WSP(bf16_t, WS_WIN) + (size_t)l * 3072 * D, 1024, D, WSP(u64, WS_XSSM) + l * T, WSP(float, WS_BIASL) + l * 3072, WSP(bf16_t, WS_QLAT), WSP(bf16_t, WS_KVLAT),
                      WSP(bf16_t, WS_U), WSP(bf16_t, WS_GA), WSP(bf16_t, WS_GB), WSP(u64, WS_QSS) + l * T, WSP(u64, WS_KVSS) + l * T, WSP(float, WS_KRSS), 0, 1.f);
                 __syncthreads();
                 GEMM8(EpiProjF, WSP(bf16_t, WS_XB8), WSP(bf16_t, WS_WIN8) + (size_t)l * 2048 * (D / 2), 2048, D / 2, WSP(u64, WS_XSSM) + l * T, WSP(float, WS_BIASL) + l * 3072, WSP(bf16_t, WS_QLAT), WSP(bf16_t, WS_KVLAT),
                      WSP(bf16_t, WS_U), WSP(bf16_t, WS_GA), WSP(bf16_t, WS_GB), WSP(u64, WS_QSS) + l * T, WSP(u64, WS_KVSS) + l * T, WSP(float, WS_KRSS), 4, 1.f / 64.f); PH_END
        PH_BEGIN for (int rep_ = 0; rep_ < REP_P2; ++rep_) { GEMM(EpiRowScale, WSP(bf16_t, WS_QLAT), WSP(bf16_t, WS_WUQ) + (size_t)l * 768 * 256, 768, 256, WSP(bf16_t, WS_QRAW), WSP(u64, WS_QSS) + l * T, 768, 1.f / 256.f);
                 __syncthreads();
                 if (c.G == 256) { GEMM(EpiKV, WSP(bf16_t, WS_KVLAT), WSP(bf16_t, WS_WUKV) + (size_t)l * 1024 * 256, 1024, 256, WSP(u64, WS_KVSS) + l * T, WSP(float, WS_KRSS), WSP(bf16_t, WS_KVLAT), IN(9) + l * QKD, WSP(float, WS_ROPE), WSP(bf16_t, WS_K), WSP(bf16_t, WS_V)); }
                 else { GEMM(EpiKVslow, WSP(bf16_t, WS_KVLAT), WSP(bf16_t, WS_WUKV) + (size_t)l * 1024 * 256, 1024, 256, WSP(u64, WS_KVSS) + l * T, WSP(float, WS_KRSS), WSP(bf16_t, WS_KVLAT), IN(9) + l * QKD, WSP(float, WS_ROPE), WSP(bf16_t, WS_K), WSP(bf16_t, WS_V)); }
                 __syncthreads();
                 f_s5_e(c, WSP(bf16_t, WS_U), WSP(bf16_t, WS_S5W) + (size_t)l * 32 * S5_W_ELEMS, WSP(float, WS_S5E));
 __syncthreads(); }
                 PH_END
        PH_BEGIN { unsigned* scnt_ = WSP(unsigned, WS_SCANCNT) + 64 * l; const int nscan_ = bid < BATCH * S5G ? (BATCH * S5G - bid + c.G - 1) / c.G : 0;
                 if (nscan_ > 0) { f_s5_scan(c, WSP(float, WS_S5E), WSP(float, WS_S5LB) + l * 4096, WSP(bf16_t, WS_S5X)); asm volatile("s_waitcnt vmcnt(0)" ::: "memory"); __syncthreads();
                     if (c.tid == 0) { __builtin_amdgcn_fence(__ATOMIC_RELEASE, "agent"); asm volatile("s_waitcnt vmcnt(0)" ::: "memory"); (void)__hip_atomic_fetch_add(scnt_, (unsigned)nscan_, __ATOMIC_RELAXED, __HIP_MEMORY_SCOPE_AGENT); } }
                 { const float sb_ = attn_score_bound(c, IN(8) + l * QKD, IN(9) + l * QKD); const float sbe_ = sb_ * 1.02f;     const bool fast_ = sbe_ <= 17.0f && !PROBE_ONLINE; const float csh_ = ceilf(fmaxf(sbe_ - 15.7f, 0.f) * 8.f) * 0.125f;         const int slot_ = (c.G % 8 == 0 ? (bid % 8) * (c.G / 8) + bid / 8 : bid) % 3;
                 for (int part_ = 0; part_ < 3; ++part_) {
                     if (part_ == slot_) { __syncthreads(); { Ctx cj_ = c; cj_.lane = hw_lane(); cj_.tid = cj_.wave * 64 + cj_.lane; const Ctx& c = cj_;     const int nsw_ = (c.G >= 128 ? BATCH * S5G : 0) * NWAVES;     ConvDist cd_{l == 0 ? (c.gw >= nsw_ ? c.gw - nsw_ : -1) : (c.gw >= nsw_ ? c.gw - nsw_ : c.gw + c.NGW - nsw_), l == 0 ? c.NGW - nsw_ : c.NGW, 0, (l == 1 && c.G == 256) ? MOE_S2 : 0, 0x7fffffff}; if (l == 0) { JOB_MIXER(1); JOB_FFN(); } else { JOB_MOE(); } } __syncthreads(); }
                     if (part_ < 2) f_attn_part(c, WSP(bf16_t, WS_QRAW), WSP(bf16_t, WS_K), WSP(bf16_t, WS_V), WSP(bf16_t, WS_ATT), IN(8) + l * QKD, WSP(float, WS_ROPE), part_, fast_, csh_); } }
                 __syncthreads();
                 if (c.tid == 0) { unsigned sp_ = 0u; while (__hip_atomic_load(scnt_, __ATOMIC_RELAXED, __HIP_MEMORY_SCOPE_AGENT) < (unsigned)(BATCH * S5G)) { __builtin_amdgcn_s_sleep(4); if (++sp_ > (1u << 22)) break; }
                     __builtin_amdgcn_fence(__ATOMIC_ACQUIRE, "agent"); asm volatile("s_waitcnt vmcnt(0)" ::: "memory"); }
                 __syncthreads();
                 for (int rep_ = 0; rep_ < REP_S5Y; ++rep_) { f_s5_y(c, WSP(bf16_t, WS_U), WSP(bf16_t, WS_S5X), WSP(bf16_t, WS_S5MT) + (size_t)l * 32 * S5_MT_ELEMS, IN(17) + l * 512, WSP(bf16_t, WS_YG)); } } PH_END
        PH_BEGIN GEMM(EpiGluF, WSP(bf16_t, WS_YG), WSP(bf16_t, WS_WGLU) + (size_t)l * 512 * 512, 512, 512, WSP(bf16_t, WS_YG), IN(19) + l * 512, WSP(bf16_t, WS_ATT) + 512, 1024, 0);
                 if (l == 0) MOE_SLICE(0, MOE_S0); else MOE_SLICE(MOE_S1, MOE_S2); PH_END
        PH_BEGIN GEMM(EpiMixFused, WSP(bf16_t, WS_ATT), WSP(bf16_t, WS_WPA) + (size_t)l * 1024 * 1024, 1024, 1024, WSP(bf16_t, WS_GA), WSP(bf16_t, WS_GB), WSP(bf16_t, WS_MIX)); PH_END
        PH_BEGIN if (l == 0) { GEMM(EpiResidF<false COMMA false>, WSP(bf16_t, WS_MIX), WSP(bf16_t, WS_WOUT), D, D, IN(0), nullptr, WSP(bf16_t, WS_XB), WSP(u64, WS_XSSF), nullptr); }
                 else { GEMM(EpiResidF<true COMMA true>, WSP(bf16_t, WS_MIX), WSP(bf16_t, WS_WOUT) + (size_t)D * D, D, D, nullptr, X, WSP(bf16_t, WS_XB), WSP(u64, WS_XSSF) + T, WSP(unsigned char, WS_XB8)); } PH_END
        if (l == 0) {
            PH_BEGIN STAGGER(STAG_FFN1); for (int rep_ = 0; rep_ < REP_FFN1; ++rep_) { GEMM(EpiSwigluF, WSP(bf16_t, WS_XB), WSP(bf16_t, WS_WFGU), 2 * FFD, D, WSP(bf16_t, WS_HD), WSP(u64, WS_XSSF), nullptr, FFD, 22, 1.f); } MOE_SLICE(MOE_S0, MOE_S1); PH_END
            PH_BEGIN GEMM(EpiResidF<true COMMA false COMMA true COMMA true>, WSP(bf16_t, WS_HD), WSP(bf16_t, WS_WFD), D, FFD, nullptr, nullptr, WSP(bf16_t, WS_XB), WSP(u64, WS_XSSM) + T, WSP(unsigned char, WS_XB8)); PH_END
        } else {
            PH_BEGIN for (int rep_ = 0; rep_ < REP_ROUTE1; ++rep_) { __syncthreads(); f_route1(c, X, IN(23) + l * D, IN(27), IN(28), WSP(int, WS_TOPE), WSP(float, WS_TOPW), WSP(int, WS_RANK), WSP(int, WS_CNT), WSP(int, WS_ROWTOK), WSP(float, WS_RROW));
 } PH_END
            PH_BEGIN for (int rep_ = 0; rep_ < REP_ROUTE2; ++rep_) { f_route2(c, WSP(int, WS_TOPE), WSP(int, WS_RANK), WSP(int, WS_CNT), WSP(int, WS_POS), WSP(int, WS_ROWTOK), WSP(int, WS_TILEE), WSP(int, WS_NTILES), WSP(u64, WS_XSSF) + T, WSP(float, WS_RROW)); } PH_END
            PH_BEGIN { const int ntl = __builtin_amdgcn_readfirstlane(WSP(int, WS_NTILES)[0]);
                pg8::Gemm g_{(const pg8::bf16_t*)WSP(bf16_t, WS_XB8), (const pg8::bf16_t*)WSP(bf16_t, WS_WMGU), ntl * 256, 2 * FFE, D / 2, D / 2};     LAS int* lte_ = (LAS int*)(c.lds + pg8::STAGE_BYTES); for (int i_ = c.tid; i_ < RCAP / 256; i_ += NTHREADS) lte_[i_] = WSP(int, WS_TILEE)[i_]; __syncthreads();
                pg8::MoeOrder S_; S_.init(ntl * 256, 2 * FFE, c.G, bid); S_.tile_e = lte_; S_.per_e = 2 * FFE / 256;
                EpiSwigluF8 E_{WSP(bf16_t, WS_H1), nullptr, WSP(float, WS_RROW), FFE, 2 * FFE / 256, 1.f};
                STAGGER(STAG_GEMM1); int tid_ = c.tid; asm volatile("" : "+v"(tid_)); for (int rep_ = 0; rep_ < REP_GEMM1; ++rep_) pg8::gemm_phase_gather<EpiSwigluF8, pg8::MoeOrder, true>(c.lds, g_, WSP(int, WS_ROWTOK), S_, E_, tid_); } PH_END
            PH_BEGIN { const int ntl = __builtin_amdgcn_readfirstlane(WSP(int, WS_NTILES)[0]); const int nfull = ntl < 128 ? ntl : 128;
                { pg8::Gemm g_{(const pg8::bf16_t*)WSP(bf16_t, WS_H1), (const pg8::bf16_t*)WSP(bf16_t, WS_WMD), nfull * 256, D, FFE / 2, FFE / 2}; LAS int* lte_ = (LAS int*)(c.lds + pg8::STAGE_BYTES); for (int i_ = c.tid; i_ < RCAP / 256; i_ += NTHREADS) lte_[i_] = WSP(int, WS_TILEE)[i_]; __syncthreads();
                  pg8::MoeOrder S_; S_.init(nfull * 256, D, c.G, bid); S_.tile_e = lte_; S_.per_e = D / 256;
                  EpiStoreBf16 E_{WSP(bf16_t, WS_YB), D, D / 256};
                  int tid_ = c.tid; asm volatile("" : "+v"(tid_)); for (int rep_ = 0; rep_ < REP_GEMM2; ++rep_) pg8::gemm_phase<EpiStoreBf16, pg8::MoeOrder, true, true, true>(c.lds, g_, S_, E_, tid_); }
                __syncthreads();
                if (ntl > nfull) {
                    if ((ntl - nfull) * (D / 256) * TAIL_NSL7 <= c.G) {
                        pg8::Gemm g_{(const pg8::bf16_t*)WSP(bf16_t, WS_H1), (const pg8::bf16_t*)WSP(bf16_t, WS_WMD), ntl * 256, D, FFE / 2 / TAIL_NSL7, FFE / 2};
                        EpiSplitKAll E_{WSP(bf16_t, WS_YB), WSP(float, WS_SLAB), WSP(unsigned, WS_TICKETS), D, D / 256, nfull, TAIL_NSL7, FFE / TAIL_NSL7};
                        pg8::TailOrder S_{WSP(int, WS_TILEE), nfull, ntl - nfull, D / 256, TAIL_NSL7, FFE / TAIL_NSL7, bid};
                        int tid_ = c.tid; asm volatile("" : "+v"(tid_)); pg8::gemm_phase<EpiSplitKAll, pg8::TailOrder, false, true, true>(c.lds, g_, S_, E_, tid_); __syncthreads();
                    } else {
                    pg8::Gemm g_{(const pg8::bf16_t*)WSP(bf16_t, WS_H1), (const pg8::bf16_t*)WSP(bf16_t, WS_WMD), ntl * 256, D, FFE / 2 / TAIL_NSL, FFE / 2};
                    EpiSplitK E_{WSP(bf16_t, WS_YB), WSP(float, WS_XB), WSP(unsigned, WS_TICKETS), D, D / 256, nfull, TAIL_NSL, FFE / TAIL_NSL};
                    for (int base_ = 0; base_ < (ntl - nfull) * (D / 256) * TAIL_NSL; base_ += c.G) {
                        pg8::TailOrder S_{WSP(int, WS_TILEE), nfull, ntl - nfull, D / 256, TAIL_NSL, FFE / TAIL_NSL, bid + base_};
                        int tid_ = c.wave * 64 + hw_lane(); asm volatile("" : "+v"(tid_)); pg8::gemm_phase<EpiSplitK, pg8::TailOrder, false, true, true>(c.lds, g_, S_, E_, tid_); __syncthreads(); } } } } PH_END
            PH_BEGIN f_combine(c, X, WSP(bf16_t, WS_YB), WSP(int, WS_POS), WSP(float, WS_TOPW)); PH_END
        }

    }
    if ((PROBE_MASK != 0ull || PROBE_BAR) && blockIdx.x == 0 && (c0.wave == 0 && hw_lane() == 0)) { const unsigned long long t0_ = __builtin_amdgcn_s_memrealtime(); const unsigned long long acc_ = PRB[0]; while (__builtin_amdgcn_s_memrealtime() - t0_ < acc_) __builtin_amdgcn_s_sleep(8); }
}

extern "C" void kernel_launch(void* const* d_in, const int* in_sizes, int n_in, void* d_out, int out_size, void* d_ws, size_t ws_size, hipStream_t stream) {
    static int grid = 0;
    if (grid == 0) {
        if (n_in != 32 || out_size != T * D || ws_size < WS_END) { fprintf(stderr, "kernel_launch: unexpected shapes (n_in %d out %d ws %zu)\n", n_in, out_size, ws_size); grid = -1; return; }
        int dev = 0, cus = 0, per_cu = 0;
        if (hipGetDevice(&dev) != hipSuccess || hipDeviceGetAttribute(&cus, hipDeviceAttributeMultiprocessorCount, dev) != hipSuccess) { grid = -1; return; }
        if (hipFuncSetAttribute((const void*)mk_fwd, hipFuncAttributeMaxDynamicSharedMemorySize, LDS_BYTES) != hipSuccess) { fprintf(stderr, "kernel_launch: hipFuncSetAttribute failed\n"); grid = -1; return; }
        if (hipOccupancyMaxActiveBlocksPerMultiprocessor(&per_cu, (const void*)mk_fwd, NTHREADS, LDS_BYTES) != hipSuccess || per_cu < 1) { fprintf(stderr, "kernel_launch: occupancy query says %d\n", per_cu); }
        (void)hipGetLastError();
        grid = cus;
    }
    if (grid < 0) return;
    (void)hipMemsetAsync((char*)d_ws + WS_CTL, 0, CTL_ZERO_BYTES, stream);
    Args a{};
    for (int i = 0; i < 32; ++i) a.in[i] = (const float*)d_in[i];
    a.out = (float*)d_out; a.ws = (unsigned char*)d_ws; a.ph_lo = 0; a.ph_hi = 1000;
    hipLaunchKernelGGL(mk_fwd, dim3(grid), dim3(NTHREADS), LDS_BYTES, stream, a);
}
```
